# Optimizing an MI355X kernel written in HIP

```python
import math
import jax, jax.numpy as jnp
from jax import lax
import numpy as np

D_MODEL = 1024
BATCH = 8
SEQ = 4096
DEPTH = 1

GDN_HEADS = 8
GDN_DK = 64
GDN_DV = 64
GDN_CONV = 4
GDN_CHUNK = 64
NSA_HEADS = 8
NSA_KV_GROUPS = 2
NSA_HPG = NSA_HEADS // NSA_KV_GROUPS
NSA_DH = 64
NSA_BRANCHES = 3
CMP_BLOCK = 32
CMP_STRIDE = 16
SEL_BLOCK = 64
N_SELECT = 16
WINDOW = 512
NSA_QBLOCK = 64
FORCE_BONUS = 1e4
REL_BUCKETS = 32
REL_MAX_DIST = 128
PEER_HEADS = 8
PEER_NKEYS = 128
PEER_N_EXPERTS = PEER_NKEYS * PEER_NKEYS
PEER_TOPK = 16
PEER_DQ = 256
PEER_DQH = PEER_DQ // 2
PEER_TOKBLOCK = 128
GDN_QKV_W = 2 * GDN_HEADS * GDN_DK + GDN_HEADS * GDN_DV
GDN_Z_W = GDN_HEADS * GDN_DV
GDN_BETA_W = GDN_HEADS
GDN_DECAY_W = GDN_HEADS
NSA_Q_W = NSA_HEADS * NSA_DH
NSA_KV_W = NSA_BRANCHES * 2 * NSA_KV_GROUPS * NSA_DH
NSA_GATE_W = NSA_HEADS * NSA_BRANCHES
MERGE_W = 2 * D_MODEL
N_IN = GDN_QKV_W + GDN_Z_W + GDN_BETA_W + GDN_DECAY_W + NSA_Q_W + NSA_KV_W + NSA_GATE_W + MERGE_W
RMS_EPS = 1e-6
NEG = -1e30

kernel_name = 'hybrid_gdn_nsa_peer_block'


def rms_norm(x, w):
    xf = x.astype(jnp.float32)
    y = xf * lax.rsqrt(jnp.mean(xf * xf, axis=-1, keepdims=True) + RMS_EPS)
    return (y * w.astype(jnp.float32)).astype(x.dtype)


def l2_normalize(x):
    xf = x.astype(jnp.float32)
    return xf * lax.rsqrt(jnp.sum(xf * xf, axis=-1, keepdims=True) + 1e-6)


def t5_bucket(dist):
    dist = jnp.maximum(dist, 0)
    max_exact = REL_BUCKETS // 2
    d = jnp.maximum(dist, 1).astype(jnp.float32)
    large = max_exact + (jnp.log(d / max_exact) / math.log(REL_MAX_DIST / max_exact)
                         * (REL_BUCKETS - max_exact)).astype(jnp.int32)
    large = jnp.minimum(large, REL_BUCKETS - 1)
    return jnp.where(dist < max_exact, dist, large)


def masked_softmax(s, mask):
    s = jnp.where(mask, s.astype(jnp.float32), NEG)
    p = jax.nn.softmax(s, axis=-1)
    return jnp.where(mask, p, 0.0)


def causal_depthwise_conv(x, w):
    k = w.shape[0]
    return lax.conv_general_dilated(x, w[:, None, :].astype(x.dtype), (1,), ((k - 1, 0),),
                                    dimension_numbers=('NWC', 'WIO', 'NWC'),
                                    feature_group_count=x.shape[-1])


def gated_delta_rule_chunked(q, k, v, g, beta):
    b, h, s, dk = q.shape
    dv = v.shape[-1]
    c = GDN_CHUNK
    n = s // c
    q = (q * dk ** -0.5).reshape(b, h, n, c, dk)
    k = k.reshape(b, h, n, c, dk)
    v = v.reshape(b, h, n, c, dv)
    beta = beta.reshape(b, h, n, c)
    g = jnp.cumsum(g.reshape(b, h, n, c), axis=-1)
    lower = jnp.tril(jnp.ones((c, c), bool))
    strict = jnp.tril(jnp.ones((c, c), bool), -1)
    decay = jnp.where(lower, jnp.exp(jnp.where(lower, g[..., :, None] - g[..., None, :], 0.0)), 0.0)
    k_beta = k * beta[..., None]
    a_mat = jnp.where(strict, jnp.einsum('bhnid,bhnjd->bhnij', k_beta, k) * decay, 0.0)
    tri = a_mat + jnp.eye(c, dtype=a_mat.dtype)
    u = lax.linalg.triangular_solve(tri, v * beta[..., None], left_side=True, lower=True, unit_diagonal=True)
    w = lax.linalg.triangular_solve(tri, k_beta * jnp.exp(g)[..., None], left_side=True, lower=True,
                                    unit_diagonal=True)
    attn = jnp.einsum('bhnid,bhnjd->bhnij', q, k) * decay
    q_dec = q * jnp.exp(g)[..., None]
    k_dec = k * jnp.exp(g[..., -1:] - g)[..., None]
    g_last = jnp.exp(g[..., -1])

    def step(state, inp):
        u_i, w_i, q_i, a_i, k_i, gl_i = inp
        v_new = u_i - jnp.einsum('bhcd,bhde->bhce', w_i, state)
        o_i = jnp.einsum('bhcd,bhde->bhce', q_i, state) + jnp.einsum('bhij,bhje->bhie', a_i, v_new)
        state = state * gl_i[..., None, None] + jnp.einsum('bhcd,bhce->bhde', k_i, v_new)
        return state, o_i

    xs = (jnp.moveaxis(u, 2, 0), jnp.moveaxis(w, 2, 0), jnp.moveaxis(q_dec, 2, 0),
          jnp.moveaxis(attn, 2, 0), jnp.moveaxis(k_dec, 2, 0), jnp.moveaxis(g_last, 2, 0))
    state0 = jnp.zeros((b, h, dk, dv), jnp.float32)
    _, o = lax.scan(step, state0, xs)
    return jnp.moveaxis(o, 0, 2).reshape(b, h, s, dv)


def nsa_attention(q, kv, gates, cmp_pe_k, cmp_pe_v, cmp_w_k, cmp_w_v, rel_bias):
    b, s = q.shape[0], q.shape[1]
    G, HPG, DH, QB = NSA_KV_GROUPS, NSA_HPG, NSA_DH, NSA_QBLOCK
    scale = DH ** -0.5
    k_c, v_c = kv[:, :, 0, 0], kv[:, :, 0, 1]
    k_s, v_s = kv[:, :, 1, 0], kv[:, :, 1, 1]
    k_w, v_w = kv[:, :, 2, 0], kv[:, :, 2, 1]
    n_cmp = (s - CMP_BLOCK) // CMP_STRIDE + 1
    blk_idx = jnp.arange(n_cmp)[:, None] * CMP_STRIDE + jnp.arange(CMP_BLOCK)[None, :]
    k_cmp = jnp.einsum('bnlgd,lde->bnge', k_c[:, blk_idx] + cmp_pe_k[:, None, :], cmp_w_k)
    v_cmp = jnp.einsum('bnlgd,lde->bnge', v_c[:, blk_idx] + cmp_pe_v[:, None, :], cmp_w_v)
    cmp_start = jnp.arange(n_cmp) * CMP_STRIDE
    cmp_end = cmp_start + CMP_BLOCK - 1
    n_sel = s // SEL_BLOCK
    top_n = min(N_SELECT, n_sel)
    sel_start = jnp.arange(n_sel) * SEL_BLOCK
    overlap = jnp.clip(jnp.minimum(cmp_end[:, None] + 1, sel_start[None, :] + SEL_BLOCK)
                       - jnp.maximum(cmp_start[:, None], sel_start[None, :]), 0, None).astype(jnp.float32) / CMP_BLOCK
    k_s_g = k_s.transpose(0, 2, 1, 3)
    v_s_g = v_s.transpose(0, 2, 1, 3)
    pad = ((0, 0), (WINDOW, 0), (0, 0), (0, 0))
    k_w_pad = jnp.pad(k_w, pad)
    v_w_pad = jnp.pad(v_w, pad)
    tbl_g = rel_bias.reshape(REL_BUCKETS, G, HPG).transpose(1, 0, 2)
    b_ix = jnp.arange(b)[:, None, None, None, None]
    g_ix = jnp.arange(G)[None, :, None, None, None]

    def head_bias(dist):
        bb = rel_bias[t5_bucket(dist)]
        return bb.reshape(dist.shape + (G, HPG)).transpose(2, 3, 0, 1)

    def block(args):
        qi, q_blk, g_blk = args
        t = qi * QB + jnp.arange(QB)
        s_c = jnp.einsum('bqghd,bngd->bghqn', q_blk, k_cmp) * scale + head_bias(t[:, None] - cmp_end[None, :])
        p_c = masked_softmax(s_c, cmp_end[None, :] <= t[:, None])
        o_c = jnp.einsum('bghqn,bngd->bqghd', p_c.astype(v_cmp.dtype), v_cmp)
        imp = jnp.einsum('bghqn,nm->bgqm', p_c, overlap)
        blk = jnp.arange(n_sel)[None, :]
        cur = (t // SEL_BLOCK)[:, None]
        valid_blk = sel_start[None, :] <= t[:, None]
        forced = (blk == 0) | (blk == cur) | (blk == cur - 1)
        imp = jnp.where(valid_blk, imp + jnp.where(forced, FORCE_BONUS, 0.0), -1.0)
        top_val, top_idx = lax.top_k(imp, top_n)
        pos = top_idx[..., None] * SEL_BLOCK + jnp.arange(SEL_BLOCK)
        m_s = ((top_val >= 0.0)[..., None] & (pos <= t[None, None, :, None, None])).reshape(b, G, QB, -1)
        k_sel = k_s_g[b_ix, g_ix, pos].reshape(b, G, QB, -1, DH)
        v_sel = v_s_g[b_ix, g_ix, pos].reshape(b, G, QB, -1, DH)
        pos = pos.reshape(b, G, QB, -1)
        bias_s = tbl_g[g_ix[..., 0], t5_bucket(t[None, None, :, None] - pos)]
        s_s = jnp.einsum('bqghd,bgqld->bghql', q_blk, k_sel) * scale + bias_s.transpose(0, 1, 4, 2, 3)
        p_s = masked_softmax(s_s, m_s[:, :, None])
        o_s = jnp.einsum('bghql,bgqld->bqghd', p_s.astype(v_sel.dtype), v_sel)
        start = qi * QB
        k_win = lax.dynamic_slice_in_dim(k_w_pad, start, WINDOW + QB, axis=1)
        v_win = lax.dynamic_slice_in_dim(v_w_pad, start, WINDOW + QB, axis=1)
        kpos = start - WINDOW + jnp.arange(WINDOW + QB)
        dist = t[:, None] - kpos[None, :]
        m_w = (kpos[None, :] >= 0) & (dist >= 0) & (dist < WINDOW)
        s_w = jnp.einsum('bqghd,bkgd->bghqk', q_blk, k_win) * scale + head_bias(dist)
        p_w = masked_softmax(s_w, m_w)
        o_w = jnp.einsum('bghqk,bkgd->bqghd', p_w.astype(v_win.dtype), v_win)
        gate = jax.nn.sigmoid(g_blk.astype(jnp.float32))
        return gate[..., 0:1] * o_c + gate[..., 1:2] * o_s + gate[..., 2:3] * o_w

    nq = s // QB
    q_blocks = q.reshape(b, nq, QB, G, HPG, DH).swapaxes(0, 1)
    g_blocks = gates.reshape(b, nq, QB, G, HPG, NSA_BRANCHES).swapaxes(0, 1)
    out = lax.map(block, (jnp.arange(nq, dtype=jnp.int32), q_blocks, g_blocks))
    return out.swapaxes(0, 1).reshape(b, s, NSA_HEADS * DH).astype(q.dtype)


def peer_ffn(h, w_query, sub_keys, expert_u, expert_v):
    b, s, d = h.shape
    tok = h.reshape(-1, PEER_TOKBLOCK, d)
    kk = PEER_TOPK

    def block(h_blk):
        tb = h_blk.shape[0]
        qry = (h_blk @ w_query).reshape(tb, PEER_HEADS, 2, PEER_DQH)
        sc = jnp.einsum('thpd,hpkd->thpk', qry, sub_keys).astype(jnp.float32)
        s1, i1 = lax.top_k(sc[:, :, 0], kk)
        s2, i2 = lax.top_k(sc[:, :, 1], kk)
        cand = (s1[..., :, None] + s2[..., None, :]).reshape(tb, PEER_HEADS, kk * kk)
        cidx = (i1[..., :, None] * PEER_NKEYS + i2[..., None, :]).reshape(tb, PEER_HEADS, kk * kk)
        top, sel = lax.top_k(cand, kk)
        eidx = jnp.take_along_axis(cidx, sel, axis=-1)
        gate = jax.nn.softmax(top, axis=-1)
        u = expert_u[eidx]
        v = expert_v[eidx]
        act = jax.nn.gelu(jnp.einsum('td,thkd->thk', h_blk, u).astype(jnp.float32))
        return jnp.einsum('thk,thkd->td', (gate * act).astype(v.dtype), v)

    out = lax.map(block, tok)
    return out.reshape(b, s, d).astype(h.dtype)


def _split_points():
    widths = (GDN_QKV_W, GDN_Z_W, GDN_BETA_W, GDN_DECAY_W, NSA_Q_W, NSA_KV_W, NSA_GATE_W)
    pts = []
    acc = 0
    for wd in widths:
        acc += wd
        pts.append(acc)
    return pts


def hybrid_layer(x, rel_bias, norm_mix, w_in, conv_w, a_log, dt_bias, gdn_norm, cmp_pe_k, cmp_pe_v,
                 cmp_w_k, cmp_w_v, w_branch_a, w_branch_b, w_out, norm_ffn, w_query, sub_keys,
                 expert_u, expert_v):
    b, s, _ = x.shape
    h = rms_norm(x, norm_mix)
    proj = h @ w_in
    qkv, z, beta_in, a_in, q_n, kv_n, gate_n, merge = jnp.split(proj, _split_points(), axis=-1)
    qkv = jax.nn.silu(causal_depthwise_conv(qkv, conv_w))
    qa, ka, va = jnp.split(qkv, [GDN_HEADS * GDN_DK, 2 * GDN_HEADS * GDN_DK], axis=-1)
    qa = l2_normalize(qa.reshape(b, s, GDN_HEADS, GDN_DK).transpose(0, 2, 1, 3))
    ka = l2_normalize(ka.reshape(b, s, GDN_HEADS, GDN_DK).transpose(0, 2, 1, 3))
    va = va.reshape(b, s, GDN_HEADS, GDN_DV).transpose(0, 2, 1, 3).astype(jnp.float32)
    beta = jax.nn.sigmoid(beta_in.astype(jnp.float32)).transpose(0, 2, 1)
    g = (-jnp.exp(a_log.astype(jnp.float32))
         * jax.nn.softplus(a_in.astype(jnp.float32) + dt_bias.astype(jnp.float32))).transpose(0, 2, 1)
    oa = gated_delta_rule_chunked(qa, ka, va, g, beta).transpose(0, 2, 1, 3)
    oa = rms_norm(oa, gdn_norm) * jax.nn.silu(z.reshape(b, s, GDN_HEADS, GDN_DV).astype(jnp.float32))
    ya = oa.reshape(b, s, -1).astype(x.dtype) @ w_branch_a
    qb = q_n.reshape(b, s, NSA_KV_GROUPS, NSA_HPG, NSA_DH)
    kvb = kv_n.reshape(b, s, NSA_BRANCHES, 2, NSA_KV_GROUPS, NSA_DH)
    gb = gate_n.reshape(b, s, NSA_KV_GROUPS, NSA_HPG, NSA_BRANCHES)
    ob = nsa_attention(qb, kvb, gb, cmp_pe_k, cmp_pe_v, cmp_w_k, cmp_w_v, rel_bias)
    yb = ob @ w_branch_b
    gate_a, gate_b = jnp.split(merge, 2, axis=-1)
    mixed = (jax.nn.sigmoid(gate_a) * ya + jax.nn.sigmoid(gate_b) * yb).astype(x.dtype)
    x = x + mixed @ w_out
    x = x + peer_ffn(rms_norm(x, norm_ffn), w_query, sub_keys, expert_u, expert_v)
    return x


def setup_inputs(seed: int = 0) -> dict:
    key = jax.random.key(seed)
    ks = jax.random.split(key, 24)
    f32 = jnp.float32

    def nrm(k, shape, sc):
        return jax.random.normal(k, shape, f32) * sc

    L = DEPTH
    dt = jnp.exp(jax.random.uniform(ks[5], (L, GDN_HEADS), f32, math.log(1e-3), math.log(1e-1)))
    return {
        'x': nrm(ks[0], (BATCH, SEQ, D_MODEL), 1.0),
        'rel_bias': nrm(ks[1], (REL_BUCKETS, NSA_HEADS), 0.5),
        'norm_final': 1.0 + nrm(ks[2], (D_MODEL,), 0.1),
        'norm_mix': 1.0 + nrm(ks[3], (L, D_MODEL), 0.1),
        'w_in': nrm(ks[4], (L, D_MODEL, N_IN), D_MODEL ** -0.5),
        'conv_w': nrm(ks[6], (L, GDN_CONV, GDN_QKV_W), GDN_CONV ** -0.5),
        'a_log': jnp.log(jax.random.uniform(ks[7], (L, GDN_HEADS), f32, 1.0, 16.0)),
        'dt_bias': dt + jnp.log(-jnp.expm1(-dt)),
        'gdn_norm': 1.0 + nrm(ks[8], (L, GDN_DV), 0.1),
        'cmp_pe_k': nrm(ks[9], (L, CMP_BLOCK, NSA_DH), 0.5),
        'cmp_pe_v': nrm(ks[10], (L, CMP_BLOCK, NSA_DH), 0.5),
        'cmp_w_k': nrm(ks[11], (L, CMP_BLOCK, NSA_DH, NSA_DH), (CMP_BLOCK * NSA_DH) ** -0.5),
        'cmp_w_v': nrm(ks[12], (L, CMP_BLOCK, NSA_DH, NSA_DH), (CMP_BLOCK * NSA_DH) ** -0.5),
        'w_branch_a': nrm(ks[13], (L, GDN_HEADS * GDN_DV, D_MODEL), (GDN_HEADS * GDN_DV) ** -0.5),
        'w_branch_b': nrm(ks[14], (L, NSA_HEADS * NSA_DH, D_MODEL), (NSA_HEADS * NSA_DH) ** -0.5),
        'w_out': nrm(ks[15], (L, D_MODEL, D_MODEL), D_MODEL ** -0.5),
        'norm_ffn': 1.0 + nrm(ks[16], (L, D_MODEL), 0.1),
        'w_query': nrm(ks[17], (L, D_MODEL, PEER_HEADS * PEER_DQ), D_MODEL ** -0.5),
        'sub_keys': nrm(ks[18], (L, PEER_HEADS, 2, PEER_NKEYS, PEER_DQH), PEER_DQH ** -0.5),
        'expert_u': nrm(ks[19], (L, PEER_N_EXPERTS, D_MODEL), D_MODEL ** -0.5),
        'expert_v': nrm(ks[20], (L, PEER_N_EXPERTS, D_MODEL), 0.5),
    }


def reference(x, rel_bias, norm_final, norm_mix, w_in, conv_w, a_log, dt_bias, gdn_norm, cmp_pe_k,
              cmp_pe_v, cmp_w_k, cmp_w_v, w_branch_a, w_branch_b, w_out, norm_ffn, w_query, sub_keys,
              expert_u, expert_v):
    for layer in range(DEPTH):
        x = hybrid_layer(x, rel_bias, norm_mix[layer], w_in[layer], conv_w[layer], a_log[layer],
                         dt_bias[layer], gdn_norm[layer], cmp_pe_k[layer], cmp_pe_v[layer],
                         cmp_w_k[layer], cmp_w_v[layer], w_branch_a[layer], w_branch_b[layer],
                         w_out[layer], norm_ffn[layer], w_query[layer], sub_keys[layer],
                         expert_u[layer], expert_v[layer])
    return rms_norm(x, norm_final)
```

```cpp
#include <hip/hip_runtime.h>
#include <hip/hip_cooperative_groups.h>
#include <stdint.h>
namespace cg = cooperative_groups;

#define DI __device__ __forceinline__
#ifndef DBG_NAIVE_GDN
#define DBG_NAIVE_GDN 0
#endif
#ifndef DBG_NAIVE_PEER
#define DBG_NAIVE_PEER 0
#endif
#ifndef DBG_P11
#define DBG_P11 2
#endif
typedef unsigned short u16;
typedef __attribute__((ext_vector_type(8))) short bf16x8;
typedef __attribute__((ext_vector_type(16))) float f32x16;
typedef __attribute__((ext_vector_type(4))) float f32x4;
typedef __attribute__((ext_vector_type(4))) unsigned u32x4;
typedef __attribute__((ext_vector_type(2))) unsigned u32x2;
typedef __attribute__((ext_vector_type(2))) __bf16 bf16x2v;

constexpr int BATCH = 8, SEQ = 4096, DM = 1024, NTOK = BATCH * SEQ;
constexpr int NIN = 5416, NP = 5504;
constexpr int NTHREADS = 256;
constexpr int SMEM_BYTES = 72 * 1024;
constexpr float L2E = 1.4426950408889634f;

constexpr size_t AL(size_t x) { return (x + 255) & ~(size_t)255; }
constexpr size_t OFF_WINT = 0;
constexpr size_t OFF_WAT = OFF_WINT + AL((size_t)NP * 1024 * 2);
constexpr size_t OFF_WBT = OFF_WAT + AL((size_t)1024 * 512 * 2);
constexpr size_t OFF_WOT = OFF_WBT + AL((size_t)1024 * 512 * 2);
constexpr size_t OFF_WQT = OFF_WOT + AL((size_t)1024 * 1024 * 2);
constexpr size_t OFF_SK = OFF_WQT + AL((size_t)2048 * 1024 * 2);
constexpr size_t OFF_WKT = OFF_SK + AL((size_t)16 * 128 * 128 * 2);
constexpr size_t OFF_WVT = OFF_WKT + AL((size_t)128 * 2048 * 2);
constexpr size_t OFF_EU = OFF_WVT + AL((size_t)128 * 2048 * 2);
constexpr size_t OFF_EV = OFF_EU + AL((size_t)16384 * 1024 * 2);
constexpr size_t OFF_MISC = OFF_EV + AL((size_t)16384 * 1024 * 2);
constexpr size_t MISC_CK = 0, MISC_CV = 256, MISC_BIAS = 512, MISC_CNT = 512 + 8 * 132 * 4 + 256, MISC_GL = 8192;
constexpr size_t OFF_RH = OFF_MISC + 65536;
constexpr size_t OFF_QKV = OFF_RH + (size_t)NTOK * 1024 * 2;
constexpr size_t OFF_Z = OFF_QKV + (size_t)NTOK * 1536 * 2;
constexpr size_t OFF_NQ = OFF_Z + (size_t)NTOK * 512 * 2;
constexpr size_t OFF_NKV = OFF_NQ + (size_t)NTOK * 512 * 2;
constexpr size_t OFF_MG = OFF_NKV + (size_t)NTOK * 768 * 2;
constexpr size_t OFF_SM = OFF_MG + (size_t)NTOK * 2048 * 2;
constexpr size_t OFF_VST = OFF_SM + AL((size_t)NTOK * 40 * 4);
constexpr size_t OFF_VWT = OFF_VST + (size_t)16 * 64 * 4096 * 2;
constexpr size_t OFF_KC = OFF_VWT + (size_t)16 * 64 * 4096 * 2;
constexpr size_t OFF_VCT = OFF_KC + (size_t)16 * 256 * 64 * 2;
constexpr size_t WS_NEEDED = OFF_VCT + (size_t)16 * 64 * 256 * 2;

struct Params {
  const float *x, *rel_bias, *norm_final, *norm_mix, *w_in, *conv_w, *a_log, *dt_bias, *gdn_norm, *cmp_pe_k, *cmp_pe_v,
      *cmp_w_k, *cmp_w_v, *w_a, *w_b, *w_out, *norm_ffn, *w_query, *sub_keys, *expert_u, *expert_v;
  float* out;
  char* ws;
};

DI u16 f2bf(float x) { return __builtin_bit_cast(u16, (__bf16)x); }
DI float bf2f(u16 b) { return __uint_as_float(((unsigned)b) << 16); }
DI unsigned pack2(float lo, float hi) { return (unsigned)f2bf(lo) | ((unsigned)f2bf(hi) << 16); }
DI float bflo(unsigned u) { return __uint_as_float(u << 16); }
DI float bfhi(unsigned u) { return __uint_as_float(u & 0xffff0000u); }
DI float wave_sum(float v) {
#pragma unroll
  for (int o = 32; o >= 1; o >>= 1) v += __shfl_xor(v, o);
  return v;
}
DI int opaque0() { int z = 0; asm volatile("" : "+v"(z)); return z; }
DI float sigmoidf_(float x) { return 1.f / (1.f + __expf(-x)); }
DI f32x16 mfma32(bf16x8 a, bf16x8 b, f32x16 c) { return __builtin_amdgcn_mfma_f32_32x32x16_bf16(a, b, c, 0, 0, 0); }
DI f32x4 mfma16(bf16x8 a, bf16x8 b, f32x4 c) { return __builtin_amdgcn_mfma_f32_16x16x32_bf16(a, b, c, 0, 0, 0); }
DI int swz(int row, int ch) { return row * 128 + ((ch ^ ((row >> 1) & 7)) << 4); }
DI bf16x8 lds_frag(const char* tile, int row, int ch) { return *(const bf16x8*)(tile + swz(row, ch)); }
DI bf16x8 pad_frag(const char* tile, int row, int ch) { return *(const bf16x8*)(tile + row * 144 + ch * 16); }
DI bf16x8 pack8(float a0, float a1, float a2, float a3, float a4, float a5, float a6, float a7) {
  u32x4 p;
  p[0] = pack2(a0, a1); p[1] = pack2(a2, a3); p[2] = pack2(a4, a5); p[3] = pack2(a6, a7);
  return __builtin_bit_cast(bf16x8, p);
}
DI int perm16(int o) { return (o & ~12) | ((o & 4) << 1) | ((o & 8) >> 1); }

DI int win_colmap(int n) {
  if (n < 2048) return n;
  if (n < 2560) return n - 2048 + 2064;
  if (n < 3328) return n - 2560 + 2576;
  if (n < 5376) return n - 3328 + 3368;
  if (n < 5392) return n - 5376 + 2048;
  if (n < 5416) return n - 5392 + 3344;
  return -1;
}
template <int MAPMODE>
DI void tconv_tile(const float* __restrict__ src, int K, int N, u16* __restrict__ dst, int kt, int nt, char* smem) {
  float* tile = (float*)smem;
  const int tid = threadIdx.x;
  const int nl = tid & 63, k0 = kt * 64, n0 = nt * 64;
  int col;
  if (MAPMODE == 1) col = win_colmap(n0 + nl); else col = (n0 + nl < N) ? (n0 + nl) : -1;
#pragma unroll 4
  for (int i = 0; i < 16; ++i) {
    int kl = (tid >> 6) + 4 * i;
    float v = (col >= 0) ? src[(size_t)(k0 + kl) * N + col] : 0.f;
    tile[kl * 65 + nl] = v;
  }
  __syncthreads();
  {
    const int n2 = tid >> 2, kp = tid & 3;
    u32x4 o0, o1;
#pragma unroll
    for (int i = 0; i < 4; ++i) {
      o0[i] = pack2(tile[(kp * 16 + 2 * i) * 65 + n2], tile[(kp * 16 + 2 * i + 1) * 65 + n2]);
      o1[i] = pack2(tile[(kp * 16 + 8 + 2 * i) * 65 + n2], tile[(kp * 16 + 8 + 2 * i + 1) * 65 + n2]);
    }
    u16* d = dst + (size_t)(n0 + n2) * K + k0 + kp * 16;
    *(u32x4*)d = o0;
    *(u32x4*)(d + 8) = o1;
  }
  __syncthreads();
}

DI void convert_flat(const float* __restrict__ src, u16* __restrict__ dst, size_t n, int bid, int nblk) {
  size_t nv = n / 8;
  for (size_t i = (size_t)bid * NTHREADS + threadIdx.x; i < nv; i += (size_t)nblk * NTHREADS) {
    f32x4 a = ((const f32x4*)src)[2 * i], b = ((const f32x4*)src)[2 * i + 1];
    u32x4 o;
    o[0] = pack2(a[0], a[1]); o[1] = pack2(a[2], a[3]); o[2] = pack2(b[0], b[1]); o[3] = pack2(b[2], b[3]);
    ((u32x4*)dst)[i] = o;
  }
}

DI void rmsnorm_rows_bf16(const float* __restrict__ src, const float* __restrict__ w, u16* __restrict__ dst, int nrows, int bid, int nblk) {
  const int lane = threadIdx.x & 63, wv = threadIdx.x >> 6;
  f32x4 wr[4];
#pragma unroll
  for (int i = 0; i < 4; ++i) wr[i] = ((const f32x4*)w)[lane + 64 * i];
  for (int row = bid * 4 + wv; row < nrows; row += nblk * 4) {
    const f32x4* s = (const f32x4*)(src + (size_t)row * 1024);
    f32x4 v[4];
    float ss = 0.f;
#pragma unroll
    for (int i = 0; i < 4; ++i) { v[i] = s[lane + 64 * i]; ss += v[i][0] * v[i][0] + v[i][1] * v[i][1] + v[i][2] * v[i][2] + v[i][3] * v[i][3]; }
    ss = wave_sum(ss);
    float rs = rsqrtf(ss * (1.f / 1024.f) + 1e-6f);
#pragma unroll
    for (int i = 0; i < 4; ++i) {
      u32x2 o;
      o[0] = pack2(v[i][0] * rs * wr[i][0], v[i][1] * rs * wr[i][1]);
      o[1] = pack2(v[i][2] * rs * wr[i][2], v[i][3] * rs * wr[i][3]);
      *(u32x2*)(dst + (size_t)row * 1024 + (lane + 64 * i) * 4) = o;
    }
  }
}

DI int t5_bucket(int d) {
  if (d < 16) return d < 0 ? 0 : d;
  const int th[16] = {16, 19, 21, 24, 27, 31, 35, 40, 46, 52, 59, 67, 77, 87, 99, 113};
  int b = 16;
#pragma unroll
  for (int k = 1; k < 16; ++k) b += (d >= th[k]) ? 1 : 0;
  return b;
}

DI void phase0(const Params& p, int bid, int nblk, char* smem) {
  char* ws = p.ws;
  const int n_win = 16 * 86, n_wa = 8 * 16, n_wo = 16 * 16, n_wq = 16 * 32, n_wc = 32 * 2;
  const int total = n_win + 2 * n_wa + n_wo + n_wq + 2 * n_wc;
  for (int it = bid; it < total; it += nblk) {
    int i = it;
    if (i < n_win) { tconv_tile<1>(p.w_in, 1024, NIN, (u16*)(ws + OFF_WINT), i / 86, i % 86, smem); continue; }
    i -= n_win;
    if (i < n_wa) { tconv_tile<0>(p.w_a, 512, 1024, (u16*)(ws + OFF_WAT), i / 16, i % 16, smem); continue; }
    i -= n_wa;
    if (i < n_wa) { tconv_tile<0>(p.w_b, 512, 1024, (u16*)(ws + OFF_WBT), i / 16, i % 16, smem); continue; }
    i -= n_wa;
    if (i < n_wo) { tconv_tile<0>(p.w_out, 1024, 1024, (u16*)(ws + OFF_WOT), i / 16, i % 16, smem); continue; }
    i -= n_wo;
    if (i < n_wq) { tconv_tile<0>(p.w_query, 1024, 2048, (u16*)(ws + OFF_WQT), i / 32, i % 32, smem); continue; }
    i -= n_wq;
    if (i < n_wc) { tconv_tile<0>(p.cmp_w_k, 2048, 64, (u16*)(ws + OFF_WKT), i / 2, i % 2, smem); continue; }
    i -= n_wc;
    tconv_tile<0>(p.cmp_w_v, 2048, 64, (u16*)(ws + OFF_WVT), i / 2, i % 2, smem);
  }
  convert_flat(p.sub_keys, (u16*)(ws + OFF_SK), (size_t)16 * 128 * 128, bid, nblk);
#if !DBG_NAIVE_GDN
  convert_flat(p.expert_u, (u16*)(ws + OFF_EU), (size_t)16384 * 1024, bid, nblk);
  convert_flat(p.expert_v, (u16*)(ws + OFF_EV), (size_t)16384 * 1024, bid, nblk);
#endif
  rmsnorm_rows_bf16(p.x, p.norm_mix, (u16*)(ws + OFF_RH), NTOK, bid, nblk);
  const int tid = threadIdx.x;
  if (bid == nblk - 1) {
    float* ck = (float*)(ws + OFF_MISC + MISC_CK);
    float* cv = (float*)(ws + OFF_MISC + MISC_CV);
    if (tid < 128) {
      const int e = tid & 63;
      const float* pe = (tid < 64) ? p.cmp_pe_k : p.cmp_pe_v;
      const float* W = (tid < 64) ? p.cmp_w_k : p.cmp_w_v;
      float s = 0.f;
      for (int k = 0; k < 2048; ++k) s += pe[k] * W[(size_t)k * 64 + e];
      if (tid < 64) ck[e] = s; else cv[e] = s;
    }
  }
  if (bid == nblk - 2 || nblk == 1) {
    float* bt = (float*)(ws + OFF_MISC + MISC_BIAS);
    for (int i = tid; i < 8 * 132; i += NTHREADS) {
      int hd = i / 132, d = i % 132;
      bt[i] = p.rel_bias[t5_bucket(d) * 8 + hd] * L2E;
    }
    if (tid < 16) ((unsigned*)(ws + OFF_MISC + MISC_CNT))[tid] = 0u;
  }
}

struct GemmPtrs {
  const u16* a[4];
  const u16* b[4];
  long aks, bks;
};

DI void gemm_kloop(f32x16 (&acc)[2][2], const GemmPtrs& g, int nkt, char* smem) {
  const int tid = threadIdx.x, lane = tid & 63, w = tid >> 6, wm = w >> 1, wn = w & 1, r = lane & 31, h = lane >> 5;
  const int lrow = tid >> 3, lch = tid & 7;
  u32x4 ra[4], rb[4];
#pragma unroll
  for (int i = 0; i < 4; ++i) { ra[i] = *(const u32x4*)(g.a[i]); rb[i] = *(const u32x4*)(g.b[i]); }
#pragma unroll
  for (int i = 0; i < 4; ++i) {
    *(u32x4*)(smem + swz(lrow + 32 * i, lch)) = ra[i];
    *(u32x4*)(smem + 16384 + swz(lrow + 32 * i, lch)) = rb[i];
  }
  __syncthreads();
  for (int kt = 0; kt < nkt; ++kt) {
    const char* A = smem + (kt & 1) * 32768;
    const char* B = A + 16384;
    const bool more = (kt + 1 < nkt);
    if (more) {
#pragma unroll
      for (int i = 0; i < 4; ++i) {
        ra[i] = *(const u32x4*)(g.a[i] + (long)(kt + 1) * g.aks);
        rb[i] = *(const u32x4*)(g.b[i] + (long)(kt + 1) * g.bks);
      }
    }
#pragma unroll
    for (int s = 0; s < 4; ++s) {
      bf16x8 a0 = lds_frag(A, wm * 64 + r, 2 * s + h);
      bf16x8 a1 = lds_frag(A, wm * 64 + 32 + r, 2 * s + h);
      bf16x8 b0 = lds_frag(B, wn * 64 + r, 2 * s + h);
      bf16x8 b1 = lds_frag(B, wn * 64 + 32 + r, 2 * s + h);
      acc[0][0] = mfma32(a0, b0, acc[0][0]);
      acc[0][1] = mfma32(a0, b1, acc[0][1]);
      acc[1][0] = mfma32(a1, b0, acc[1][0]);
      acc[1][1] = mfma32(a1, b1, acc[1][1]);
    }
    if (more) {
      char* A2 = smem + ((kt + 1) & 1) * 32768;
#pragma unroll
      for (int i = 0; i < 4; ++i) {
        *(u32x4*)(A2 + swz(lrow + 32 * i, lch)) = ra[i];
        *(u32x4*)(A2 + 16384 + swz(lrow + 32 * i, lch)) = rb[i];
      }
    }
    __syncthreads();
  }
}

DI void zero_acc(f32x16 (&acc)[2][2]) {
#pragma unroll
  for (int i = 0; i < 2; ++i)
#pragma unroll
    for (int j = 0; j < 2; ++j)
#pragma unroll
      for (int k = 0; k < 16; ++k) acc[i][j][k] = 0.f;
}
DI void gemm_setup(GemmPtrs& g, const u16* A, long lda, int m0, const u16* Bt, long ldb, int n0) {
  const int lrow = threadIdx.x >> 3, lch = threadIdx.x & 7;
#pragma unroll
  for (int i = 0; i < 4; ++i) {
    g.a[i] = A + (size_t)(m0 + lrow + 32 * i) * lda + lch * 8;
    g.b[i] = Bt + (size_t)(n0 + lrow + 32 * i) * ldb + lch * 8;
  }
  g.aks = 64; g.bks = 64;
}
template <class F>
DI void gemm_epilogue(const f32x16 (&acc)[2][2], F f) {
  const int lane = threadIdx.x & 63, w = threadIdx.x >> 6, wm = w >> 1, wn = w & 1, r = lane & 31, h = lane >> 5;
#pragma unroll
  for (int i = 0; i < 2; ++i)
#pragma unroll
    for (int j = 0; j < 2; ++j) {
#pragma unroll
      for (int k = 0; k < 16; ++k) f(wm * 64 + i * 32 + (k & 3) + 8 * (k >> 2) + 4 * h, wn * 64 + j * 32 + r, acc[i][j][k]);
      asm volatile("" ::: "memory");
    }
}

template <class F>
DI void gemm_epilogue_lds(const f32x16 (&acc)[2][2], char* smem, F f) {
  float* T = (float*)smem;
  {
    const int lane = threadIdx.x & 63, w = threadIdx.x >> 6, wm = w >> 1, wn = w & 1, r = lane & 31, h = lane >> 5;
#pragma unroll
    for (int i = 0; i < 2; ++i)
#pragma unroll
      for (int j = 0; j < 2; ++j)
#pragma unroll
        for (int k = 0; k < 16; ++k) T[(wm * 64 + i * 32 + (k & 3) + 8 * (k >> 2) + 4 * h) * 132 + wn * 64 + j * 32 + r] = acc[i][j][k];
  }
  __syncthreads();
  const int c8 = (threadIdx.x & 15) * 8, r0 = threadIdx.x >> 4;
#pragma unroll 2
  for (int it = 0; it < 8; ++it) {
    const int row = r0 + 16 * it;
    const f32x4 a = *(const f32x4*)(T + row * 132 + c8), b = *(const f32x4*)(T + row * 132 + c8 + 4);
    const float v[8] = {a[0], a[1], a[2], a[3], b[0], b[1], b[2], b[3]};
    f(row, c8, v);
  }
  __syncthreads();
}
DI u32x4 pack8u(const float (&v)[8]) { u32x4 o; o[0] = pack2(v[0], v[1]); o[1] = pack2(v[2], v[3]); o[2] = pack2(v[4], v[5]); o[3] = pack2(v[6], v[7]); return o; }

DI void phase_inproj(const Params& p, int bid, int nblk, char* smem) {
  char* ws = p.ws;
  const u16* H = (const u16*)(ws + OFF_RH);
  const u16* W = (const u16*)(ws + OFF_WINT);
  const int NT = NP / 128;
  for (int t = bid; t < 256 * NT; t += nblk) {
    const int mt = t / NT, nt = t % NT, m0 = mt * 128, n0 = nt * 128;
    GemmPtrs g;
    gemm_setup(g, H, 1024, m0, W, 1024, n0);
    f32x16 acc[2][2];
    zero_acc(acc);
    gemm_kloop(acc, g, 16, smem);
    if (n0 >= 5376) {
      float* SM = (float*)(ws + OFF_SM);
      gemm_epilogue_lds(acc, smem, [&](int ml, int nl, const float (&v)[8]) {
        if (nl < 40) {
          float* d = SM + (size_t)(m0 + ml) * 40 + nl;
          *(f32x4*)d = f32x4{v[0], v[1], v[2], v[3]};
          *(f32x4*)(d + 4) = f32x4{v[4], v[5], v[6], v[7]};
        }
      });
    } else {
      u16* dst; int ld, c0;
      if (n0 < 1536) { dst = (u16*)(ws + OFF_QKV); ld = 1536; c0 = n0; }
      else if (n0 < 2048) { dst = (u16*)(ws + OFF_Z); ld = 512; c0 = n0 - 1536; }
      else if (n0 < 2560) { dst = (u16*)(ws + OFF_NQ); ld = 512; c0 = n0 - 2048; }
      else if (n0 < 3328) { dst = (u16*)(ws + OFF_NKV); ld = 768; c0 = n0 - 2560; }
      else { dst = (u16*)(ws + OFF_MG); ld = 2048; c0 = n0 - 3328; }
      gemm_epilogue_lds(acc, smem, [&](int ml, int nl, const float (&v)[8]) { *(u32x4*)(dst + (size_t)(m0 + ml) * ld + c0 + nl) = pack8u(v); });
    }
  }
}

DI void vtrans_item(const Params& p, int item, char* smem) {
  char* ws = p.ws;
  const int tile = item & 63, bg = (item >> 6) & 15, which = item >> 10;
  const int b = bg >> 1, g = bg & 1;
  const u16* NKV = (const u16*)(ws + OFF_NKV);
  u16* VT = (u16*)(ws + (which ? OFF_VWT : OFF_VST)) + (size_t)bg * 64 * 4096;
  const int col0 = (which ? 640 : 384) + g * 64;
  u16* t = (u16*)smem;
  const int tid = threadIdx.x;
  {
#pragma unroll
    for (int i = 0; i < 2; ++i) {
      int c = tid + 256 * i, row = c >> 3, ch = c & 7;
      u32x4 v = *(const u32x4*)(NKV + (size_t)(b * SEQ + tile * 64 + row) * 768 + col0 + ch * 8);
      *(u32x4*)(t + row * 72 + ch * 8) = v;
    }
  }
  __syncthreads();
  {
    const int d = tid >> 2, part = tid & 3;
    u32x4 o0, o1;
    u16 vals[16];
#pragma unroll
    for (int pp = 0; pp < 16; ++pp) vals[pp] = t[(part * 16 + perm16(pp)) * 72 + d];
#pragma unroll
    for (int i = 0; i < 4; ++i) {
      o0[i] = (unsigned)vals[2 * i] | ((unsigned)vals[2 * i + 1] << 16);
      o1[i] = (unsigned)vals[8 + 2 * i] | ((unsigned)vals[8 + 2 * i + 1] << 16);
    }
    u16* dst = VT + (size_t)d * 4096 + tile * 64 + part * 16;
    *(u32x4*)dst = o0;
    *(u32x4*)(dst + 8) = o1;
  }
  __syncthreads();
}

DI void cmp_gemm_item(const Params& p, int item, char* smem) {
  char* ws = p.ws;
  const int which = item >> 5, mt = item & 31, m0 = mt * 128;
  const u16* NKV = (const u16*)(ws + OFF_NKV);
  const u16* Wt = (const u16*)(ws + (which ? OFF_WVT : OFF_WKT));
  GemmPtrs g;
  const int lrow = threadIdx.x >> 3, lch = threadIdx.x & 7;
#pragma unroll
  for (int i = 0; i < 4; ++i) {
    int m = m0 + lrow + 32 * i, bg = m >> 8, n = m & 255;
    if (n > 254) n = 254;
    g.a[i] = NKV + (size_t)((bg >> 1) * SEQ + 16 * n) * 768 + which * 128 + (bg & 1) * 64 + lch * 8;
    g.b[i] = Wt + (size_t)(lrow + 32 * i) * 2048 + lch * 8;
  }
  g.aks = 768; g.bks = 64;
  f32x16 acc[2][2];
  zero_acc(acc);
  gemm_kloop(acc, g, 32, smem);
  const float* cc = (const float*)(ws + OFF_MISC + (which ? MISC_CV : MISC_CK));
  if (which == 0) {
    u16* KC = (u16*)(ws + OFF_KC);
    gemm_epilogue_lds(acc, smem, [&](int ml, int nl, const float (&v)[8]) {
      if (nl < 64) {
        float t[8];
#pragma unroll
        for (int e = 0; e < 8; ++e) t[e] = v[e] + cc[nl + e];
        *(u32x4*)(KC + (size_t)(m0 + ml) * 64 + nl) = pack8u(t);
      }
    });
  } else {
    u16* VCT = (u16*)(ws + OFF_VCT);
    gemm_epilogue_lds(acc, smem, [&](int ml, int nl, const float (&v)[8]) {
      if (nl < 64) {
        const int m = m0 + ml, bg = m >> 8, n = m & 255;
        u16* d = VCT + ((size_t)bg * 64 + nl) * 256 + (n & ~15) + perm16(n & 15);
#pragma unroll
        for (int e = 0; e < 8; ++e) d[e * 256] = f2bf(v[e] + cc[nl + e]);
      }
    });
  }
}

DI void gdn_store_frag(u16* dst, const char* tile, int idx  , float scale_is_row, const float* rowscale) {
  const int blk = idx >> 6, lane = idx & 63, rt = blk >> 1, ks = blk & 1, r = lane & 15, q = lane >> 4;
  const int row = 16 * rt + r;
  const int k0 = 32 * ks + 4 * q, k1 = k0 + 16;
  u32x2 lo = *(const u32x2*)(tile + swz(row, k0 >> 3) + (k0 & 7) * 2);
  u32x2 hi = *(const u32x2*)(tile + swz(row, k1 >> 3) + (k1 & 7) * 2);
  u32x4 o;
  if (rowscale) {
    float s = rowscale[row];
    o[0] = pack2(bflo(lo[0]) * s, bfhi(lo[0]) * s); o[1] = pack2(bflo(lo[1]) * s, bfhi(lo[1]) * s);
    o[2] = pack2(bflo(hi[0]) * s, bfhi(hi[0]) * s); o[3] = pack2(bflo(hi[1]) * s, bfhi(hi[1]) * s);
  } else { o[0] = lo[0]; o[1] = lo[1]; o[2] = hi[0]; o[3] = hi[1]; }
  *(u32x4*)(dst + (size_t)idx * 8) = o;
}

DI void gdn_chunk_item(const Params& p, int item, char* smem) {
  char* ws = p.ws;
  const int n = item & 63, bh = item >> 6, b = bh >> 3, hd = bh & 7;
  const int tid = threadIdx.x + opaque0(), lane = tid & 63, w = tid >> 6;
  char* Cq = smem;
  char* Ck = smem + 8192;
  char* Cv = smem + 16384;
  float* Am = (float*)(smem + 24576);
  char* ATT = smem + 40960;
  char* Wt = smem + 49152;
  float* gc = (float*)(smem + 57344);
  float* bet = gc + 64;
  float* eg = gc + 128;
  float* ekd = gc + 192;
  const u16* QKV = (const u16*)(ws + OFF_QKV);
  const size_t tok0 = (size_t)b * SEQ + n * 64;
  {
    const int ch = tid & 63, tg = tid >> 6;
#pragma unroll
    for (int part = 0; part < 3; ++part) {
      const int col = part * 512 + hd * 64 + ch;
      const float w0 = p.conv_w[col], w1 = p.conv_w[1536 + col], w2 = p.conv_w[3072 + col], w3 = p.conv_w[4608 + col];
      const int s0 = n * 64 + tg * 16;
      const u16* src = QKV + ((size_t)b * SEQ) * 1536 + col;
      float x0 = (s0 - 3 >= 0) ? bf2f(src[(size_t)(s0 - 3) * 1536]) : 0.f;
      float x1 = (s0 - 2 >= 0) ? bf2f(src[(size_t)(s0 - 2) * 1536]) : 0.f;
      float x2 = (s0 - 1 >= 0) ? bf2f(src[(size_t)(s0 - 1) * 1536]) : 0.f;
      char* C = smem + part * 8192;
#pragma unroll 4
      for (int i = 0; i < 16; ++i) {
        float x3 = bf2f(src[(size_t)(s0 + i) * 1536]);
        float y = w0 * x0 + w1 * x1 + w2 * x2 + w3 * x3;
        y = y / (1.f + __expf(-y));
        int tok = tg * 16 + i;
        *(u16*)(C + swz(tok, ch >> 3) + (ch & 7) * 2) = f2bf(y);
        x0 = x1; x1 = x2; x2 = x3;
      }
    }
  }
  if (w == 0) {
    const float* SM = (const float*)(ws + OFF_SM);
    float bi = SM[(tok0 + lane) * 40 + hd], ai = SM[(tok0 + lane) * 40 + 8 + hd];
    float xs = ai + p.dt_bias[hd];
    float sp = (xs > 20.f) ? xs : log1pf(__expf(xs));
    float gv = -__expf(p.a_log[hd]) * sp;
#pragma unroll
    for (int o = 1; o < 64; o <<= 1) { float t = __shfl_up(gv, o); if (lane >= o) gv += t; }
    float glast = __shfl(gv, 63);
    gc[lane] = gv; bet[lane] = sigmoidf_(bi); eg[lane] = __expf(gv); ekd[lane] = __expf(glast - gv);
    if (lane == 63) ((float*)(ws + OFF_MISC + MISC_GL))[item] = __expf(gv);
  }
  __syncthreads();
  if (tid < 128) {
    char* C = (tid < 64) ? Cq : Ck;
    const int row = tid & 63;
    u32x4 v[8];
    float ss = 0.f;
#pragma unroll
    for (int c = 0; c < 8; ++c) {
      v[c] = *(const u32x4*)(C + swz(row, c));
#pragma unroll
      for (int e = 0; e < 4; ++e) { float a = bflo(v[c][e]), bb = bfhi(v[c][e]); ss += a * a + bb * bb; }
    }
    float rs = rsqrtf(ss + 1e-6f) * ((tid < 64) ? 0.125f : 1.f);
#pragma unroll
    for (int c = 0; c < 8; ++c) {
      u32x4 o;
#pragma unroll
      for (int e = 0; e < 4; ++e) o[e] = pack2(bflo(v[c][e]) * rs, bfhi(v[c][e]) * rs);
      *(u32x4*)(C + swz(row, c)) = o;
    }
  }
  __syncthreads();
  {
    const int qa = w >> 1, qb = w & 1, r = lane & 31, h = lane >> 5;
    f32x16 akk, aqk;
#pragma unroll
    for (int k = 0; k < 16; ++k) { akk[k] = 0.f; aqk[k] = 0.f; }
    if (!(qa == 0 && qb == 1)) {
#pragma unroll
      for (int s = 0; s < 4; ++s) {
        bf16x8 ak = lds_frag(Ck, 32 * qa + r, 2 * s + h);
        bf16x8 aq = lds_frag(Cq, 32 * qa + r, 2 * s + h);
        bf16x8 bk = lds_frag(Ck, 32 * qb + r, 2 * s + h);
        akk = mfma32(ak, bk, akk);
        aqk = mfma32(aq, bk, aqk);
      }
    }
    const int j = 32 * qb + r;
    const float gj = gc[j];
#pragma unroll
    for (int k = 0; k < 16; ++k) {
      const int i = 32 * qa + (k & 3) + 8 * (k >> 2) + 4 * h;
      float dec = __expf(fminf(gc[i] - gj, 0.f));
      Am[i * 64 + j] = (j < i) ? akk[k] * bet[i] * dec : 0.f;
      *(u16*)(ATT + swz(i, j >> 3) + (j & 7) * 2) = f2bf((j <= i) ? aqk[k] * dec : 0.f);
    }
  }
  __syncthreads();
  u16* AMg = (u16*)p.out + (size_t)item * 16384;
  if (tid < 128) {
    const int c = tid;
    float x[64];
#pragma unroll
    for (int i = 0; i < 64; ++i) {
      const int dcol = c & 63;
      float rhs = bf2f(*(const u16*)(((c < 64) ? Cv : Ck) + swz(i, dcol >> 3) + (dcol & 7) * 2)) * bet[i] * ((c < 64) ? 1.f : eg[i]);
      float s0 = rhs, s1 = 0.f;
#pragma unroll
      for (int j4 = 0; j4 < (i + 3) / 4; ++j4) {
        f32x4 a = *(const f32x4*)(Am + i * 64 + j4 * 4);
#pragma unroll
        for (int e = 0; e < 4; ++e) {
          const int j = j4 * 4 + e;
          if (j < i) { if (e & 1) s1 -= a[e] * x[j]; else s0 -= a[e] * x[j]; }
        }
      }
      x[i] = s0 + s1;
      asm volatile("" : "+v"(x[i]) : : "memory");
    }
    if (c < 64) {
      float* U = (float*)(ws + OFF_RH) + ((size_t)item * 64 + c) * 64;
#pragma unroll
      for (int i = 0; i < 16; ++i) { f32x4 o = {x[4 * i], x[4 * i + 1], x[4 * i + 2], x[4 * i + 3]}; *(f32x4*)(U + 4 * i) = o; }
    } else {
      const int d = c - 64;
#pragma unroll
      for (int i = 0; i < 64; ++i) *(u16*)(Wt + swz(i, d >> 3) + (d & 7) * 2) = f2bf(x[i]);
    }
  } else {
    const int t2 = tid - 128;
#pragma unroll
    for (int i = 0; i < 4; ++i) {
      gdn_store_frag(AMg + 4096, Cq, t2 + 128 * i, 1.f, eg);
      gdn_store_frag(AMg + 8192, ATT, t2 + 128 * i, 0.f, nullptr);
    }
#pragma unroll
    for (int i = 0; i < 4; ++i) {
      const int idx = t2 + 128 * i, blk = idx >> 6, ln = idx & 63, rt = blk >> 1, ks = blk & 1, r = ln & 15, q = ln >> 4;
      const int d = 16 * rt + r;
      float vv[8];
#pragma unroll
      for (int j = 0; j < 8; ++j) {
        const int tk = 32 * ks + ((j < 4) ? (4 * q + j) : (16 + 4 * q + (j - 4)));
        vv[j] = bf2f(*(const u16*)(Ck + swz(tk, d >> 3) + (d & 7) * 2)) * ekd[tk];
      }
      *(bf16x8*)(AMg + 12288 + (size_t)idx * 8) = pack8(vv[0], vv[1], vv[2], vv[3], vv[4], vv[5], vv[6], vv[7]);
    }
  }
  __syncthreads();
#pragma unroll
  for (int i = 0; i < 2; ++i) gdn_store_frag(AMg, Wt, tid + 256 * i, 0.f, nullptr);
  __syncthreads();
}

DI void phase2(const Params& p, int bid, int nblk, char* smem) {
  const int total = 64 + 2048 + 4096;
  for (int it = bid; it < total; it += nblk) {
    if (it < 64) cmp_gemm_item(p, it, smem);
    else if (it < 2112) vtrans_item(p, it - 64, smem);
    else gdn_chunk_item(p, it - 2112, smem);
  }
}

DI void gdn_scan_item(const Params& p, int bh, char* smem) {
  char* ws = p.ws;
  const int tid = threadIdx.x, lane = tid & 63, w = tid >> 6, col = lane & 15, q = lane >> 4;
  const int b = bh >> 3, hd = bh & 7;
  const u16* AMg = (const u16*)p.out + (size_t)bh * 64 * 16384;
  const float* U = (const float*)(ws + OFF_RH) + (size_t)bh * 64 * 4096;
  const float* GL = (const float*)(ws + OFF_MISC + MISC_GL) + bh * 64;
  float* O = (float*)(ws + OFF_QKV);
  f32x4 S[4];
#pragma unroll
  for (int t = 0; t < 4; ++t) S[t] = f32x4{0.f, 0.f, 0.f, 0.f};
  u32x4 stg[8];
#pragma unroll
  for (int i = 0; i < 8; ++i) stg[i] = *(const u32x4*)(AMg + (size_t)(i * 256 + tid) * 8);
  f32x4 u[4];
#pragma unroll
  for (int ct = 0; ct < 4; ++ct) u[ct] = *(const f32x4*)(U + (size_t)(16 * w + col) * 64 + 16 * ct + 4 * q);
  float gl = GL[0];
  for (int n = 0; n < 64; ++n) {
    char* buf = smem + (n & 1) * 32768;
#pragma unroll
    for (int i = 0; i < 8; ++i) *(u32x4*)(buf + (i * 256 + tid) * 16) = stg[i];
    __syncthreads();
    f32x4 ucur[4];
#pragma unroll
    for (int ct = 0; ct < 4; ++ct) ucur[ct] = u[ct];
    const float glcur = gl;
    if (n + 1 < 64) {
      const u16* src = AMg + (size_t)(n + 1) * 16384;
#pragma unroll
      for (int i = 0; i < 8; ++i) stg[i] = *(const u32x4*)(src + (size_t)(i * 256 + tid) * 8);
      const float* un = U + (size_t)(n + 1) * 4096;
#pragma unroll
      for (int ct = 0; ct < 4; ++ct) u[ct] = *(const f32x4*)(un + (size_t)(16 * w + col) * 64 + 16 * ct + 4 * q);
      gl = GL[n + 1];
    }
    bf16x8 bS[2];
#pragma unroll
    for (int ks = 0; ks < 2; ++ks)
      bS[ks] = pack8(S[2 * ks][0], S[2 * ks][1], S[2 * ks][2], S[2 * ks][3], S[2 * ks + 1][0], S[2 * ks + 1][1], S[2 * ks + 1][2], S[2 * ks + 1][3]);
#define AFRAG(mat, rt, ks) (*(const bf16x8*)(buf + (mat) * 8192 + (((rt) * 2 + (ks)) * 64 + lane) * 16))
    f32x4 vn[4], o[4];
#pragma unroll
    for (int ct = 0; ct < 4; ++ct) {
      f32x4 a = f32x4{0.f, 0.f, 0.f, 0.f};
      a = mfma16(AFRAG(0, ct, 0), bS[0], a);
      a = mfma16(AFRAG(0, ct, 1), bS[1], a);
      vn[ct] = ucur[ct] - a;
      f32x4 oo = f32x4{0.f, 0.f, 0.f, 0.f};
      oo = mfma16(AFRAG(1, ct, 0), bS[0], oo);
      oo = mfma16(AFRAG(1, ct, 1), bS[1], oo);
      o[ct] = oo;
    }
    bf16x8 bV[2];
#pragma unroll
    for (int ks = 0; ks < 2; ++ks)
      bV[ks] = pack8(vn[2 * ks][0], vn[2 * ks][1], vn[2 * ks][2], vn[2 * ks][3], vn[2 * ks + 1][0], vn[2 * ks + 1][1], vn[2 * ks + 1][2], vn[2 * ks + 1][3]);
#pragma unroll
    for (int ct = 0; ct < 4; ++ct) {
      o[ct] = mfma16(AFRAG(2, ct, 0), bV[0], o[ct]);
      o[ct] = mfma16(AFRAG(2, ct, 1), bV[1], o[ct]);
      f32x4 sn = S[ct] * glcur;
      sn = mfma16(AFRAG(3, ct, 0), bV[0], sn);
      sn = mfma16(AFRAG(3, ct, 1), bV[1], sn);
      S[ct] = sn;
    }
#undef AFRAG
    float* od = O + ((size_t)b * SEQ + n * 64) * 512 + hd * 64 + 16 * w + col;
#pragma unroll
    for (int ct = 0; ct < 4; ++ct)
#pragma unroll
      for (int rg = 0; rg < 4; ++rg) od[(size_t)(16 * ct + 4 * q + rg) * 512] = o[ct][rg];
  }
  __syncthreads();
}

DI void phase_gdn_post(const Params& p, int bid, int nblk) {
  char* ws = p.ws;
  const float* O = (const float*)(ws + (DBG_NAIVE_GDN ? OFF_EU : OFF_QKV));
  const u16* Z = (const u16*)(ws + OFF_Z);
  u16* OA = (u16*)(ws + OFF_NQ);
  const int sub = threadIdx.x & 15;
  const f32x4 gw = ((const f32x4*)p.gdn_norm)[sub];
  const size_t ngrp = (size_t)NTOK * 8;
  for (size_t gi = ((size_t)bid * NTHREADS + threadIdx.x) >> 4; gi < ngrp; gi += ((size_t)nblk * NTHREADS) >> 4) {
    f32x4 v = *(const f32x4*)(O + gi * 64 + sub * 4);
    float ss = v[0] * v[0] + v[1] * v[1] + v[2] * v[2] + v[3] * v[3];
    ss += __shfl_xor(ss, 1); ss += __shfl_xor(ss, 2); ss += __shfl_xor(ss, 4); ss += __shfl_xor(ss, 8);
    float rs = rsqrtf(ss * (1.f / 64.f) + 1e-6f);
    u32x2 zz = *(const u32x2*)(Z + gi * 64 + sub * 4);
    float z0 = bflo(zz[0]), z1 = bfhi(zz[0]), z2 = bflo(zz[1]), z3 = bfhi(zz[1]);
    u32x2 o;
    o[0] = pack2(v[0] * rs * gw[0] * (z0 * sigmoidf_(z0)), v[1] * rs * gw[1] * (z1 * sigmoidf_(z1)));
    o[1] = pack2(v[2] * rs * gw[2] * (z2 * sigmoidf_(z2)), v[3] * rs * gw[3] * (z3 * sigmoidf_(z3)));
    *(u32x2*)(OA + gi * 64 + sub * 4) = o;
  }
}

constexpr int NSA_LDS_K = 0, NSA_LDS_V = 9216, NSA_LDS_BIAS = 18432, NSA_LDS_IMP = 18432 + 8 * 132 * 4;
constexpr int NSA_LDS_Q = NSA_LDS_IMP + 4 * 8 * 68 * 4;
constexpr float NEGBIG = -1e30f;
constexpr float QK_SCALE = 0.125f * L2E;

template <int MODE>
DI void nsa_tile(const char* Kt, const char* Vt, const char* Qw, f32x16 (&O)[2], float& m, float& l,
                 const int t, const int key0, const bool slow, const bool lane_sel, const float* tab,
                 const float mfin, const float linv, float* impw) {
  const int lane = threadIdx.x & 63, r = lane & 31, h = lane >> 5;
#pragma unroll
  for (int a = 0; a < 2; ++a) {
    f32x16 S;
#pragma unroll
    for (int k = 0; k < 16; ++k) S[k] = 0.f;
#pragma unroll
    for (int s = 0; s < 4; ++s) S = mfma32(pad_frag(Kt, 32 * a + r, 2 * s + h), *(const bf16x8*)(Qw + (s * 64 + lane) * 16), S);
    if (MODE < 2 || slow) {
#pragma unroll
      for (int k = 0; k < 16; ++k) {
        const int kl = 32 * a + (k & 3) + 8 * (k >> 2) + 4 * h;
        int dist;
        if (MODE < 2) dist = t - (16 * (key0 + kl) + 31); else dist = t - (key0 + kl);
        bool valid = (dist >= 0) && lane_sel;
        if (MODE == 3) valid = valid && (dist < 512);
        int di = dist < 0 ? 0 : (dist > 128 ? 128 : dist);
        float bias = tab[di];
        S[k] = valid ? fmaf(S[k], QK_SCALE, bias) : NEGBIG;
      }
    } else {
      const float c31 = tab[128];
#pragma unroll
      for (int k = 0; k < 16; ++k) S[k] = lane_sel ? fmaf(S[k], QK_SCALE, c31) : NEGBIG;
    }
    if (MODE == 1) {
#pragma unroll
      for (int k = 0; k < 16; ++k) S[k] = (S[k] > -1e29f) ? exp2f(S[k] - mfin) * linv : 0.f;
    } else {
      float mx = S[0];
#pragma unroll
      for (int k = 1; k < 16; ++k) mx = fmaxf(mx, S[k]);
      mx = fmaxf(mx, __shfl_xor(mx, 32));
      const float mn = fmaxf(m, mx);
      const float alpha = exp2f(m - mn);
      float ps = 0.f;
#pragma unroll
      for (int k = 0; k < 16; ++k) { S[k] = (S[k] > -1e29f) ? exp2f(S[k] - mn) : 0.f; ps += S[k]; }
      l = l * alpha + ps;
      m = mn;
      if (MODE != 0) {
#pragma unroll
        for (int dt = 0; dt < 2; ++dt)
#pragma unroll
          for (int k = 0; k < 16; ++k) O[dt][k] *= alpha;
      }
    }
    if (MODE == 1) {
#pragma unroll
      for (int g4 = 0; g4 < 4; ++g4) {
        float mainv = S[4 * g4] + S[4 * g4 + 1] + S[4 * g4 + 2] + 0.5f * S[4 * g4 + 3];
        float spill = 0.5f * S[4 * g4 + 3];
        mainv += __shfl_xor(mainv, 8); mainv += __shfl_xor(mainv, 16);
        spill += __shfl_xor(spill, 8); spill += __shfl_xor(spill, 16);
        const int blk = ((key0 + 32 * a) >> 2) + 2 * g4 + h;
        if (r < 8) impw[r * 68 + blk] += mainv;
        if (r < 8) impw[r * 68 + blk + 1] += spill;
      }
    }
    if (MODE != 0) {
      bf16x8 P0 = pack8(S[0], S[1], S[2], S[3], S[4], S[5], S[6], S[7]);
      bf16x8 P1 = pack8(S[8], S[9], S[10], S[11], S[12], S[13], S[14], S[15]);
#pragma unroll
      for (int dt = 0; dt < 2; ++dt) {
        O[dt] = mfma32(pad_frag(Vt, 32 * dt + r, 4 * a + h), P0, O[dt]);
        O[dt] = mfma32(pad_frag(Vt, 32 * dt + r, 4 * a + 2 + h), P1, O[dt]);
      }
    }
  }
}

struct NsaSrc { const u16* k; long kld; const u16* v; long vld; };

DI void nsa_item(const Params& p, const int bg, const int hq, char* smem) {
  char* ws = p.ws;
  const int tid = threadIdx.x, lane = tid & 63, w = tid >> 6, r = lane & 31, h = lane >> 5;
  const int b = bg >> 1, g = bg & 1, qi = hq >> 1;
  const int t = 32 * hq + 8 * w + (r & 7);
  const int head = g * 4 + (r >> 3);
  const size_t trow = (size_t)b * SEQ + t;
  char* Kt = smem + NSA_LDS_K;
  char* Vt = smem + NSA_LDS_V;
  float* biasl = (float*)(smem + NSA_LDS_BIAS);
  float* impw = (float*)(smem + NSA_LDS_IMP) + w * (8 * 68);
  char* Q = smem + NSA_LDS_Q + w * 4096;
  const u16* NKV = (const u16*)(ws + OFF_NKV);
  __syncthreads();
  for (int i = tid; i < 8 * 132; i += NTHREADS) biasl[i] = ((const float*)(ws + OFF_MISC + MISC_BIAS))[i];
  for (int i = lane; i < 8 * 68; i += 64) impw[i] = 0.f;
  {
    const u16* NQ = (const u16*)(ws + OFF_NQ);
#pragma unroll
    for (int s = 0; s < 4; ++s) *(bf16x8*)(Q + (s * 64 + lane) * 16) = *(const bf16x8*)(NQ + trow * 512 + head * 64 + 16 * s + 8 * h);
  }
  const float* tab = biasl + head * 132;
  __syncthreads();
  f32x16 O[2];
  float m, l, mfin = 0.f, linv = 0.f;
  u16* OB = (u16*)(ws + OFF_QKV + (size_t)NTOK * 512 * 4);
  auto reset = [&]() {
#pragma unroll
    for (int dt = 0; dt < 2; ++dt)
#pragma unroll
      for (int k = 0; k < 16; ++k) O[dt][k] = 0.f;
    m = NEGBIG; l = 0.f;
  };
  u32x4 sk[2], sv[2];
  auto stage_load = [&](const NsaSrc& s) {
#pragma unroll
    for (int i = 0; i < 2; ++i) {
      const int c = tid + 256 * i, row = c >> 3, ch = c & 7;
      sk[i] = *(const u32x4*)(s.k + (size_t)row * s.kld + ch * 8);
      sv[i] = *(const u32x4*)(s.v + (size_t)row * s.vld + ch * 8);
    }
  };
  auto stage_store = [&]() {
#pragma unroll
    for (int i = 0; i < 2; ++i) {
      const int c = tid + 256 * i, row = c >> 3, ch = c & 7;
      *(u32x4*)(Kt + row * 144 + ch * 16) = sk[i];
      *(u32x4*)(Vt + row * 144 + ch * 16) = sv[i];
    }
  };
  auto src_cmp = [&](int tt) { NsaSrc s; s.k = (const u16*)(ws + OFF_KC) + ((size_t)bg * 256 + 64 * tt) * 64; s.kld = 64;
                               s.v = (const u16*)(ws + OFF_VCT) + (size_t)bg * 64 * 256 + 64 * tt; s.vld = 256; return s; };
  auto src_slc = [&](int j) { NsaSrc s; s.k = NKV + ((size_t)b * SEQ + 64 * j) * 768 + 256 + g * 64; s.kld = 768;
                              s.v = (const u16*)(ws + OFF_VST) + (size_t)bg * 64 * 4096 + 64 * j; s.vld = 4096; return s; };
  auto src_win = [&](int j) { NsaSrc s; s.k = NKV + ((size_t)b * SEQ + 64 * j) * 768 + 512 + g * 64; s.kld = 768;
                              s.v = (const u16*)(ws + OFF_VWT) + (size_t)bg * 64 * 4096 + 64 * j; s.vld = 4096; return s; };
  auto gatev = [&](int br) { return sigmoidf_(((const float*)(ws + OFF_SM))[trow * 40 + 16 + head * 3 + br]); };
  auto emit = [&](const float wgt, bool first) {
#pragma unroll
    for (int dt = 0; dt < 2; ++dt)
#pragma unroll
      for (int g4 = 0; g4 < 4; ++g4) {
        u16* dst = OB + trow * 512 + head * 64 + 32 * dt + 8 * g4 + 4 * h;
        float v0 = O[dt][4 * g4] * wgt, v1 = O[dt][4 * g4 + 1] * wgt, v2 = O[dt][4 * g4 + 2] * wgt, v3 = O[dt][4 * g4 + 3] * wgt;
        if (!first) {
          u32x2 old = *(const u32x2*)dst;
          v0 += bflo(old[0]); v1 += bfhi(old[0]); v2 += bflo(old[1]); v3 += bfhi(old[1]);
        }
        u32x2 o; o[0] = pack2(v0, v1); o[1] = pack2(v2, v3);
        *(u32x2*)dst = o;
      }
  };

  const int ntc = (2 * hq + 1 + 63) >> 6;
  reset();
  stage_load(src_cmp(0));
  for (int tt = 0; tt < ntc; ++tt) {
    __syncthreads(); stage_store(); __syncthreads();
    if (tt + 1 < ntc) stage_load(src_cmp(tt + 1)); else stage_load(src_cmp(0));
    nsa_tile<0>(Kt, Vt, Q, O, m, l, t, 64 * tt, true, true, tab, mfin, linv, impw);
  }
  { float lt = l + __shfl_xor(l, 32); mfin = m; linv = lt > 0.f ? 1.f / lt : 0.f; }
  for (int tt = 0; tt < ntc; ++tt) {
    __syncthreads(); stage_store(); __syncthreads();
    if (tt + 1 < ntc) stage_load(src_cmp(tt + 1)); else stage_load(src_slc(0));
    nsa_tile<1>(Kt, Vt, Q, O, m, l, t, 64 * tt, true, true, tab, mfin, linv, impw);
  }
  emit(gatev(0), true);
  unsigned sel_lo, sel_hi;
  if (qi < 16) {
    unsigned long long mk = (2ull << qi) - 1ull;
    sel_lo = (unsigned)mk; sel_hi = (unsigned)(mk >> 32);
  } else {
    unsigned long long mk = 0ull;
    const float* row = impw + (lane & 7) * 68;
    const int part = lane >> 3, hiM = qi - 2;
    for (int mm = 1 + part; mm <= hiM; mm += 8) {
      const float v = row[mm];
      int rank = 0;
      for (int m2 = 1; m2 <= hiM; ++m2) { const float u = row[m2]; rank += ((u > v) || (u == v && m2 < mm)) ? 1 : 0; }
      if (rank < 13) mk |= 1ull << mm;
    }
    mk |= 1ull | (1ull << qi) | (1ull << (qi - 1));
    sel_lo = (unsigned)mk; sel_hi = (unsigned)(mk >> 32);
    sel_lo |= __shfl_xor(sel_lo, 8); sel_hi |= __shfl_xor(sel_hi, 8);
    sel_lo |= __shfl_xor(sel_lo, 16); sel_hi |= __shfl_xor(sel_hi, 16);
    sel_lo |= __shfl_xor(sel_lo, 32); sel_hi |= __shfl_xor(sel_hi, 32);
  }
  reset();
  for (int j = 0; j <= qi; ++j) {
    __syncthreads(); stage_store(); __syncthreads();
    if (j + 1 <= qi) stage_load(src_slc(j + 1)); else stage_load(src_win(qi >= 8 ? qi - 8 : 0));
    const bool lsel = ((j < 32 ? (sel_lo >> j) : (sel_hi >> (j - 32))) & 1u) != 0u;
    nsa_tile<2>(Kt, Vt, Q, O, m, l, t, 64 * j, (qi - j) <= 2, lsel, tab, mfin, linv, impw);
  }
  { float lt = l + __shfl_xor(l, 32); emit(lt > 0.f ? gatev(1) / lt : 0.f, false); }
  reset();
  const int j0 = qi >= 8 ? qi - 8 : 0;
  for (int j = j0; j <= qi; ++j) {
    __syncthreads(); stage_store(); __syncthreads();
    if (j + 1 <= qi) stage_load(src_win(j + 1));
    nsa_tile<3>(Kt, Vt, Q, O, m, l, t, 64 * j, ((qi - j) <= 2) || ((qi - j) == 8), true, tab, mfin, linv, impw);
  }
  { float lt = l + __shfl_xor(l, 32); emit(lt > 0.f ? gatev(2) / lt : 0.f, false); }
}

DI void phase4(const Params& p, char* smem) {
  unsigned* cnt = (unsigned*)(p.ws + OFF_MISC + MISC_CNT);
  __shared__ int s_item;
  for (;;) {
    __syncthreads();
    if (threadIdx.x == 0) s_item = (int)atomicAdd(cnt, 1u);
    __syncthreads();
    const int it = __builtin_amdgcn_readfirstlane(s_item);
    if (it >= 64 + 2048) break;
    if (it < 64) gdn_scan_item(p, it, smem);
    else { const int k = it - 64; nsa_item(p, k & 15, 127 - (k >> 4), smem); }
  }
}

DI void phase_branch(const Params& p, int bid, int nblk, char* smem) {
  char* ws = p.ws;
  const u16* OA = (const u16*)(ws + OFF_NQ);
  const u16* OB = (const u16*)(ws + OFF_QKV + (size_t)NTOK * 512 * 4);
  const u16* MG = (const u16*)(ws + OFF_MG);
  u16* MIX = (u16*)(ws + OFF_RH);
  for (int t = bid; t < 256 * 8; t += nblk) {
    const int mt = t >> 3, nt = t & 7, m0 = mt * 128, n0 = nt * 128;
    GemmPtrs g;
    f32x16 acc[2][2];
    gemm_setup(g, OA, 512, m0, (const u16*)(ws + OFF_WAT), 512, n0);
    zero_acc(acc);
    gemm_kloop(acc, g, 8, smem);
    gemm_epilogue_lds(acc, smem, [&](int ml, int nl, const float (&v)[8]) {
      const size_t m = m0 + ml; const int n = n0 + nl;
      const u32x4 gt = *(const u32x4*)(MG + m * 2048 + n);
      float t[8];
#pragma unroll
      for (int e = 0; e < 4; ++e) { t[2 * e] = v[2 * e] * sigmoidf_(bflo(gt[e])); t[2 * e + 1] = v[2 * e + 1] * sigmoidf_(bfhi(gt[e])); }
      *(u32x4*)(MIX + m * 1024 + n) = pack8u(t);
    });
    gemm_setup(g, OB, 512, m0, (const u16*)(ws + OFF_WBT), 512, n0);
    zero_acc(acc);
    gemm_kloop(acc, g, 8, smem);
    gemm_epilogue_lds(acc, smem, [&](int ml, int nl, const float (&v)[8]) {
      const size_t m = m0 + ml; const int n = n0 + nl;
      const u32x4 gt = *(const u32x4*)(MG + m * 2048 + 1024 + n);
      const u32x4 old = *(const u32x4*)(MIX + m * 1024 + n);
      float t[8];
#pragma unroll
      for (int e = 0; e < 4; ++e) {
        t[2 * e] = bflo(old[e]) + v[2 * e] * sigmoidf_(bflo(gt[e]));
        t[2 * e + 1] = bfhi(old[e]) + v[2 * e + 1] * sigmoidf_(bfhi(gt[e]));
      }
      *(u32x4*)(MIX + m * 1024 + n) = pack8u(t);
    });
  }
}

DI void phase_outproj(const Params& p, int bid, int nblk, char* smem) {
  char* ws = p.ws;
  const u16* MIX = (const u16*)(ws + OFF_RH);
  for (int t = bid; t < 256 * 8; t += nblk) {
    const int mt = t >> 3, nt = t & 7, m0 = mt * 128, n0 = nt * 128;
    GemmPtrs g;
    f32x16 acc[2][2];
    gemm_setup(g, MIX, 1024, m0, (const u16*)(ws + OFF_WOT), 1024, n0);
    zero_acc(acc);
    gemm_kloop(acc, g, 16, smem);
    gemm_epilogue_lds(acc, smem, [&](int ml, int nl, const float (&v)[8]) {
      const size_t idx = (size_t)(m0 + ml) * 1024 + n0 + nl;
      const f32x4 x0 = *(const f32x4*)(p.x + idx), x1 = *(const f32x4*)(p.x + idx + 4);
      *(f32x4*)(p.out + idx) = f32x4{x0[0] + v[0], x0[1] + v[1], x0[2] + v[2], x0[3] + v[3]};
      *(f32x4*)(p.out + idx + 4) = f32x4{x1[0] + v[4], x1[1] + v[5], x1[2] + v[6], x1[3] + v[7]};
    });
  }
}

DI void phase_query(const Params& p, int bid, int nblk, char* smem) {
  char* ws = p.ws;
  const u16* H2 = (const u16*)(ws + OFF_RH);
  u16* QRY = (u16*)(ws + OFF_MG);
  for (int t = bid; t < 256 * 16; t += nblk) {
    const int mt = t >> 4, nt = t & 15, m0 = mt * 128, n0 = nt * 128;
    GemmPtrs g;
    f32x16 acc[2][2];
    gemm_setup(g, H2, 1024, m0, (const u16*)(ws + OFF_WQT), 1024, n0);
    zero_acc(acc);
    gemm_kloop(acc, g, 16, smem);
    gemm_epilogue_lds(acc, smem, [&](int ml, int nl, const float (&v)[8]) { *(u32x4*)(QRY + (size_t)(m0 + ml) * 2048 + n0 + nl) = pack8u(v); });
  }
}

DI unsigned f2ord(float f) { unsigned u = __float_as_uint(f); return (u & 0x80000000u) ? ~u : (u | 0x80000000u); }
DI float ord2f(unsigned o) { unsigned u = (o & 0x80000000u) ? (o & 0x7fffffffu) : ~o; return __uint_as_float(u); }

DI void peer_route_job(const Params& p, int job, char* smem) {
  char* ws = p.ws;
  const int mt = job >> 3, hd = job & 7, m0 = mt * 128;
  const u16* QRY = (const u16*)(ws + OFF_MG);
  const u16* SK = (const u16*)(ws + OFF_SK);
  unsigned* keys = (unsigned*)smem;
  const int tid = threadIdx.x + opaque0();
  unsigned top[2][16];
#pragma unroll
  for (int pp = 0; pp < 2; ++pp) {
    GemmPtrs g;
    f32x16 acc[2][2];
    gemm_setup(g, QRY + (hd * 2 + pp) * 128, 2048, m0, SK + (size_t)(hd * 2 + pp) * 128 * 128, 128, 0);
    zero_acc(acc);
    gemm_kloop(acc, g, 2, smem);
    gemm_epilogue(acc, [&](int ml, int nl, float v) { keys[ml * 129 + nl] = (f2ord(v) & ~127u) | (unsigned)(127 - nl); });
    __syncthreads();
    if (tid < 128) {
      const unsigned* row = keys + tid * 129;
      unsigned prev = 0xffffffffu;
#pragma unroll
      for (int rd = 0; rd < 16; ++rd) {
        unsigned best = 0u;
#pragma unroll 8
        for (int j = 0; j < 128; ++j) { unsigned k = row[j]; k = (k < prev) ? k : 0u; best = (k > best) ? k : best; }
        top[pp][rd] = best; prev = best;
      }
    }
    __syncthreads();
  }
  if (tid < 128) {
    float v1[16], v2[16];
    int i1[16], i2[16];
#pragma unroll
    for (int i = 0; i < 16; ++i) {
      v1[i] = ord2f(top[0][i] & ~127u); i1[i] = 127 - (int)(top[0][i] & 127u);
      v2[i] = ord2f(top[1][i] & ~127u); i2[i] = 127 - (int)(top[1][i] & 127u);
    }
    float pv = 3.0e38f; int pf = -1;
    float selv[16];
    int* EI = (int*)(ws + OFF_Z) + ((size_t)(m0 + tid) * 128 + hd * 16);
    float* GT = (float*)(ws + OFF_Z + (size_t)NTOK * 128 * 4) + ((size_t)(m0 + tid) * 128 + hd * 16);
#pragma unroll
    for (int rd = 0; rd < 16; ++rd) {
      float bv = -3.0e38f; int bf = 1 << 20, be = 0;
#pragma unroll
      for (int i = 0; i < 16; ++i)
#pragma unroll
        for (int j = 0; j < 16; ++j)
          if ((i + 1) * (j + 1) <= 16) {
            const float c = v1[i] + v2[j];
            const int fl = i * 16 + j;
            const bool elig = (c < pv) || (c == pv && fl > pf);
            const bool better = elig && (c > bv);
            bv = better ? c : bv; bf = better ? fl : bf; be = better ? (i1[i] * 128 + i2[j]) : be;
          }
      selv[rd] = bv; pv = bv; pf = bf;
      EI[rd] = be;
    }
    float sum = 0.f;
    const float mx = selv[0];
#pragma unroll
    for (int k = 0; k < 16; ++k) { selv[k] = __expf(selv[k] - mx); sum += selv[k]; }
    const float inv = 1.f / sum;
#pragma unroll
    for (int k = 0; k < 16; ++k) GT[k] = selv[k] * inv;
  }
}

DI float gelu_tanh(float x) {
  const float u = 0.7978845608028654f * (x + 0.044715f * x * x * x);
  const float e = __expf(2.f * u);
  const float th = 1.f - 2.f / (e + 1.f);
  return 0.5f * x * (1.f + th);
}
DI float dot8(u32x4 a, u32x4 b, float acc) {
#pragma unroll
  for (int i = 0; i < 4; ++i) {
#if DBG_P11 == 2
    acc += bflo(a[i]) * bflo(b[i]) + bfhi(a[i]) * bfhi(b[i]);
#else
    acc = __builtin_amdgcn_fdot2_f32_bf16(__builtin_bit_cast(bf16x2v, a[i]), __builtin_bit_cast(bf16x2v, b[i]), acc, false);
#endif
  }
  return acc;
}
DI void peer_expert_phase(const Params& p, int bid, int nblk) {
  char* ws = p.ws;
  const int lane = threadIdx.x & 63, wv = threadIdx.x >> 6;
  const u16* EU = (const u16*)(ws + OFF_EU);
  const u16* EV = (const u16*)(ws + OFF_EV);
  const int* EI = (const int*)(ws + OFF_Z);
  const float* GT = (const float*)(ws + OFF_Z + (size_t)NTOK * 128 * 4);
  for (int tok = bid * 4 + wv; tok < NTOK; tok += nblk * 4) {
    const float* xr = p.out + (size_t)tok * 1024;
    f32x4 xa[4];
    xa[0] = *(const f32x4*)(xr + 8 * lane); xa[1] = *(const f32x4*)(xr + 8 * lane + 4);
    xa[2] = *(const f32x4*)(xr + 512 + 8 * lane); xa[3] = *(const f32x4*)(xr + 512 + 8 * lane + 4);
    float ss = 0.f;
#pragma unroll
    for (int i = 0; i < 4; ++i) ss += xa[i][0] * xa[i][0] + xa[i][1] * xa[i][1] + xa[i][2] * xa[i][2] + xa[i][3] * xa[i][3];
    ss = wave_sum(ss);
    const float rs = rsqrtf(ss * (1.f / 1024.f) + 1e-6f);
    u32x4 hA, hB;
    {
      const f32x4 w0 = *(const f32x4*)(p.norm_ffn + 8 * lane), w1 = *(const f32x4*)(p.norm_ffn + 8 * lane + 4);
      const f32x4 w2 = *(const f32x4*)(p.norm_ffn + 512 + 8 * lane), w3 = *(const f32x4*)(p.norm_ffn + 512 + 8 * lane + 4);
      hA[0] = pack2(xa[0][0] * rs * w0[0], xa[0][1] * rs * w0[1]); hA[1] = pack2(xa[0][2] * rs * w0[2], xa[0][3] * rs * w0[3]);
      hA[2] = pack2(xa[1][0] * rs * w1[0], xa[1][1] * rs * w1[1]); hA[3] = pack2(xa[1][2] * rs * w1[2], xa[1][3] * rs * w1[3]);
      hB[0] = pack2(xa[2][0] * rs * w2[0], xa[2][1] * rs * w2[1]); hB[1] = pack2(xa[2][2] * rs * w2[2], xa[2][3] * rs * w2[3]);
      hB[2] = pack2(xa[3][0] * rs * w3[0], xa[3][1] * rs * w3[1]); hB[3] = pack2(xa[3][2] * rs * w3[2], xa[3][3] * rs * w3[3]);
    }
    float outv[16];
#pragma unroll
    for (int i = 0; i < 16; ++i) outv[i] = 0.f;
#pragma unroll 1
    for (int bt = 0; bt < 2; ++bt) {
      const int eidx = EI[(size_t)tok * 128 + bt * 64 + lane];
      const float gt = GT[(size_t)tok * 128 + bt * 64 + lane];
      float acc[64];
#pragma unroll
      for (int e = 0; e < 64; ++e) {
        const int ei = __builtin_amdgcn_readlane(eidx, e);
        const u16* ur = EU + (size_t)ei * 1024;
        u32x4 a = *(const u32x4*)(ur + 8 * lane), bq = *(const u32x4*)(ur + 512 + 8 * lane);
        acc[e] = dot8(bq, hB, dot8(a, hA, 0.f));
      }
#pragma unroll
      for (int st = 0; st < 6; ++st) {
        const int half = 32 >> st;
        const bool up = (lane & half) != 0;
#pragma unroll
        for (int k = 0; k < half; ++k) {
          const float send = up ? acc[k] : acc[k + half];
          const float keep = up ? acc[k + half] : acc[k];
          acc[k] = keep + __shfl_xor(send, half);
        }
      }
#if DBG_P11 == 1
      {
        float mine = 0.f;
        for (int e = 0; e < 64; ++e) {
          const int ei = __builtin_amdgcn_readlane(eidx, e);
          const float* ur = p.expert_u + (size_t)ei * 1024;
          float part = 0.f;
          for (int i = 0; i < 4; ++i) {
            part += ur[8 * lane + 2 * i] * bflo(hA[i]) + ur[8 * lane + 2 * i + 1] * bfhi(hA[i]);
            part += ur[512 + 8 * lane + 2 * i] * bflo(hB[i]) + ur[512 + 8 * lane + 2 * i + 1] * bfhi(hB[i]);
          }
          part = wave_sum(part);
          if (lane == e) mine = part;
        }
        acc[0] = mine;
      }
#endif
      const float wgt = gt * gelu_tanh(acc[0]);
#pragma unroll
      for (int e = 0; e < 64; ++e) {
        const int ei = __builtin_amdgcn_readlane(eidx, e);
        const float we = __uint_as_float((unsigned)__builtin_amdgcn_readlane((int)__float_as_uint(wgt), e));
        const u16* vr = EV + (size_t)ei * 1024;
        u32x4 a = *(const u32x4*)(vr + 8 * lane), bq = *(const u32x4*)(vr + 512 + 8 * lane);
#pragma unroll
        for (int i = 0; i < 4; ++i) {
          outv[2 * i] += we * bflo(a[i]); outv[2 * i + 1] += we * bfhi(a[i]);
          outv[8 + 2 * i] += we * bflo(bq[i]); outv[8 + 2 * i + 1] += we * bfhi(bq[i]);
        }
      }
    }
    float x2[16];
#pragma unroll
    for (int i = 0; i < 4; ++i)
#pragma unroll
      for (int e = 0; e < 4; ++e) x2[4 * i + e] = xa[i][e] + outv[4 * i + e];
    float s2 = 0.f;
#pragma unroll
    for (int i = 0; i < 16; ++i) s2 += x2[i] * x2[i];
    s2 = wave_sum(s2);
    const float r2 = rsqrtf(s2 * (1.f / 1024.f) + 1e-6f);
    float* orow = p.out + (size_t)tok * 1024;
#pragma unroll
    for (int i = 0; i < 4; ++i) {
      const int base = (i < 2 ? 0 : 512) + 8 * lane + 4 * (i & 1);
      const f32x4 nw = *(const f32x4*)(p.norm_final + base);
      f32x4 o = {x2[4 * i] * r2 * nw[0], x2[4 * i + 1] * r2 * nw[1], x2[4 * i + 2] * r2 * nw[2], x2[4 * i + 3] * r2 * nw[3]};
      *(f32x4*)(orow + base) = o;
    }
  }
}

DI void naive_gdn(const Params& p, int bh, char* smem) {
  char* ws = p.ws;
  const int b = bh >> 3, hd = bh & 7, tid = threadIdx.x;
  const u16* QKV = (const u16*)(ws + OFF_QKV);
  const float* SM = (const float*)(ws + OFF_SM);
  float* Obuf = (float*)(ws + OFF_EU);
  float* sq = (float*)smem;
  float* sk = sq + 64;
  float* sv = sk + 64;
  float* red = sv + 64;
  float* misc = red + 256;
  float S[16];
  for (int i = 0; i < 16; ++i) S[i] = 0.f;
  const int dv = tid & 63, dk0 = (tid >> 6) * 16;
  for (int s = 0; s < SEQ; ++s) {
    const size_t trow = (size_t)b * SEQ + s;
    if (tid < 192) {
      const int part = tid >> 6, ch = tid & 63, col = part * 512 + hd * 64 + ch;
      float y = 0.f;
      for (int j = 0; j < 4; ++j) { int ss = s - 3 + j; if (ss >= 0) y += p.conv_w[j * 1536 + col] * bf2f(QKV[((size_t)b * SEQ + ss) * 1536 + col]); }
      y = y / (1.f + __expf(-y));
      (part == 0 ? sq : (part == 1 ? sk : sv))[ch] = y;
    }
    __syncthreads();
    if (tid < 2) {
      float* v = tid ? sk : sq; float ss = 0.f;
      for (int i = 0; i < 64; ++i) ss += v[i] * v[i];
      misc[tid] = rsqrtf(ss + 1e-6f);
    }
    if (tid == 2) {
      float xs = SM[trow * 40 + 8 + hd] + p.dt_bias[hd];
      float sp = (xs > 20.f) ? xs : log1pf(__expf(xs));
      misc[2] = __expf(-__expf(p.a_log[hd]) * sp);
      misc[3] = sigmoidf_(SM[trow * 40 + hd]);
    }
    __syncthreads();
    const float rq = misc[0] * 0.125f, rk = misc[1], eg = misc[2], beta = misc[3];
    float part = 0.f;
    for (int i = 0; i < 16; ++i) { S[i] *= eg; part += sk[dk0 + i] * rk * S[i]; }
    red[(tid >> 6) * 64 + dv] = part;
    __syncthreads();
    const float kS = red[dv] + red[64 + dv] + red[128 + dv] + red[192 + dv];
    const float delta = beta * (sv[dv] - kS);
    float po = 0.f;
    for (int i = 0; i < 16; ++i) { S[i] += sk[dk0 + i] * rk * delta; po += sq[dk0 + i] * rq * S[i]; }
    __syncthreads();
    red[(tid >> 6) * 64 + dv] = po;
    __syncthreads();
    if (tid < 64) Obuf[trow * 512 + hd * 64 + dv] = red[dv] + red[64 + dv] + red[128 + dv] + red[192 + dv];
    __syncthreads();
  }
}

DI void naive_peer(const Params& p, int bid, int nblk, char* smem) {
  float* h2 = (float*)smem;
  float* qry = h2 + 1024;
  float* sc = qry + 2048;
  float* tv = sc + 2048;
  int* ti = (int*)(tv + 256);
  float* gw = (float*)(ti + 256);
  int* ge = (int*)(gw + 128);
  float* red = (float*)(ge + 128);
  const int tid = threadIdx.x;
  for (int tok = bid; tok < NTOK; tok += nblk) {
    __syncthreads();
    const float* xr = p.out + (size_t)tok * 1024;
    float xv[4], ss = 0.f;
    for (int i = 0; i < 4; ++i) { xv[i] = xr[tid + 256 * i]; ss += xv[i] * xv[i]; }
    red[tid] = ss; __syncthreads();
    for (int o = 128; o > 0; o >>= 1) { if (tid < o) red[tid] += red[tid + o]; __syncthreads(); }
    const float rs = rsqrtf(red[0] * (1.f / 1024.f) + 1e-6f);
    __syncthreads();
    for (int i = 0; i < 4; ++i) h2[tid + 256 * i] = xv[i] * rs * p.norm_ffn[tid + 256 * i];
    __syncthreads();
    for (int i = 0; i < 8; ++i) {
      const int n = tid + 256 * i; float a = 0.f;
      for (int k = 0; k < 1024; ++k) a += h2[k] * p.w_query[(size_t)k * 2048 + n];
      qry[n] = a;
    }
    __syncthreads();
    for (int i = 0; i < 8; ++i) {
      const int o = tid + 256 * i, hp = o >> 7, key = o & 127; float a = 0.f;
      for (int d = 0; d < 128; ++d) a += qry[hp * 128 + d] * p.sub_keys[((size_t)hp * 128 + key) * 128 + d];
      sc[o] = a;
    }
    __syncthreads();
    if (tid < 16) {
      float* row = sc + tid * 128;
      for (int rd = 0; rd < 16; ++rd) {
        float bv = -3e38f; int bi = 0;
        for (int j = 0; j < 128; ++j) if (row[j] > bv) { bv = row[j]; bi = j; }
        tv[tid * 16 + rd] = bv; ti[tid * 16 + rd] = bi; row[bi] = -3e38f;
      }
    }
    __syncthreads();
    if (tid < 8) {
      const float* a1 = tv + (tid * 2) * 16; const float* a2 = tv + (tid * 2 + 1) * 16;
      const int* i1 = ti + (tid * 2) * 16; const int* i2 = ti + (tid * 2 + 1) * 16;
      float pv = 3e38f; int pf = -1; float vals[16]; float mx = 0.f, sum = 0.f;
      for (int rd = 0; rd < 16; ++rd) {
        float bv = -3e38f; int bf = 0;
        for (int fl = 0; fl < 256; ++fl) {
          const float c = a1[fl >> 4] + a2[fl & 15];
          const bool elig = (c < pv) || (c == pv && fl > pf);
          if (elig && c > bv) { bv = c; bf = fl; }
        }
        pv = bv; pf = bf;
        if (rd == 0) mx = bv;
        const float e = __expf(bv - mx);
        red[tid * 16 + rd] = e; sum += e;
        ge[tid * 16 + rd] = i1[bf >> 4] * 128 + i2[bf & 15];
      }
      for (int rd = 0; rd < 16; ++rd) gw[tid * 16 + rd] = red[tid * 16 + rd] / sum;
    }
    __syncthreads();
#if DBG_NAIVE_PEER == 2
    if (tid < 128) { ge[tid] = ((const int*)(p.ws + OFF_Z))[(size_t)tok * 128 + tid]; gw[tid] = ((const float*)(p.ws + OFF_Z + (size_t)NTOK * 128 * 4))[(size_t)tok * 128 + tid]; }
    __syncthreads();
#endif
    if (tid < 128) {
      const float* ur = p.expert_u + (size_t)ge[tid] * 1024; float a = 0.f;
      for (int k = 0; k < 1024; ++k) a += h2[k] * ur[k];
      gw[tid] *= gelu_tanh(a);
    }
    __syncthreads();
    float x2[4]; ss = 0.f;
    for (int i = 0; i < 4; ++i) {
      const int c = tid + 256 * i; float a = 0.f;
      for (int e = 0; e < 128; ++e) a += gw[e] * p.expert_v[(size_t)ge[e] * 1024 + c];
      x2[i] = xv[i] + a; ss += x2[i] * x2[i];
    }
    __syncthreads();
    red[tid] = ss; __syncthreads();
    for (int o = 128; o > 0; o >>= 1) { if (tid < o) red[tid] += red[tid + o]; __syncthreads(); }
    const float r2 = rsqrtf(red[0] * (1.f / 1024.f) + 1e-6f);
    float* orow = p.out + (size_t)tok * 1024;
    for (int i = 0; i < 4; ++i) orow[tid + 256 * i] = x2[i] * r2 * p.norm_final[tid + 256 * i];
  }
}

#ifndef MK_SINGLE
#define MK_SINGLE 1
#endif
#define SMEM_DECL __shared__ __attribute__((aligned(16))) char smem[SMEM_BYTES]

DI void run_phase(const Params& p, int ph, int bid, int nblk, char* smem) {
  switch (ph) {
    case 0: phase0(p, bid, nblk, smem); break;
    case 1: phase_inproj(p, bid, nblk, smem); break;
    case 2: phase2(p, bid, nblk, smem); break;
    case 3: phase4(p, smem); break;
    case 4: phase_gdn_post(p, bid, nblk); break;
    case 5: phase_branch(p, bid, nblk, smem); break;
    case 6: phase_outproj(p, bid, nblk, smem); break;
    case 7: rmsnorm_rows_bf16(p.out, p.norm_ffn, (u16*)(p.ws + OFF_RH), NTOK, bid, nblk); break;
    case 8: phase_query(p, bid, nblk, smem); break;
    case 9: for (int j = bid; j < 2048; j += nblk) peer_route_job(p, j, smem); break;
    case 10: peer_expert_phase(p, bid, nblk); break;
  }
}
constexpr int NPHASES = 11;

#if MK_SINGLE
__global__ void __launch_bounds__(NTHREADS, 2) fwd_megakernel(Params p) {
  SMEM_DECL;
  cg::grid_group grid = cg::this_grid();
  const int bid = blockIdx.x, nblk = gridDim.x;
  run_phase(p, 0, bid, nblk, smem); grid.sync();
  run_phase(p, 1, bid, nblk, smem); grid.sync();
  run_phase(p, 2, bid, nblk, smem); grid.sync();
  run_phase(p, 3, bid, nblk, smem); grid.sync();
  run_phase(p, 4, bid, nblk, smem); grid.sync();
  run_phase(p, 5, bid, nblk, smem); grid.sync();
  run_phase(p, 6, bid, nblk, smem); grid.sync();
  run_phase(p, 7, bid, nblk, smem); grid.sync();
  run_phase(p, 8, bid, nblk, smem); grid.sync();
  run_phase(p, 9, bid, nblk, smem); grid.sync();
  run_phase(p, 10, bid, nblk, smem);
}
#else
template <int PH>
__global__ void __launch_bounds__(NTHREADS, 2) phase_kernel(Params p) {
  SMEM_DECL;
  run_phase(p, PH, blockIdx.x, gridDim.x, smem);
}
__global__ void __launch_bounds__(NTHREADS, 2) dbg_naive_peer_kernel(Params p) { SMEM_DECL; naive_peer(p, blockIdx.x, gridDim.x, smem); }
__global__ void __launch_bounds__(NTHREADS, 2) dbg_naive_gdn_kernel(Params p) { SMEM_DECL; naive_gdn(p, blockIdx.x, smem); }
__global__ void __launch_bounds__(NTHREADS, 2) dbg_convert_experts(Params p) {
  convert_flat(p.expert_u, (u16*)(p.ws + OFF_EU), (size_t)16384 * 1024, blockIdx.x, gridDim.x);
  convert_flat(p.expert_v, (u16*)(p.ws + OFF_EV), (size_t)16384 * 1024, blockIdx.x, gridDim.x);
}
#endif

extern "C" void kernel_launch(void* const* d_in, const int* in_sizes, int n_in, void* d_out, int out_size, void* d_ws, size_t ws_size,
                              hipStream_t stream) {
  Params p{};
  const float** f = (const float**)&p;
  for (int i = 0; i < 21; ++i) f[i] = (const float*)d_in[i];
  p.out = (float*)d_out;
  p.ws = (char*)d_ws;
  if (ws_size < WS_NEEDED) return;
#if MK_SINGLE
  static int grid_blocks = 0;
  if (!grid_blocks) {
    int dev = 0, cus = 0, per_cu = 0;
    hipGetDevice(&dev);
    hipDeviceGetAttribute(&cus, hipDeviceAttributeMultiprocessorCount, dev);
    hipOccupancyMaxActiveBlocksPerMultiprocessor(&per_cu, fwd_megakernel, NTHREADS, 0);
    if (per_cu > 2) per_cu = 2;
    grid_blocks = cus * per_cu;
  }
  void* args[] = {&p};
  hipLaunchCooperativeKernel((void*)fwd_megakernel, dim3(grid_blocks), dim3(NTHREADS), args, 0, stream);
#else
  const int G = 512;
  phase_kernel<0><<<G, NTHREADS, 0, stream>>>(p);
  phase_kernel<1><<<G, NTHREADS, 0, stream>>>(p);
  phase_kernel<2><<<G, NTHREADS, 0, stream>>>(p);
#if DBG_NAIVE_GDN
  dbg_naive_gdn_kernel<<<64, NTHREADS, 0, stream>>>(p);
#endif
  phase_kernel<3><<<G, NTHREADS, 0, stream>>>(p);
  phase_kernel<4><<<G, NTHREADS, 0, stream>>>(p);
#if DBG_NAIVE_GDN
  dbg_convert_experts<<<G, NTHREADS, 0, stream>>>(p);
#endif
  phase_kernel<5><<<G, NTHREADS, 0, stream>>>(p);
  phase_kernel<6><<<G, NTHREADS, 0, stream>>>(p);
#if DBG_NAIVE_PEER == 1
  dbg_naive_peer_kernel<<<G, NTHREADS, 0, stream>>>(p);
#elif DBG_NAIVE_PEER == 2
  phase_kernel<7><<<G, NTHREADS, 0, stream>>>(p);
  phase_kernel<8><<<G, NTHREADS, 0, stream>>>(p);
  phase_kernel<9><<<G, NTHREADS, 0, stream>>>(p);
  dbg_naive_peer_kernel<<<G, NTHREADS, 0, stream>>>(p);
#else
  phase_kernel<7><<<G, NTHREADS, 0, stream>>>(p);
  phase_kernel<8><<<G, NTHREADS, 0, stream>>>(p);
  phase_kernel<9><<<G, NTHREADS, 0, stream>>>(p);
  phase_kernel<10><<<G, NTHREADS, 0, stream>>>(p);
#endif
#endif
}
```

```cpp
#include <hip/hip_runtime.h>
#include <hip/hip_cooperative_groups.h>
#include <stdint.h>
namespace cg = cooperative_groups;

#define DI __device__ __forceinline__
typedef unsigned short u16;
typedef __attribute__((ext_vector_type(8))) short bf16x8;
typedef __attribute__((ext_vector_type(16))) float f32x16;
typedef __attribute__((ext_vector_type(4))) float f32x4;
typedef __attribute__((ext_vector_type(4))) unsigned u32x4;
typedef __attribute__((ext_vector_type(2))) unsigned u32x2;
typedef __attribute__((ext_vector_type(2))) __bf16 bf16x2v;

constexpr int BATCH = 8, SEQ = 4096, DM = 1024, NTOK = BATCH * SEQ;
constexpr int NIN = 5416, NP = 5504;
constexpr int NTHREADS = 256;
constexpr int SMEM_BYTES = 72 * 1024;
constexpr float L2E = 1.4426950408889634f;

constexpr size_t AL(size_t x) { return (x + 255) & ~(size_t)255; }
constexpr size_t OFF_WINT = 0;
constexpr size_t OFF_WAT = OFF_WINT + AL((size_t)NP * 1024 * 2);
constexpr size_t OFF_WBT = OFF_WAT + AL((size_t)1024 * 512 * 2);
constexpr size_t OFF_WOT = OFF_WBT + AL((size_t)1024 * 512 * 2);
constexpr size_t OFF_WQT = OFF_WOT + AL((size_t)1024 * 1024 * 2);
constexpr size_t OFF_SK = OFF_WQT + AL((size_t)2048 * 1024 * 2);
constexpr size_t OFF_WKT = OFF_SK + AL((size_t)16 * 128 * 128 * 2);
constexpr size_t OFF_WVT = OFF_WKT + AL((size_t)128 * 2048 * 2);
constexpr size_t OFF_EU = OFF_WVT + AL((size_t)128 * 2048 * 2);
constexpr size_t OFF_EV = OFF_EU + AL((size_t)16384 * 1024 * 2);
constexpr size_t OFF_MISC = OFF_EV + AL((size_t)16384 * 1024 * 2);
constexpr size_t MISC_CK = 0, MISC_CV = 256, MISC_BIAS = 512, MISC_CNT = 512 + 8 * 132 * 4 + 256, MISC_GL = 8192;
constexpr size_t OFF_RH = OFF_MISC + 65536;
constexpr size_t OFF_QKV = OFF_RH + (size_t)NTOK * 1024 * 2;
constexpr size_t OFF_Z = OFF_QKV + (size_t)NTOK * 1536 * 2;
constexpr size_t OFF_NQ = OFF_Z + (size_t)NTOK * 512 * 2;
constexpr size_t OFF_NKV = OFF_NQ + (size_t)NTOK * 512 * 2;
constexpr size_t OFF_MG = OFF_NKV + (size_t)NTOK * 768 * 2;
constexpr size_t OFF_SM = OFF_MG + (size_t)NTOK * 2048 * 2;
constexpr size_t OFF_VST = OFF_SM + AL((size_t)NTOK * 40 * 4);
constexpr size_t OFF_VWT = OFF_VST + (size_t)16 * 64 * 4096 * 2;
constexpr size_t OFF_KC = OFF_VWT + (size_t)16 * 64 * 4096 * 2;
constexpr size_t OFF_VCT = OFF_KC + (size_t)16 * 256 * 64 * 2;
constexpr size_t WS_NEEDED = OFF_VCT + (size_t)16 * 64 * 256 * 2;

struct Params {
  const float *x, *rel_bias, *norm_final, *norm_mix, *w_in, *conv_w, *a_log, *dt_bias, *gdn_norm, *cmp_pe_k, *cmp_pe_v,
      *cmp_w_k, *cmp_w_v, *w_a, *w_b, *w_out, *norm_ffn, *w_query, *sub_keys, *expert_u, *expert_v;
  float* out;
  char* ws;
};

DI u16 f2bf(float x) { return __builtin_bit_cast(u16, (__bf16)x); }
DI float bf2f(u16 b) { return __uint_as_float(((unsigned)b) << 16); }
DI unsigned pack2(float lo, float hi) { return (unsigned)f2bf(lo) | ((unsigned)f2bf(hi) << 16); }
DI float bflo(unsigned u) { return __uint_as_float(u << 16); }
DI float bfhi(unsigned u) { return __uint_as_float(u & 0xffff0000u); }
DI float wave_sum(float v) {
#pragma unroll
  for (int o = 32; o >= 1; o >>= 1) v += __shfl_xor(v, o);
  return v;
}
DI int opaque0() { int z = 0; asm volatile("" : "+v"(z)); return z; }
DI float sigmoidf_(float x) { return 1.f / (1.f + __expf(-x)); }
DI f32x16 mfma32(bf16x8 a, bf16x8 b, f32x16 c) { return __builtin_amdgcn_mfma_f32_32x32x16_bf16(a, b, c, 0, 0, 0); }
DI f32x4 mfma16(bf16x8 a, bf16x8 b, f32x4 c) { return __builtin_amdgcn_mfma_f32_16x16x32_bf16(a, b, c, 0, 0, 0); }
DI int swz(int row, int ch) { return row * 128 + ((ch ^ ((row >> 1) & 7)) << 4); }
DI bf16x8 lds_frag(const char* tile, int row, int ch) { return *(const bf16x8*)(tile + swz(row, ch)); }
DI bf16x8 pad_frag(const char* tile, int row, int ch) { return *(const bf16x8*)(tile + row * 144 + ch * 16); }
DI bf16x8 pack8(float a0, float a1, float a2, float a3, float a4, float a5, float a6, float a7) {
  u32x4 p;
  p[0] = pack2(a0, a1); p[1] = pack2(a2, a3); p[2] = pack2(a4, a5); p[3] = pack2(a6, a7);
  return __builtin_bit_cast(bf16x8, p);
}
DI int perm16(int o) { return (o & ~12) | ((o & 4) << 1) | ((o & 8) >> 1); }

DI int win_colmap(int n) {
  if (n < 2048) return n;
  if (n < 2560) return n - 2048 + 2064;
  if (n < 3328) return n - 2560 + 2576;
  if (n < 5376) return n - 3328 + 3368;
  if (n < 5392) return n - 5376 + 2048;
  if (n < 5416) return n - 5392 + 3344;
  return -1;
}
template <int MAPMODE>
DI void tconv_tile(const float* __restrict__ src, int K, int N, u16* __restrict__ dst, int kt, int nt, char* smem) {
  float* tile = (float*)smem;
  const int tid = threadIdx.x;
  const int nl = tid & 63, k0 = kt * 64, n0 = nt * 64;
  int col;
  if (MAPMODE == 1) col = win_colmap(n0 + nl); else col = (n0 + nl < N) ? (n0 + nl) : -1;
#pragma unroll 4
  for (int i = 0; i < 16; ++i) {
    int kl = (tid >> 6) + 4 * i;
    float v = (col >= 0) ? src[(size_t)(k0 + kl) * N + col] : 0.f;
    tile[kl * 65 + nl] = v;
  }
  __syncthreads();
  {
    const int n2 = tid >> 2, kp = tid & 3;
    u32x4 o0, o1;
#pragma unroll
    for (int i = 0; i < 4; ++i) {
      o0[i] = pack2(tile[(kp * 16 + 2 * i) * 65 + n2], tile[(kp * 16 + 2 * i + 1) * 65 + n2]);
      o1[i] = pack2(tile[(kp * 16 + 8 + 2 * i) * 65 + n2], tile[(kp * 16 + 8 + 2 * i + 1) * 65 + n2]);
    }
    u16* d = dst + (size_t)(n0 + n2) * K + k0 + kp * 16;
    *(u32x4*)d = o0;
    *(u32x4*)(d + 8) = o1;
  }
  __syncthreads();
}

DI void convert_flat(const float* __restrict__ src, u16* __restrict__ dst, size_t n, int bid, int nblk) {
  size_t nv = n / 8;
  for (size_t i = (size_t)bid * NTHREADS + threadIdx.x; i < nv; i += (size_t)nblk * NTHREADS) {
    f32x4 a = ((const f32x4*)src)[2 * i], b = ((const f32x4*)src)[2 * i + 1];
    u32x4 o;
    o[0] = pack2(a[0], a[1]); o[1] = pack2(a[2], a[3]); o[2] = pack2(b[0], b[1]); o[3] = pack2(b[2], b[3]);
    ((u32x4*)dst)[i] = o;
  }
}

DI void rmsnorm_rows_bf16(const float* __restrict__ src, const float* __restrict__ w, u16* __restrict__ dst, int nrows, int bid, int nblk) {
  const int lane = threadIdx.x & 63, wv = threadIdx.x >> 6;
  f32x4 wr[4];
#pragma unroll
  for (int i = 0; i < 4; ++i) wr[i] = ((const f32x4*)w)[lane + 64 * i];
  for (int row = bid * 4 + wv; row < nrows; row += nblk * 4) {
    const f32x4* s = (const f32x4*)(src + (size_t)row * 1024);
    f32x4 v[4];
    float ss = 0.f;
#pragma unroll
    for (int i = 0; i < 4; ++i) { v[i] = s[lane + 64 * i]; ss += v[i][0] * v[i][0] + v[i][1] * v[i][1] + v[i][2] * v[i][2] + v[i][3] * v[i][3]; }
    ss = wave_sum(ss);
    float rs = rsqrtf(ss * (1.f / 1024.f) + 1e-6f);
#pragma unroll
    for (int i = 0; i < 4; ++i) {
      u32x2 o;
      o[0] = pack2(v[i][0] * rs * wr[i][0], v[i][1] * rs * wr[i][1]);
      o[1] = pack2(v[i][2] * rs * wr[i][2], v[i][3] * rs * wr[i][3]);
      *(u32x2*)(dst + (size_t)row * 1024 + (lane + 64 * i) * 4) = o;
    }
  }
}

DI int t5_bucket(int d) {
  if (d < 16) return d < 0 ? 0 : d;
  const int th[16] = {16, 19, 21, 24, 27, 31, 35, 40, 46, 52, 59, 67, 77, 87, 99, 113};
  int b = 16;
#pragma unroll
  for (int k = 1; k < 16; ++k) b += (d >= th[k]) ? 1 : 0;
  return b;
}

DI void phase0(const Params& p, int bid, int nblk, char* smem) {
  char* ws = p.ws;
  const int n_win = 16 * 86, n_wa = 8 * 16, n_wo = 16 * 16, n_wq = 16 * 32, n_wc = 32 * 2;
  const int total = n_win + 2 * n_wa + n_wo + n_wq + 2 * n_wc;
  for (int it = bid; it < total; it += nblk) {
    int i = it;
    if (i < n_win) { tconv_tile<1>(p.w_in, 1024, NIN, (u16*)(ws + OFF_WINT), i / 86, i % 86, smem); continue; }
    i -= n_win;
    if (i < n_wa) { tconv_tile<0>(p.w_a, 512, 1024, (u16*)(ws + OFF_WAT), i / 16, i % 16, smem); continue; }
    i -= n_wa;
    if (i < n_wa) { tconv_tile<0>(p.w_b, 512, 1024, (u16*)(ws + OFF_WBT), i / 16, i % 16, smem); continue; }
    i -= n_wa;
    if (i < n_wo) { tconv_tile<0>(p.w_out, 1024, 1024, (u16*)(ws + OFF_WOT), i / 16, i % 16, smem); continue; }
    i -= n_wo;
    if (i < n_wq) { tconv_tile<0>(p.w_query, 1024, 2048, (u16*)(ws + OFF_WQT), i / 32, i % 32, smem); continue; }
    i -= n_wq;
    if (i < n_wc) { tconv_tile<0>(p.cmp_w_k, 2048, 64, (u16*)(ws + OFF_WKT), i / 2, i % 2, smem); continue; }
    i -= n_wc;
    tconv_tile<0>(p.cmp_w_v, 2048, 64, (u16*)(ws + OFF_WVT), i / 2, i % 2, smem);
  }
  convert_flat(p.sub_keys, (u16*)(ws + OFF_SK), (size_t)16 * 128 * 128, bid, nblk);
  convert_flat(p.expert_u, (u16*)(ws + OFF_EU), (size_t)16384 * 1024, bid, nblk);
  convert_flat(p.expert_v, (u16*)(ws + OFF_EV), (size_t)16384 * 1024, bid, nblk);
  rmsnorm_rows_bf16(p.x, p.norm_mix, (u16*)(ws + OFF_RH), NTOK, bid, nblk);
  const int tid = threadIdx.x;
  if (bid == nblk - 1) {
    float* ck = (float*)(ws + OFF_MISC + MISC_CK);
    float* cv = (float*)(ws + OFF_MISC + MISC_CV);
    if (tid < 128) {
      const int e = tid & 63;
      const float* pe = (tid < 64) ? p.cmp_pe_k : p.cmp_pe_v;
      const float* W = (tid < 64) ? p.cmp_w_k : p.cmp_w_v;
      float s = 0.f;
      for (int k = 0; k < 2048; ++k) s += pe[k] * W[(size_t)k * 64 + e];
      if (tid < 64) ck[e] = s; else cv[e] = s;
    }
  }
  if (bid == nblk - 2 || nblk == 1) {
    float* bt = (float*)(ws + OFF_MISC + MISC_BIAS);
    for (int i = tid; i < 8 * 132; i += NTHREADS) {
      int hd = i / 132, d = i % 132;
      bt[i] = p.rel_bias[t5_bucket(d) * 8 + hd] * L2E;
    }
    if (tid < 16) ((unsigned*)(ws + OFF_MISC + MISC_CNT))[tid] = 0u;
  }
}

struct GemmPtrs {
  const u16* a[4];
  const u16* b[4];
  long aks, bks;
};

DI void gemm_kloop(f32x16 (&acc)[2][2], const GemmPtrs& g, int nkt, char* smem) {
  const int tid = threadIdx.x, lane = tid & 63, w = tid >> 6, wm = w >> 1, wn = w & 1, r = lane & 31, h = lane >> 5;
  const int lrow = tid >> 3, lch = tid & 7;
  u32x4 ra[4], rb[4];
#pragma unroll
  for (int i = 0; i < 4; ++i) { ra[i] = *(const u32x4*)(g.a[i]); rb[i] = *(const u32x4*)(g.b[i]); }
#pragma unroll
  for (int i = 0; i < 4; ++i) {
    *(u32x4*)(smem + swz(lrow + 32 * i, lch)) = ra[i];
    *(u32x4*)(smem + 16384 + swz(lrow + 32 * i, lch)) = rb[i];
  }
  __syncthreads();
  for (int kt = 0; kt < nkt; ++kt) {
    const char* A = smem + (kt & 1) * 32768;
    const char* B = A + 16384;
    const bool more = (kt + 1 < nkt);
    if (more) {
#pragma unroll
      for (int i = 0; i < 4; ++i) {
        ra[i] = *(const u32x4*)(g.a[i] + (long)(kt + 1) * g.aks);
        rb[i] = *(const u32x4*)(g.b[i] + (long)(kt + 1) * g.bks);
      }
    }
#pragma unroll
    for (int s = 0; s < 4; ++s) {
      bf16x8 a0 = lds_frag(A, wm * 64 + r, 2 * s + h);
      bf16x8 a1 = lds_frag(A, wm * 64 + 32 + r, 2 * s + h);
      bf16x8 b0 = lds_frag(B, wn * 64 + r, 2 * s + h);
      bf16x8 b1 = lds_frag(B, wn * 64 + 32 + r, 2 * s + h);
      acc[0][0] = mfma32(a0, b0, acc[0][0]);
      acc[0][1] = mfma32(a0, b1, acc[0][1]);
      acc[1][0] = mfma32(a1, b0, acc[1][0]);
      acc[1][1] = mfma32(a1, b1, acc[1][1]);
    }
    if (more) {
      char* A2 = smem + ((kt + 1) & 1) * 32768;
#pragma unroll
      for (int i = 0; i < 4; ++i) {
        *(u32x4*)(A2 + swz(lrow + 32 * i, lch)) = ra[i];
        *(u32x4*)(A2 + 16384 + swz(lrow + 32 * i, lch)) = rb[i];
      }
    }
    __syncthreads();
  }
}

DI void zero_acc(f32x16 (&acc)[2][2]) {
#pragma unroll
  for (int i = 0; i < 2; ++i)
#pragma unroll
    for (int j = 0; j < 2; ++j)
#pragma unroll
      for (int k = 0; k < 16; ++k) acc[i][j][k] = 0.f;
}
DI void gemm_setup(GemmPtrs& g, const u16* A, long lda, int m0, const u16* Bt, long ldb, int n0) {
  const int lrow = threadIdx.x >> 3, lch = threadIdx.x & 7;
#pragma unroll
  for (int i = 0; i < 4; ++i) {
    g.a[i] = A + (size_t)(m0 + lrow + 32 * i) * lda + lch * 8;
    g.b[i] = Bt + (size_t)(n0 + lrow + 32 * i) * ldb + lch * 8;
  }
  g.aks = 64; g.bks = 64;
}
template <class F>
DI void gemm_epilogue(const f32x16 (&acc)[2][2], F f) {
  const int lane = threadIdx.x & 63, w = threadIdx.x >> 6, wm = w >> 1, wn = w & 1, r = lane & 31, h = lane >> 5;
#pragma unroll
  for (int i = 0; i < 2; ++i)
#pragma unroll
    for (int j = 0; j < 2; ++j) {
#pragma unroll
      for (int k = 0; k < 16; ++k) f(wm * 64 + i * 32 + (k & 3) + 8 * (k >> 2) + 4 * h, wn * 64 + j * 32 + r, acc[i][j][k]);
      asm volatile("" ::: "memory");
    }
}

template <class F>
DI void gemm_epilogue_lds(const f32x16 (&acc)[2][2], char* smem, F f) {
  float* T = (float*)smem;
  {
    const int lane = threadIdx.x & 63, w = threadIdx.x >> 6, wm = w >> 1, wn = w & 1, r = lane & 31, h = lane >> 5;
#pragma unroll
    for (int i = 0; i < 2; ++i)
#pragma unroll
      for (int j = 0; j < 2; ++j)
#pragma unroll
        for (int k = 0; k < 16; ++k) T[(wm * 64 + i * 32 + (k & 3) + 8 * (k >> 2) + 4 * h) * 132 + wn * 64 + j * 32 + r] = acc[i][j][k];
  }
  __syncthreads();
  const int c8 = (threadIdx.x & 15) * 8, r0 = threadIdx.x >> 4;
#pragma unroll 2
  for (int it = 0; it < 8; ++it) {
    const int row = r0 + 16 * it;
    const f32x4 a = *(const f32x4*)(T + row * 132 + c8), b = *(const f32x4*)(T + row * 132 + c8 + 4);
    const float v[8] = {a[0], a[1], a[2], a[3], b[0], b[1], b[2], b[3]};
    f(row, c8, v);
  }
  __syncthreads();
}
DI u32x4 pack8u(const float (&v)[8]) { u32x4 o; o[0] = pack2(v[0], v[1]); o[1] = pack2(v[2], v[3]); o[2] = pack2(v[4], v[5]); o[3] = pack2(v[6], v[7]); return o; }

DI void phase_inproj(const Params& p, int bid, int nblk, char* smem) {
  char* ws = p.ws;
  const u16* H = (const u16*)(ws + OFF_RH);
  const u16* W = (const u16*)(ws + OFF_WINT);
  const int NT = NP / 128;
  for (int t = bid; t < 256 * NT; t += nblk) {
    const int mt = t / NT, nt = t % NT, m0 = mt * 128, n0 = nt * 128;
    GemmPtrs g;
    gemm_setup(g, H, 1024, m0, W, 1024, n0);
    f32x16 acc[2][2];
    zero_acc(acc);
    gemm_kloop(acc, g, 16, smem);
    if (n0 >= 5376) {
      float* SM = (float*)(ws + OFF_SM);
      gemm_epilogue_lds(acc, smem, [&](int ml, int nl, const float (&v)[8]) {
        if (nl < 40) {
          float* d = SM + (size_t)(m0 + ml) * 40 + nl;
          *(f32x4*)d = f32x4{v[0], v[1], v[2], v[3]};
          *(f32x4*)(d + 4) = f32x4{v[4], v[5], v[6], v[7]};
        }
      });
    } else {
      u16* dst; int ld, c0;
      if (n0 < 1536) { dst = (u16*)(ws + OFF_QKV); ld = 1536; c0 = n0; }
      else if (n0 < 2048) { dst = (u16*)(ws + OFF_Z); ld = 512; c0 = n0 - 1536; }
      else if (n0 < 2560) { dst = (u16*)(ws + OFF_NQ); ld = 512; c0 = n0 - 2048; }
      else if (n0 < 3328) { dst = (u16*)(ws + OFF_NKV); ld = 768; c0 = n0 - 2560; }
      else { dst = (u16*)(ws + OFF_MG); ld = 2048; c0 = n0 - 3328; }
      gemm_epilogue_lds(acc, smem, [&](int ml, int nl, const float (&v)[8]) { *(u32x4*)(dst + (size_t)(m0 + ml) * ld + c0 + nl) = pack8u(v); });
    }
  }
}

DI void vtrans_item(const Params& p, int item, char* smem) {
  char* ws = p.ws;
  const int tile = item & 63, bg = (item >> 6) & 15, which = item >> 10;
  const int b = bg >> 1, g = bg & 1;
  const u16* NKV = (const u16*)(ws + OFF_NKV);
  u16* VT = (u16*)(ws + (which ? OFF_VWT : OFF_VST)) + (size_t)bg * 64 * 4096;
  const int col0 = (which ? 640 : 384) + g * 64;
  u16* t = (u16*)smem;
  const int tid = threadIdx.x;
  {
#pragma unroll
    for (int i = 0; i < 2; ++i) {
      int c = tid + 256 * i, row = c >> 3, ch = c & 7;
      u32x4 v = *(const u32x4*)(NKV + (size_t)(b * SEQ + tile * 64 + row) * 768 + col0 + ch * 8);
      *(u32x4*)(t + row * 72 + ch * 8) = v;
    }
  }
  __syncthreads();
  {
    const int d = tid >> 2, part = tid & 3;
    u32x4 o0, o1;
    u16 vals[16];
#pragma unroll
    for (int pp = 0; pp < 16; ++pp) vals[pp] = t[(part * 16 + perm16(pp)) * 72 + d];
#pragma unroll
    for (int i = 0; i < 4; ++i) {
      o0[i] = (unsigned)vals[2 * i] | ((unsigned)vals[2 * i + 1] << 16);
      o1[i] = (unsigned)vals[8 + 2 * i] | ((unsigned)vals[8 + 2 * i + 1] << 16);
    }
    u16* dst = VT + (size_t)d * 4096 + tile * 64 + part * 16;
    *(u32x4*)dst = o0;
    *(u32x4*)(dst + 8) = o1;
  }
  __syncthreads();
}

DI void cmp_gemm_item(const Params& p, int item, char* smem) {
  char* ws = p.ws;
  const int which = item >> 5, mt = item & 31, m0 = mt * 128;
  const u16* NKV = (const u16*)(ws + OFF_NKV);
  const u16* Wt = (const u16*)(ws + (which ? OFF_WVT : OFF_WKT));
  GemmPtrs g;
  const int lrow = threadIdx.x >> 3, lch = threadIdx.x & 7;
#pragma unroll
  for (int i = 0; i < 4; ++i) {
    int m = m0 + lrow + 32 * i, bg = m >> 8, n = m & 255;
    if (n > 254) n = 254;
    g.a[i] = NKV + (size_t)((bg >> 1) * SEQ + 16 * n) * 768 + which * 128 + (bg & 1) * 64 + lch * 8;
    g.b[i] = Wt + (size_t)(lrow + 32 * i) * 2048 + lch * 8;
  }
  g.aks = 768; g.bks = 64;
  f32x16 acc[2][2];
  zero_acc(acc);
  gemm_kloop(acc, g, 32, smem);
  const float* cc = (const float*)(ws + OFF_MISC + (which ? MISC_CV : MISC_CK));
  if (which == 0) {
    u16* KC = (u16*)(ws + OFF_KC);
    gemm_epilogue_lds(acc, smem, [&](int ml, int nl, const float (&v)[8]) {
      if (nl < 64) {
        float t[8];
#pragma unroll
        for (int e = 0; e < 8; ++e) t[e] = v[e] + cc[nl + e];
        *(u32x4*)(KC + (size_t)(m0 + ml) * 64 + nl) = pack8u(t);
      }
    });
  } else {
    u16* VCT = (u16*)(ws + OFF_VCT);
    gemm_epilogue_lds(acc, smem, [&](int ml, int nl, const float (&v)[8]) {
      if (nl < 64) {
        const int m = m0 + ml, bg = m >> 8, n = m & 255;
        u16* d = VCT + ((size_t)bg * 64 + nl) * 256 + (n & ~15) + perm16(n & 15);
#pragma unroll
        for (int e = 0; e < 8; ++e) d[e * 256] = f2bf(v[e] + cc[nl + e]);
      }
    });
  }
}

DI void gdn_store_frag(u16* dst, const char* tile, int idx  , float scale_is_row, const float* rowscale) {
  const int blk = idx >> 6, lane = idx & 63, rt = blk >> 1, ks = blk & 1, r = lane & 15, q = lane >> 4;
  const int row = 16 * rt + r;
  const int k0 = 32 * ks + 4 * q, k1 = k0 + 16;
  u32x2 lo = *(const u32x2*)(tile + swz(row, k0 >> 3) + (k0 & 7) * 2);
  u32x2 hi = *(const u32x2*)(tile + swz(row, k1 >> 3) + (k1 & 7) * 2);
  u32x4 o;
  if (rowscale) {
    float s = rowscale[row];
    o[0] = pack2(bflo(lo[0]) * s, bfhi(lo[0]) * s); o[1] = pack2(bflo(lo[1]) * s, bfhi(lo[1]) * s);
    o[2] = pack2(bflo(hi[0]) * s, bfhi(hi[0]) * s); o[3] = pack2(bflo(hi[1]) * s, bfhi(hi[1]) * s);
  } else { o[0] = lo[0]; o[1] = lo[1]; o[2] = hi[0]; o[3] = hi[1]; }
  *(u32x4*)(dst + (size_t)idx * 8) = o;
}

DI void gdn_chunk_item(const Params& p, int item, char* smem) {
  char* ws = p.ws;
  const int n = item & 63, bh = item >> 6, b = bh >> 3, hd = bh & 7;
  const int tid = threadIdx.x + opaque0(), lane = tid & 63, w = tid >> 6;
  char* Cq = smem;
  char* Ck = smem + 8192;
  char* Cv = smem + 16384;
  float* Am = (float*)(smem + 24576);
  char* ATT = smem + 40960;
  char* Wt = smem + 49152;
  float* gc = (float*)(smem + 57344);
  float* bet = gc + 64;
  float* eg = gc + 128;
  float* ekd = gc + 192;
  const u16* QKV = (const u16*)(ws + OFF_QKV);
  const size_t tok0 = (size_t)b * SEQ + n * 64;
  {
    const int ch = tid & 63, tg = tid >> 6;
#pragma unroll
    for (int part = 0; part < 3; ++part) {
      const int col = part * 512 + hd * 64 + ch;
      const float w0 = p.conv_w[col], w1 = p.conv_w[1536 + col], w2 = p.conv_w[3072 + col], w3 = p.conv_w[4608 + col];
      const int s0 = n * 64 + tg * 16;
      const u16* src = QKV + ((size_t)b * SEQ) * 1536 + col;
      float x0 = (s0 - 3 >= 0) ? bf2f(src[(size_t)(s0 - 3) * 1536]) : 0.f;
      float x1 = (s0 - 2 >= 0) ? bf2f(src[(size_t)(s0 - 2) * 1536]) : 0.f;
      float x2 = (s0 - 1 >= 0) ? bf2f(src[(size_t)(s0 - 1) * 1536]) : 0.f;
      char* C = smem + part * 8192;
#pragma unroll 4
      for (int i = 0; i < 16; ++i) {
        float x3 = bf2f(src[(size_t)(s0 + i) * 1536]);
        float y = w0 * x0 + w1 * x1 + w2 * x2 + w3 * x3;
        y = y / (1.f + __expf(-y));
        int tok = tg * 16 + i;
        *(u16*)(C + swz(tok, ch >> 3) + (ch & 7) * 2) = f2bf(y);
        x0 = x1; x1 = x2; x2 = x3;
      }
    }
  }
  if (w == 0) {
    const float* SM = (const float*)(ws + OFF_SM);
    float bi = SM[(tok0 + lane) * 40 + hd], ai = SM[(tok0 + lane) * 40 + 8 + hd];
    float xs = ai + p.dt_bias[hd];
    float sp = (xs > 20.f) ? xs : log1pf(__expf(xs));
    float gv = -__expf(p.a_log[hd]) * sp;
#pragma unroll
    for (int o = 1; o < 64; o <<= 1) { float t = __shfl_up(gv, o); if (lane >= o) gv += t; }
    float glast = __shfl(gv, 63);
    gc[lane] = gv; bet[lane] = sigmoidf_(bi); eg[lane] = __expf(gv); ekd[lane] = __expf(glast - gv);
    if (lane == 63) ((float*)(ws + OFF_MISC + MISC_GL))[item] = __expf(gv);
  }
  __syncthreads();
  if (tid < 128) {
    char* C = (tid < 64) ? Cq : Ck;
    const int row = tid & 63;
    u32x4 v[8];
    float ss = 0.f;
#pragma unroll
    for (int c = 0; c < 8; ++c) {
      v[c] = *(const u32x4*)(C + swz(row, c));
#pragma unroll
      for (int e = 0; e < 4; ++e) { float a = bflo(v[c][e]), bb = bfhi(v[c][e]); ss += a * a + bb * bb; }
    }
    float rs = rsqrtf(ss + 1e-6f) * ((tid < 64) ? 0.125f : 1.f);
#pragma unroll
    for (int c = 0; c < 8; ++c) {
      u32x4 o;
#pragma unroll
      for (int e = 0; e < 4; ++e) o[e] = pack2(bflo(v[c][e]) * rs, bfhi(v[c][e]) * rs);
      *(u32x4*)(C + swz(row, c)) = o;
    }
  }
  __syncthreads();
  {
    const int qa = w >> 1, qb = w & 1, r = lane & 31, h = lane >> 5;
    f32x16 akk, aqk;
#pragma unroll
    for (int k = 0; k < 16; ++k) { akk[k] = 0.f; aqk[k] = 0.f; }
    if (!(qa == 0 && qb == 1)) {
#pragma unroll
      for (int s = 0; s < 4; ++s) {
        bf16x8 ak = lds_frag(Ck, 32 * qa + r, 2 * s + h);
        bf16x8 aq = lds_frag(Cq, 32 * qa + r, 2 * s + h);
        bf16x8 bk = lds_frag(Ck, 32 * qb + r, 2 * s + h);
        akk = mfma32(ak, bk, akk);
        aqk = mfma32(aq, bk, aqk);
      }
    }
    const int j = 32 * qb + r;
    const float gj = gc[j];
#pragma unroll
    for (int k = 0; k < 16; ++k) {
      const int i = 32 * qa + (k & 3) + 8 * (k >> 2) + 4 * h;
      float dec = __expf(fminf(gc[i] - gj, 0.f));
      Am[i * 64 + j] = (j < i) ? akk[k] * bet[i] * dec : 0.f;
      *(u16*)(ATT + swz(i, j >> 3) + (j & 7) * 2) = f2bf((j <= i) ? aqk[k] * dec : 0.f);
    }
  }
  __syncthreads();
  u16* AMg = (u16*)p.out + (size_t)item * 16384;
  if (tid < 128) {
    const int c = tid;
    float x[64];
#pragma unroll
    for (int i = 0; i < 64; ++i) {
      const int dcol = c & 63;
      float rhs = bf2f(*(const u16*)(((c < 64) ? Cv : Ck) + swz(i, dcol >> 3) + (dcol & 7) * 2)) * bet[i] * ((c < 64) ? 1.f : eg[i]);
      float s0 = rhs, s1 = 0.f;
#pragma unroll
      for (int j4 = 0; j4 < (i + 3) / 4; ++j4) {
        f32x4 a = *(const f32x4*)(Am + i * 64 + j4 * 4);
#pragma unroll
        for (int e = 0; e < 4; ++e) {
          const int j = j4 * 4 + e;
          if (j < i) { if (e & 1) s1 -= a[e] * x[j]; else s0 -= a[e] * x[j]; }
        }
      }
      x[i] = s0 + s1;
      asm volatile("" : "+v"(x[i]) : : "memory");
    }
    if (c < 64) {
      float* U = (float*)(ws + OFF_RH) + ((size_t)item * 64 + c) * 64;
#pragma unroll
      for (int i = 0; i < 16; ++i) { f32x4 o = {x[4 * i], x[4 * i + 1], x[4 * i + 2], x[4 * i + 3]}; *(f32x4*)(U + 4 * i) = o; }
    } else {
      const int d = c - 64;
#pragma unroll
      for (int i = 0; i < 64; ++i) *(u16*)(Wt + swz(i, d >> 3) + (d & 7) * 2) = f2bf(x[i]);
    }
  } else {
    const int t2 = tid - 128;
#pragma unroll
    for (int i = 0; i < 4; ++i) {
      gdn_store_frag(AMg + 4096, Cq, t2 + 128 * i, 1.f, eg);
      gdn_store_frag(AMg + 8192, ATT, t2 + 128 * i, 0.f, nullptr);
    }
#pragma unroll
    for (int i = 0; i < 4; ++i) {
      const int idx = t2 + 128 * i, blk = idx >> 6, ln = idx & 63, rt = blk >> 1, ks = blk & 1, r = ln & 15, q = ln >> 4;
      const int d = 16 * rt + r;
      float vv[8];
#pragma unroll
      for (int j = 0; j < 8; ++j) {
        const int tk = 32 * ks + ((j < 4) ? (4 * q + j) : (16 + 4 * q + (j - 4)));
        vv[j] = bf2f(*(const u16*)(Ck + swz(tk, d >> 3) + (d & 7) * 2)) * ekd[tk];
      }
      *(bf16x8*)(AMg + 12288 + (size_t)idx * 8) = pack8(vv[0], vv[1], vv[2], vv[3], vv[4], vv[5], vv[6], vv[7]);
    }
  }
  __syncthreads();
#pragma unroll
  for (int i = 0; i < 2; ++i) gdn_store_frag(AMg, Wt, tid + 256 * i, 0.f, nullptr);
  __syncthreads();
}

DI void phase2(const Params& p, int bid, int nblk, char* smem) {
  const int total = 64 + 2048 + 4096;
  for (int it = bid; it < total; it += nblk) {
    if (it < 64) cmp_gemm_item(p, it, smem);
    else if (it < 2112) vtrans_item(p, it - 64, smem);
    else gdn_chunk_item(p, it - 2112, smem);
  }
}

DI void gdn_scan_item(const Params& p, int bh, char* smem) {
  char* ws = p.ws;
  const int tid = threadIdx.x, lane = tid & 63, w = tid >> 6, col = lane & 15, q = lane >> 4;
  const int b = bh >> 3, hd = bh & 7;
  const u16* AMg = (const u16*)p.out + (size_t)bh * 64 * 16384;
  const float* U = (const float*)(ws + OFF_RH) + (size_t)bh * 64 * 4096;
  const float* GL = (const float*)(ws + OFF_MISC + MISC_GL) + bh * 64;
  float* O = (float*)(ws + OFF_QKV);
  f32x4 S[4];
#pragma unroll
  for (int t = 0; t < 4; ++t) S[t] = f32x4{0.f, 0.f, 0.f, 0.f};
  u32x4 stg[8];
#pragma unroll
  for (int i = 0; i < 8; ++i) stg[i] = *(const u32x4*)(AMg + (size_t)(i * 256 + tid) * 8);
  f32x4 u[4];
#pragma unroll
  for (int ct = 0; ct < 4; ++ct) u[ct] = *(const f32x4*)(U + (size_t)(16 * w + col) * 64 + 16 * ct + 4 * q);
  float gl = GL[0];
  for (int n = 0; n < 64; ++n) {
    char* buf = smem + (n & 1) * 32768;
#pragma unroll
    for (int i = 0; i < 8; ++i) *(u32x4*)(buf + (i * 256 + tid) * 16) = stg[i];
    __syncthreads();
    f32x4 ucur[4];
#pragma unroll
    for (int ct = 0; ct < 4; ++ct) ucur[ct] = u[ct];
    const float glcur = gl;
    if (n + 1 < 64) {
      const u16* src = AMg + (size_t)(n + 1) * 16384;
#pragma unroll
      for (int i = 0; i < 8; ++i) stg[i] = *(const u32x4*)(src + (size_t)(i * 256 + tid) * 8);
      const float* un = U + (size_t)(n + 1) * 4096;
#pragma unroll
      for (int ct = 0; ct < 4; ++ct) u[ct] = *(const f32x4*)(un + (size_t)(16 * w + col) * 64 + 16 * ct + 4 * q);
      gl = GL[n + 1];
    }
    bf16x8 bS[2];
#pragma unroll
    for (int ks = 0; ks < 2; ++ks)
      bS[ks] = pack8(S[2 * ks][0], S[2 * ks][1], S[2 * ks][2], S[2 * ks][3], S[2 * ks + 1][0], S[2 * ks + 1][1], S[2 * ks + 1][2], S[2 * ks + 1][3]);
#define AFRAG(mat, rt, ks) (*(const bf16x8*)(buf + (mat) * 8192 + (((rt) * 2 + (ks)) * 64 + lane) * 16))
    f32x4 vn[4], o[4];
#pragma unroll
    for (int ct = 0; ct < 4; ++ct) {
      f32x4 a = f32x4{0.f, 0.f, 0.f, 0.f};
      a = mfma16(AFRAG(0, ct, 0), bS[0], a);
      a = mfma16(AFRAG(0, ct, 1), bS[1], a);
      vn[ct] = ucur[ct] - a;
      f32x4 oo = f32x4{0.f, 0.f, 0.f, 0.f};
      oo = mfma16(AFRAG(1, ct, 0), bS[0], oo);
      oo = mfma16(AFRAG(1, ct, 1), bS[1], oo);
      o[ct] = oo;
    }
    bf16x8 bV[2];
#pragma unroll
    for (int ks = 0; ks < 2; ++ks)
      bV[ks] = pack8(vn[2 * ks][0], vn[2 * ks][1], vn[2 * ks][2], vn[2 * ks][3], vn[2 * ks + 1][0], vn[2 * ks + 1][1], vn[2 * ks + 1][2], vn[2 * ks + 1][3]);
#pragma unroll
    for (int ct = 0; ct < 4; ++ct) {
      o[ct] = mfma16(AFRAG(2, ct, 0), bV[0], o[ct]);
      o[ct] = mfma16(AFRAG(2, ct, 1), bV[1], o[ct]);
      f32x4 sn = S[ct] * glcur;
      sn = mfma16(AFRAG(3, ct, 0), bV[0], sn);
      sn = mfma16(AFRAG(3, ct, 1), bV[1], sn);
      S[ct] = sn;
    }
#undef AFRAG
    float* od = O + ((size_t)b * SEQ + n * 64) * 512 + hd * 64 + 16 * w + col;
#pragma unroll
    for (int ct = 0; ct < 4; ++ct)
#pragma unroll
      for (int rg = 0; rg < 4; ++rg) od[(size_t)(16 * ct + 4 * q + rg) * 512] = o[ct][rg];
  }
  __syncthreads();
}

DI void phase_gdn_post(const Params& p, int bid, int nblk) {
  char* ws = p.ws;
  const float* O = (const float*)(ws + OFF_QKV);
  const u16* Z = (const u16*)(ws + OFF_Z);
  u16* OA = (u16*)(ws + OFF_NQ);
  const int sub = threadIdx.x & 15;
  const f32x4 gw = ((const f32x4*)p.gdn_norm)[sub];
  const size_t ngrp = (size_t)NTOK * 8;
  for (size_t gi = ((size_t)bid * NTHREADS + threadIdx.x) >> 4; gi < ngrp; gi += ((size_t)nblk * NTHREADS) >> 4) {
    f32x4 v = *(const f32x4*)(O + gi * 64 + sub * 4);
    float ss = v[0] * v[0] + v[1] * v[1] + v[2] * v[2] + v[3] * v[3];
    ss += __shfl_xor(ss, 1); ss += __shfl_xor(ss, 2); ss += __shfl_xor(ss, 4); ss += __shfl_xor(ss, 8);
    float rs = rsqrtf(ss * (1.f / 64.f) + 1e-6f);
    u32x2 zz = *(const u32x2*)(Z + gi * 64 + sub * 4);
    float z0 = bflo(zz[0]), z1 = bfhi(zz[0]), z2 = bflo(zz[1]), z3 = bfhi(zz[1]);
    u32x2 o;
    o[0] = pack2(v[0] * rs * gw[0] * (z0 * sigmoidf_(z0)), v[1] * rs * gw[1] * (z1 * sigmoidf_(z1)));
    o[1] = pack2(v[2] * rs * gw[2] * (z2 * sigmoidf_(z2)), v[3] * rs * gw[3] * (z3 * sigmoidf_(z3)));
    *(u32x2*)(OA + gi * 64 + sub * 4) = o;
  }
}

constexpr int NSA_LDS_K = 0, NSA_LDS_V = 9216, NSA_LDS_BIAS = 18432, NSA_LDS_IMP = 18432 + 8 * 132 * 4;
constexpr int NSA_LDS_Q = NSA_LDS_IMP + 4 * 8 * 68 * 4;
constexpr float NEGBIG = -1e30f;
constexpr float QK_SCALE = 0.125f * L2E;

template <int MODE>
DI void nsa_tile(const char* Kt, const char* Vt, const char* Qw, f32x16 (&O)[2], float& m, float& l,
                 const int t, const int key0, const bool slow, const bool lane_sel, const float* tab,
                 const float mfin, const float linv, float* impw) {
  const int lane = threadIdx.x & 63, r = lane & 31, h = lane >> 5;
#pragma unroll
  for (int a = 0; a < 2; ++a) {
    f32x16 S;
#pragma unroll
    for (int k = 0; k < 16; ++k) S[k] = 0.f;
#pragma unroll
    for (int s = 0; s < 4; ++s) S = mfma32(pad_frag(Kt, 32 * a + r, 2 * s + h), *(const bf16x8*)(Qw + (s * 64 + lane) * 16), S);
    if (MODE < 2 || slow) {
#pragma unroll
      for (int k = 0; k < 16; ++k) {
        const int kl = 32 * a + (k & 3) + 8 * (k >> 2) + 4 * h;
        int dist;
        if (MODE < 2) dist = t - (16 * (key0 + kl) + 31); else dist = t - (key0 + kl);
        bool valid = (dist >= 0) && lane_sel;
        if (MODE == 3) valid = valid && (dist < 512);
        int di = dist < 0 ? 0 : (dist > 128 ? 128 : dist);
        float bias = tab[di];
        S[k] = valid ? fmaf(S[k], QK_SCALE, bias) : NEGBIG;
      }
    } else {
      const float c31 = tab[128];
#pragma unroll
      for (int k = 0; k < 16; ++k) S[k] = lane_sel ? fmaf(S[k], QK_SCALE, c31) : NEGBIG;
    }
    if (MODE == 1) {
#pragma unroll
      for (int k = 0; k < 16; ++k) S[k] = (S[k] > -1e29f) ? exp2f(S[k] - mfin) * linv : 0.f;
    } else {
      float mx = S[0];
#pragma unroll
      for (int k = 1; k < 16; ++k) mx = fmaxf(mx, S[k]);
      mx = fmaxf(mx, __shfl_xor(mx, 32));
      const float mn = fmaxf(m, mx);
      const float alpha = exp2f(m - mn);
      float ps = 0.f;
#pragma unroll
      for (int k = 0; k < 16; ++k) { S[k] = (S[k] > -1e29f) ? exp2f(S[k] - mn) : 0.f; ps += S[k]; }
      l = l * alpha + ps;
      m = mn;
      if (MODE != 0) {
#pragma unroll
        for (int dt = 0; dt < 2; ++dt)
#pragma unroll
          for (int k = 0; k < 16; ++k) O[dt][k] *= alpha;
      }
    }
    if (MODE == 1) {
#pragma unroll
      for (int g4 = 0; g4 < 4; ++g4) {
        float mainv = S[4 * g4] + S[4 * g4 + 1] + S[4 * g4 + 2] + 0.5f * S[4 * g4 + 3];
        float spill = 0.5f * S[4 * g4 + 3];
        mainv += __shfl_xor(mainv, 8); mainv += __shfl_xor(mainv, 16);
        spill += __shfl_xor(spill, 8); spill += __shfl_xor(spill, 16);
        const int blk = ((key0 + 32 * a) >> 2) + 2 * g4 + h;
        if (r < 8) { atomicAdd(&impw[r * 68 + blk], mainv); atomicAdd(&impw[r * 68 + blk + 1], spill); }
      }
    }
    if (MODE != 0) {
      bf16x8 P0 = pack8(S[0], S[1], S[2], S[3], S[4], S[5], S[6], S[7]);
      bf16x8 P1 = pack8(S[8], S[9], S[10], S[11], S[12], S[13], S[14], S[15]);
#pragma unroll
      for (int dt = 0; dt < 2; ++dt) {
        O[dt] = mfma32(pad_frag(Vt, 32 * dt + r, 4 * a + h), P0, O[dt]);
        O[dt] = mfma32(pad_frag(Vt, 32 * dt + r, 4 * a + 2 + h), P1, O[dt]);
      }
    }
  }
}

struct NsaSrc { const u16* k; long kld; const u16* v; long vld; };

DI void nsa_item(const Params& p, const int bg, const int hq, char* smem) {
  char* ws = p.ws;
  const int tid = threadIdx.x, lane = tid & 63, w = tid >> 6, r = lane & 31, h = lane >> 5;
  const int b = bg >> 1, g = bg & 1, qi = hq >> 1;
  const int t = 32 * hq + 8 * w + (r & 7);
  const int head = g * 4 + (r >> 3);
  const size_t trow = (size_t)b * SEQ + t;
  char* Kt = smem + NSA_LDS_K;
  char* Vt = smem + NSA_LDS_V;
  float* biasl = (float*)(smem + NSA_LDS_BIAS);
  float* impw = (float*)(smem + NSA_LDS_IMP) + w * (8 * 68);
  char* Q = smem + NSA_LDS_Q + w * 4096;
  const u16* NKV = (const u16*)(ws + OFF_NKV);
  __syncthreads();
  for (int i = tid; i < 8 * 132; i += NTHREADS) biasl[i] = ((const float*)(ws + OFF_MISC + MISC_BIAS))[i];
  for (int i = lane; i < 8 * 68; i += 64) impw[i] = 0.f;
  {
    const u16* NQ = (const u16*)(ws + OFF_NQ);
#pragma unroll
    for (int s = 0; s < 4; ++s) *(bf16x8*)(Q + (s * 64 + lane) * 16) = *(const bf16x8*)(NQ + trow * 512 + head * 64 + 16 * s + 8 * h);
  }
  const float* tab = biasl + head * 132;
  __syncthreads();
  f32x16 O[2];
  float m, l, mfin = 0.f, linv = 0.f;
  u16* OB = (u16*)(ws + OFF_QKV + (size_t)NTOK * 512 * 4);
  auto reset = [&]() {
#pragma unroll
    for (int dt = 0; dt < 2; ++dt)
#pragma unroll
      for (int k = 0; k < 16; ++k) O[dt][k] = 0.f;
    m = NEGBIG; l = 0.f;
  };
  u32x4 sk[2], sv[2];
  auto stage_load = [&](const NsaSrc& s) {
#pragma unroll
    for (int i = 0; i < 2; ++i) {
      const int c = tid + 256 * i, row = c >> 3, ch = c & 7;
      sk[i] = *(const u32x4*)(s.k + (size_t)row * s.kld + ch * 8);
      sv[i] = *(const u32x4*)(s.v + (size_t)row * s.vld + ch * 8);
    }
  };
  auto stage_store = [&]() {
#pragma unroll
    for (int i = 0; i < 2; ++i) {
      const int c = tid + 256 * i, row = c >> 3, ch = c & 7;
      *(u32x4*)(Kt + row * 144 + ch * 16) = sk[i];
      *(u32x4*)(Vt + row * 144 + ch * 16) = sv[i];
    }
  };
  auto src_cmp = [&](int tt) { NsaSrc s; s.k = (const u16*)(ws + OFF_KC) + ((size_t)bg * 256 + 64 * tt) * 64; s.kld = 64;
                               s.v = (const u16*)(ws + OFF_VCT) + (size_t)bg * 64 * 256 + 64 * tt; s.vld = 256; return s; };
  auto src_slc = [&](int j) { NsaSrc s; s.k = NKV + ((size_t)b * SEQ + 64 * j) * 768 + 256 + g * 64; s.kld = 768;
                              s.v = (const u16*)(ws + OFF_VST) + (size_t)bg * 64 * 4096 + 64 * j; s.vld = 4096; return s; };
  auto src_win = [&](int j) { NsaSrc s; s.k = NKV + ((size_t)b * SEQ + 64 * j) * 768 + 512 + g * 64; s.kld = 768;
                              s.v = (const u16*)(ws + OFF_VWT) + (size_t)bg * 64 * 4096 + 64 * j; s.vld = 4096; return s; };
  auto gatev = [&](int br) { return sigmoidf_(((const float*)(ws + OFF_SM))[trow * 40 + 16 + head * 3 + br]); };
  auto emit = [&](const float wgt, bool first) {
#pragma unroll
    for (int dt = 0; dt < 2; ++dt)
#pragma unroll
      for (int g4 = 0; g4 < 4; ++g4) {
        u16* dst = OB + trow * 512 + head * 64 + 32 * dt + 8 * g4 + 4 * h;
        float v0 = O[dt][4 * g4] * wgt, v1 = O[dt][4 * g4 + 1] * wgt, v2 = O[dt][4 * g4 + 2] * wgt, v3 = O[dt][4 * g4 + 3] * wgt;
        if (!first) {
          u32x2 old = *(const u32x2*)dst;
          v0 += bflo(old[0]); v1 += bfhi(old[0]); v2 += bflo(old[1]); v3 += bfhi(old[1]);
        }
        u32x2 o; o[0] = pack2(v0, v1); o[1] = pack2(v2, v3);
        *(u32x2*)dst = o;
      }
  };

  const int ntc = (2 * hq + 1 + 63) >> 6;
  reset();
  stage_load(src_cmp(0));
  for (int tt = 0; tt < ntc; ++tt) {
    __syncthreads(); stage_store(); __syncthreads();
    if (tt + 1 < ntc) stage_load(src_cmp(tt + 1)); else stage_load(src_cmp(0));
    nsa_tile<0>(Kt, Vt, Q, O, m, l, t, 64 * tt, true, true, tab, mfin, linv, impw);
  }
  { float lt = l + __shfl_xor(l, 32); mfin = m; linv = lt > 0.f ? 1.f / lt : 0.f; }
  for (int tt = 0; tt < ntc; ++tt) {
    __syncthreads(); stage_store(); __syncthreads();
    if (tt + 1 < ntc) stage_load(src_cmp(tt + 1)); else stage_load(src_slc(0));
    nsa_tile<1>(Kt, Vt, Q, O, m, l, t, 64 * tt, true, true, tab, mfin, linv, impw);
  }
  emit(gatev(0), true);
  unsigned sel_lo, sel_hi;
  if (qi < 16) {
    unsigned long long mk = (2ull << qi) - 1ull;
    sel_lo = (unsigned)mk; sel_hi = (unsigned)(mk >> 32);
  } else {
    unsigned long long mk = 0ull;
    const float* row = impw + (lane & 7) * 68;
    const int part = lane >> 3, hiM = qi - 2;
    for (int mm = 1 + part; mm <= hiM; mm += 8) {
      const float v = row[mm];
      int rank = 0;
      for (int m2 = 1; m2 <= hiM; ++m2) { const float u = row[m2]; rank += ((u > v) || (u == v && m2 < mm)) ? 1 : 0; }
      if (rank < 13) mk |= 1ull << mm;
    }
    mk |= 1ull | (1ull << qi) | (1ull << (qi - 1));
    sel_lo = (unsigned)mk; sel_hi = (unsigned)(mk >> 32);
    sel_lo |= __shfl_xor(sel_lo, 8); sel_hi |= __shfl_xor(sel_hi, 8);
    sel_lo |= __shfl_xor(sel_lo, 16); sel_hi |= __shfl_xor(sel_hi, 16);
    sel_lo |= __shfl_xor(sel_lo, 32); sel_hi |= __shfl_xor(sel_hi, 32);
  }
  reset();
  for (int j = 0; j <= qi; ++j) {
    __syncthreads(); stage_store(); __syncthreads();
    if (j + 1 <= qi) stage_load(src_slc(j + 1)); else stage_load(src_win(qi >= 8 ? qi - 8 : 0));
    const bool lsel = ((j < 32 ? (sel_lo >> j) : (sel_hi >> (j - 32))) & 1u) != 0u;
    nsa_tile<2>(Kt, Vt, Q, O, m, l, t, 64 * j, (qi - j) <= 2, lsel, tab, mfin, linv, impw);
  }
  { float lt = l + __shfl_xor(l, 32); emit(lt > 0.f ? gatev(1) / lt : 0.f, false); }
  reset();
  const int j0 = qi >= 8 ? qi - 8 : 0;
  for (int j = j0; j <= qi; ++j) {
    __syncthreads(); stage_store(); __syncthreads();
    if (j + 1 <= qi) stage_load(src_win(j + 1));
    nsa_tile<3>(Kt, Vt, Q, O, m, l, t, 64 * j, ((qi - j) <= 2) || ((qi - j) == 8), true, tab, mfin, linv, impw);
  }
  { float lt = l + __shfl_xor(l, 32); emit(lt > 0.f ? gatev(2) / lt : 0.f, false); }
}

DI void phase4(const Params& p, char* smem) {
  unsigned* cnt = (unsigned*)(p.ws + OFF_MISC + MISC_CNT);
  __shared__ int s_item;
  for (;;) {
    __syncthreads();
    if (threadIdx.x == 0) s_item = (int)atomicAdd(cnt, 1u);
    __syncthreads();
    const int it = __builtin_amdgcn_readfirstlane(s_item);
    if (it >= 64 + 2048) break;
    if (it < 64) gdn_scan_item(p, it, smem);
    else { const int k = it - 64; nsa_item(p, k & 15, 127 - (k >> 4), smem); }
  }
}

DI void phase_branch(const Params& p, int bid, int nblk, char* smem) {
  char* ws = p.ws;
  const u16* OA = (const u16*)(ws + OFF_NQ);
  const u16* OB = (const u16*)(ws + OFF_QKV + (size_t)NTOK * 512 * 4);
  const u16* MG = (const u16*)(ws + OFF_MG);
  u16* MIX = (u16*)(ws + OFF_RH);
  for (int t = bid; t < 256 * 8; t += nblk) {
    const int mt = t >> 3, nt = t & 7, m0 = mt * 128, n0 = nt * 128;
    GemmPtrs g;
    f32x16 acc[2][2];
    gemm_setup(g, OA, 512, m0, (const u16*)(ws + OFF_WAT), 512, n0);
    zero_acc(acc);
    gemm_kloop(acc, g, 8, smem);
    gemm_epilogue_lds(acc, smem, [&](int ml, int nl, const float (&v)[8]) {
      const size_t m = m0 + ml; const int n = n0 + nl;
      const u32x4 gt = *(const u32x4*)(MG + m * 2048 + n);
      float t[8];
#pragma unroll
      for (int e = 0; e < 4; ++e) { t[2 * e] = v[2 * e] * sigmoidf_(bflo(gt[e])); t[2 * e + 1] = v[2 * e + 1] * sigmoidf_(bfhi(gt[e])); }
      *(u32x4*)(MIX + m * 1024 + n) = pack8u(t);
    });
    gemm_setup(g, OB, 512, m0, (const u16*)(ws + OFF_WBT), 512, n0);
    zero_acc(acc);
    gemm_kloop(acc, g, 8, smem);
    gemm_epilogue_lds(acc, smem, [&](int ml, int nl, const float (&v)[8]) {
      const size_t m = m0 + ml; const int n = n0 + nl;
      const u32x4 gt = *(const u32x4*)(MG + m * 2048 + 1024 + n);
      const u32x4 old = *(const u32x4*)(MIX + m * 1024 + n);
      float t[8];
#pragma unroll
      for (int e = 0; e < 4; ++e) {
        t[2 * e] = bflo(old[e]) + v[2 * e] * sigmoidf_(bflo(gt[e]));
        t[2 * e + 1] = bfhi(old[e]) + v[2 * e + 1] * sigmoidf_(bfhi(gt[e]));
      }
      *(u32x4*)(MIX + m * 1024 + n) = pack8u(t);
    });
  }
}

DI void phase_outproj(const Params& p, int bid, int nblk, char* smem) {
  char* ws = p.ws;
  const u16* MIX = (const u16*)(ws + OFF_RH);
  for (int t = bid; t < 256 * 8; t += nblk) {
    const int mt = t >> 3, nt = t & 7, m0 = mt * 128, n0 = nt * 128;
    GemmPtrs g;
    f32x16 acc[2][2];
    gemm_setup(g, MIX, 1024, m0, (const u16*)(ws + OFF_WOT), 1024, n0);
    zero_acc(acc);
    gemm_kloop(acc, g, 16, smem);
    gemm_epilogue_lds(acc, smem, [&](int ml, int nl, const float (&v)[8]) {
      const size_t idx = (size_t)(m0 + ml) * 1024 + n0 + nl;
      const f32x4 x0 = *(const f32x4*)(p.x + idx), x1 = *(const f32x4*)(p.x + idx + 4);
      *(f32x4*)(p.out + idx) = f32x4{x0[0] + v[0], x0[1] + v[1], x0[2] + v[2], x0[3] + v[3]};
      *(f32x4*)(p.out + idx + 4) = f32x4{x1[0] + v[4], x1[1] + v[5], x1[2] + v[6], x1[3] + v[7]};
    });
  }
}

DI void phase_query(const Params& p, int bid, int nblk, char* smem) {
  char* ws = p.ws;
  const u16* H2 = (const u16*)(ws + OFF_RH);
  u16* QRY = (u16*)(ws + OFF_MG);
  for (int t = bid; t < 256 * 16; t += nblk) {
    const int mt = t >> 4, nt = t & 15, m0 = mt * 128, n0 = nt * 128;
    GemmPtrs g;
    f32x16 acc[2][2];
    gemm_setup(g, H2, 1024, m0, (const u16*)(ws + OFF_WQT), 1024, n0);
    zero_acc(acc);
    gemm_kloop(acc, g, 16, smem);
    gemm_epilogue_lds(acc, smem, [&](int ml, int nl, const float (&v)[8]) { *(u32x4*)(QRY + (size_t)(m0 + ml) * 2048 + n0 + nl) = pack8u(v); });
  }
}

DI unsigned f2ord(float f) { unsigned u = __float_as_uint(f); return (u & 0x80000000u) ? ~u : (u | 0x80000000u); }
DI float ord2f(unsigned o) { unsigned u = (o & 0x80000000u) ? (o & 0x7fffffffu) : ~o; return __uint_as_float(u); }

DI void peer_route_job(const Params& p, int job, char* smem) {
  char* ws = p.ws;
  const int mt = job >> 3, hd = job & 7, m0 = mt * 128;
  const u16* QRY = (const u16*)(ws + OFF_MG);
  const u16* SK = (const u16*)(ws + OFF_SK);
  unsigned* keys = (unsigned*)smem;
  const int tid = threadIdx.x + opaque0();
  unsigned top[2][16];
#pragma unroll
  for (int pp = 0; pp < 2; ++pp) {
    GemmPtrs g;
    f32x16 acc[2][2];
    gemm_setup(g, QRY + (hd * 2 + pp) * 128, 2048, m0, SK + (size_t)(hd * 2 + pp) * 128 * 128, 128, 0);
    zero_acc(acc);
    gemm_kloop(acc, g, 2, smem);
    gemm_epilogue(acc, [&](int ml, int nl, float v) { keys[ml * 129 + nl] = (f2ord(v) & ~127u) | (unsigned)(127 - nl); });
    __syncthreads();
    if (tid < 128) {
      const unsigned* row = keys + tid * 129;
      unsigned prev = 0xffffffffu;
#pragma unroll
      for (int rd = 0; rd < 16; ++rd) {
        unsigned best = 0u;
#pragma unroll 8
        for (int j = 0; j < 128; ++j) { unsigned k = row[j]; k = (k < prev) ? k : 0u; best = (k > best) ? k : best; }
        top[pp][rd] = best; prev = best;
      }
    }
    __syncthreads();
  }
  if (tid < 128) {
    float v1[16], v2[16];
    int i1[16], i2[16];
#pragma unroll
    for (int i = 0; i < 16; ++i) {
      v1[i] = ord2f(top[0][i] & ~127u); i1[i] = 127 - (int)(top[0][i] & 127u);
      v2[i] = ord2f(top[1][i] & ~127u); i2[i] = 127 - (int)(top[1][i] & 127u);
    }
    float pv = 3.0e38f; int pf = -1;
    float selv[16];
    int* EI = (int*)(ws + OFF_Z) + ((size_t)(m0 + tid) * 128 + hd * 16);
    float* GT = (float*)(ws + OFF_Z + (size_t)NTOK * 128 * 4) + ((size_t)(m0 + tid) * 128 + hd * 16);
#pragma unroll
    for (int rd = 0; rd < 16; ++rd) {
      float bv = -3.0e38f; int bf = 1 << 20, be = 0;
#pragma unroll
      for (int i = 0; i < 16; ++i)
#pragma unroll
        for (int j = 0; j < 16; ++j)
          if ((i + 1) * (j + 1) <= 16) {
            const float c = v1[i] + v2[j];
            const int fl = i * 16 + j;
            const bool elig = (c < pv) || (c == pv && fl > pf);
            const bool better = elig && (c > bv);
            bv = better ? c : bv; bf = better ? fl : bf; be = better ? (i1[i] * 128 + i2[j]) : be;
          }
      selv[rd] = bv; pv = bv; pf = bf;
      EI[rd] = be;
    }
    float sum = 0.f;
    const float mx = selv[0];
#pragma unroll
    for (int k = 0; k < 16; ++k) { selv[k] = __expf(selv[k] - mx); sum += selv[k]; }
    const float inv = 1.f / sum;
#pragma unroll
    for (int k = 0; k < 16; ++k) GT[k] = selv[k] * inv;
  }
}

DI float gelu_tanh(float x) {
  const float u = 0.7978845608028654f * (x + 0.044715f * x * x * x);
  const float e = __expf(2.f * u);
  const float th = 1.f - 2.f / (e + 1.f);
  return 0.5f * x * (1.f + th);
}
DI float dot8(u32x4 a, u32x4 b, float acc) {
#pragma unroll
  for (int i = 0; i < 4; ++i) {
    acc += bflo(a[i]) * bflo(b[i]) + bfhi(a[i]) * bfhi(b[i]);
  }
  return acc;
}
DI void peer_expert_phase(const Params& p, int bid, int nblk) {
  char* ws = p.ws;
  const int lane = threadIdx.x & 63, wv = threadIdx.x >> 6;
  const u16* EU = (const u16*)(ws + OFF_EU);
  const u16* EV = (const u16*)(ws + OFF_EV);
  const int* EI = (const int*)(ws + OFF_Z);
  const float* GT = (const float*)(ws + OFF_Z + (size_t)NTOK * 128 * 4);
  for (int tok = bid * 4 + wv; tok < NTOK; tok += nblk * 4) {
    const float* xr = p.out + (size_t)tok * 1024;
    f32x4 xa[4];
    xa[0] = *(const f32x4*)(xr + 8 * lane); xa[1] = *(const f32x4*)(xr + 8 * lane + 4);
    xa[2] = *(const f32x4*)(xr + 512 + 8 * lane); xa[3] = *(const f32x4*)(xr + 512 + 8 * lane + 4);
    float ss = 0.f;
#pragma unroll
    for (int i = 0; i < 4; ++i) ss += xa[i][0] * xa[i][0] + xa[i][1] * xa[i][1] + xa[i][2] * xa[i][2] + xa[i][3] * xa[i][3];
    ss = wave_sum(ss);
    const float rs = rsqrtf(ss * (1.f / 1024.f) + 1e-6f);
    u32x4 hA, hB;
    {
      const f32x4 w0 = *(const f32x4*)(p.norm_ffn + 8 * lane), w1 = *(const f32x4*)(p.norm_ffn + 8 * lane + 4);
      const f32x4 w2 = *(const f32x4*)(p.norm_ffn + 512 + 8 * lane), w3 = *(const f32x4*)(p.norm_ffn + 512 + 8 * lane + 4);
      hA[0] = pack2(xa[0][0] * rs * w0[0], xa[0][1] * rs * w0[1]); hA[1] = pack2(xa[0][2] * rs * w0[2], xa[0][3] * rs * w0[3]);
      hA[2] = pack2(xa[1][0] * rs * w1[0], xa[1][1] * rs * w1[1]); hA[3] = pack2(xa[1][2] * rs * w1[2], xa[1][3] * rs * w1[3]);
      hB[0] = pack2(xa[2][0] * rs * w2[0], xa[2][1] * rs * w2[1]); hB[1] = pack2(xa[2][2] * rs * w2[2], xa[2][3] * rs * w2[3]);
      hB[2] = pack2(xa[3][0] * rs * w3[0], xa[3][1] * rs * w3[1]); hB[3] = pack2(xa[3][2] * rs * w3[2], xa[3][3] * rs * w3[3]);
    }
    float outv[16];
#pragma unroll
    for (int i = 0; i < 16; ++i) outv[i] = 0.f;
#pragma unroll 1
    for (int bt = 0; bt < 2; ++bt) {
      const int eidx = EI[(size_t)tok * 128 + bt * 64 + lane];
      const float gt = GT[(size_t)tok * 128 + bt * 64 + lane];
      float acc[64];
#pragma unroll
      for (int e = 0; e < 64; ++e) {
        const int ei = __builtin_amdgcn_readlane(eidx, e);
        const u16* ur = EU + (size_t)ei * 1024;
        u32x4 a = *(const u32x4*)(ur + 8 * lane), bq = *(const u32x4*)(ur + 512 + 8 * lane);
        acc[e] = dot8(bq, hB, dot8(a, hA, 0.f));
      }
#pragma unroll
      for (int st = 0; st < 6; ++st) {
        const int half = 32 >> st;
        const bool up = (lane & half) != 0;
#pragma unroll
        for (int k = 0; k < half; ++k) {
          const float send = up ? acc[k] : acc[k + half];
          const float keep = up ? acc[k + half] : acc[k];
          acc[k] = keep + __shfl_xor(send, half);
        }
      }
      const float wgt = gt * gelu_tanh(acc[0]);
#pragma unroll
      for (int e = 0; e < 64; ++e) {
        const int ei = __builtin_amdgcn_readlane(eidx, e);
        const float we = __uint_as_float((unsigned)__builtin_amdgcn_readlane((int)__float_as_uint(wgt), e));
        const u16* vr = EV + (size_t)ei * 1024;
        u32x4 a = *(const u32x4*)(vr + 8 * lane), bq = *(const u32x4*)(vr + 512 + 8 * lane);
#pragma unroll
        for (int i = 0; i < 4; ++i) {
          outv[2 * i] += we * bflo(a[i]); outv[2 * i + 1] += we * bfhi(a[i]);
          outv[8 + 2 * i] += we * bflo(bq[i]); outv[8 + 2 * i + 1] += we * bfhi(bq[i]);
        }
      }
    }
    float x2[16];
#pragma unroll
    for (int i = 0; i < 4; ++i)
#pragma unroll
      for (int e = 0; e < 4; ++e) x2[4 * i + e] = xa[i][e] + outv[4 * i + e];
    float s2 = 0.f;
#pragma unroll
    for (int i = 0; i < 16; ++i) s2 += x2[i] * x2[i];
    s2 = wave_sum(s2);
    const float r2 = rsqrtf(s2 * (1.f / 1024.f) + 1e-6f);
    float* orow = p.out + (size_t)tok * 1024;
#pragma unroll
    for (int i = 0; i < 4; ++i) {
      const int base = (i < 2 ? 0 : 512) + 8 * lane + 4 * (i & 1);
      const f32x4 nw = *(const f32x4*)(p.norm_final + base);
      f32x4 o = {x2[4 * i] * r2 * nw[0], x2[4 * i + 1] * r2 * nw[1], x2[4 * i + 2] * r2 * nw[2], x2[4 * i + 3] * r2 * nw[3]};
      *(f32x4*)(orow + base) = o;
    }
  }
}

#ifndef MK_SINGLE
#define MK_SINGLE 1
#endif
#define SMEM_DECL __shared__ __attribute__((aligned(16))) char smem[SMEM_BYTES]

DI void run_phase(const Params& p, int ph, int bid, int nblk, char* smem) {
  switch (ph) {
    case 0: phase0(p, bid, nblk, smem); break;
    case 1: phase_inproj(p, bid, nblk, smem); break;
    case 2: phase2(p, bid, nblk, smem); break;
    case 3: phase4(p, smem); break;
    case 4: phase_gdn_post(p, bid, nblk); break;
    case 5: phase_branch(p, bid, nblk, smem); break;
    case 6: phase_outproj(p, bid, nblk, smem); break;
    case 7: rmsnorm_rows_bf16(p.out, p.norm_ffn, (u16*)(p.ws + OFF_RH), NTOK, bid, nblk); break;
    case 8: phase_query(p, bid, nblk, smem); break;
    case 9: for (int j = bid; j < 2048; j += nblk) peer_route_job(p, j, smem); break;
    case 10: peer_expert_phase(p, bid, nblk); break;
  }
}
constexpr int NPHASES = 11;

#if MK_SINGLE
__global__ void __launch_bounds__(NTHREADS, 2) fwd_megakernel(Params p) {
  SMEM_DECL;
  cg::grid_group grid = cg::this_grid();
  const int bid = blockIdx.x, nblk = gridDim.x;
  run_phase(p, 0, bid, nblk, smem); grid.sync();
  run_phase(p, 1, bid, nblk, smem); grid.sync();
  run_phase(p, 2, bid, nblk, smem); grid.sync();
  run_phase(p, 3, bid, nblk, smem); grid.sync();
  run_phase(p, 4, bid, nblk, smem); grid.sync();
  run_phase(p, 5, bid, nblk, smem); grid.sync();
  run_phase(p, 6, bid, nblk, smem); grid.sync();
  run_phase(p, 7, bid, nblk, smem); grid.sync();
  run_phase(p, 8, bid, nblk, smem); grid.sync();
  run_phase(p, 9, bid, nblk, smem); grid.sync();
  run_phase(p, 10, bid, nblk, smem);
}
#else
template <int PH>
__global__ void __launch_bounds__(NTHREADS, 2) phase_kernel(Params p) {
  SMEM_DECL;
  run_phase(p, PH, blockIdx.x, gridDim.x, smem);
}
#endif

extern "C" void kernel_launch(void* const* d_in, const int* in_sizes, int n_in, void* d_out, int out_size, void* d_ws, size_t ws_size,
                              hipStream_t stream) {
  Params p{};
  const float** f = (const float**)&p;
  for (int i = 0; i < 21; ++i) f[i] = (const float*)d_in[i];
  p.out = (float*)d_out;
  p.ws = (char*)d_ws;
  if (ws_size < WS_NEEDED) return;
#if MK_SINGLE
  static int grid_blocks = 0;
  if (!grid_blocks) {
    int dev = 0, cus = 0, per_cu = 0;
    hipGetDevice(&dev);
    hipDeviceGetAttribute(&cus, hipDeviceAttributeMultiprocessorCount, dev);
    hipOccupancyMaxActiveBlocksPerMultiprocessor(&per_cu, fwd_megakernel, NTHREADS, 0);
    if (per_cu > 2) per_cu = 2;
    grid_blocks = cus * per_cu;
  }
  void* args[] = {&p};
  hipLaunchCooperativeKernel((void*)fwd_megakernel, dim3(grid_blocks), dim3(NTHREADS), args, 0, stream);
#else
  const int G = 512;
  phase_kernel<0><<<G, NTHREADS, 0, stream>>>(p);
  phase_kernel<1><<<G, NTHREADS, 0, stream>>>(p);
  phase_kernel<2><<<G, NTHREADS, 0, stream>>>(p);
  phase_kernel<3><<<G, NTHREADS, 0, stream>>>(p);
  phase_kernel<4><<<G, NTHREADS, 0, stream>>>(p);
  phase_kernel<5><<<G, NTHREADS, 0, stream>>>(p);
  phase_kernel<6><<<G, NTHREADS, 0, stream>>>(p);
  phase_kernel<7><<<G, NTHREADS, 0, stream>>>(p);
  phase_kernel<8><<<G, NTHREADS, 0, stream>>>(p);
  phase_kernel<9><<<G, NTHREADS, 0, stream>>>(p);
  phase_kernel<10><<<G, NTHREADS, 0, stream>>>(p);
#endif
}
```

```cpp
#include <hip/hip_runtime.h>
#include <hip/hip_cooperative_groups.h>
#include <stdint.h>
namespace cg = cooperative_groups;

#define DI __device__ __forceinline__
typedef unsigned short u16;
typedef __attribute__((ext_vector_type(8))) short bf16x8;
typedef __attribute__((ext_vector_type(16))) float f32x16;
typedef __attribute__((ext_vector_type(4))) float f32x4;
typedef __attribute__((ext_vector_type(4))) unsigned u32x4;
typedef __attribute__((ext_vector_type(2))) unsigned u32x2;
typedef __attribute__((ext_vector_type(2))) __bf16 bf16x2v;

constexpr int BATCH = 8, SEQ = 4096, DM = 1024, NTOK = BATCH * SEQ;
constexpr int NIN = 5416, NP = 5504;
constexpr int NTHREADS = 256;
constexpr int SMEM_BYTES = 72 * 1024;
constexpr float L2E = 1.4426950408889634f;

constexpr size_t AL(size_t x) { return (x + 255) & ~(size_t)255; }
constexpr size_t OFF_WINT = 0;
constexpr size_t OFF_WAT = OFF_WINT + AL((size_t)NP * 1024 * 2);
constexpr size_t OFF_WBT = OFF_WAT + AL((size_t)1024 * 512 * 2);
constexpr size_t OFF_WOT = OFF_WBT + AL((size_t)1024 * 512 * 2);
constexpr size_t OFF_WQT = OFF_WOT + AL((size_t)1024 * 1024 * 2);
constexpr size_t OFF_SK = OFF_WQT + AL((size_t)2048 * 1024 * 2);
constexpr size_t OFF_WKT = OFF_SK + AL((size_t)16 * 128 * 128 * 2);
constexpr size_t OFF_WVT = OFF_WKT + AL((size_t)128 * 2048 * 2);
constexpr size_t OFF_EU = OFF_WVT + AL((size_t)128 * 2048 * 2);
constexpr size_t OFF_EV = OFF_EU + AL((size_t)16384 * 1024 * 2);
constexpr size_t OFF_MISC = OFF_EV + AL((size_t)16384 * 1024 * 2);
constexpr size_t MISC_CK = 0, MISC_CV = 256, MISC_BIAS = 512, MISC_CNT = 512 + 8 * 132 * 4 + 256, MISC_GL = 8192;
constexpr size_t MISC_SCU = 65536, MISC_SCV = 131072;
constexpr size_t OFF_RH = OFF_MISC + 262144;
constexpr size_t OFF_QKV = OFF_RH + (size_t)NTOK * 1024 * 2;
constexpr size_t OFF_Z = OFF_QKV + (size_t)NTOK * 1536 * 2;
constexpr size_t OFF_NQ = OFF_Z + (size_t)NTOK * 512 * 2;
constexpr size_t OFF_NKV = OFF_NQ + (size_t)NTOK * 512 * 2;
constexpr size_t OFF_MG = OFF_NKV + (size_t)NTOK * 768 * 2;
constexpr size_t OFF_SM = OFF_MG + (size_t)NTOK * 2048 * 2;
constexpr size_t OFF_VST = OFF_SM + AL((size_t)NTOK * 40 * 4);
constexpr size_t OFF_VWT = OFF_VST + (size_t)16 * 64 * 4096 * 2;
constexpr size_t OFF_KC = OFF_VWT + (size_t)16 * 64 * 4096 * 2;
constexpr size_t OFF_VCT = OFF_KC + (size_t)16 * 256 * 64 * 2;
constexpr size_t WS_NEEDED = OFF_VCT + (size_t)16 * 64 * 256 * 2;

struct Params {
  const float *x, *rel_bias, *norm_final, *norm_mix, *w_in, *conv_w, *a_log, *dt_bias, *gdn_norm, *cmp_pe_k, *cmp_pe_v,
      *cmp_w_k, *cmp_w_v, *w_a, *w_b, *w_out, *norm_ffn, *w_query, *sub_keys, *expert_u, *expert_v;
  float* out;
  char* ws;
};

DI u16 f2bf(float x) { return __builtin_bit_cast(u16, (__bf16)x); }
DI float bf2f(u16 b) { return __uint_as_float(((unsigned)b) << 16); }
DI unsigned pack2(float lo, float hi) { return (unsigned)f2bf(lo) | ((unsigned)f2bf(hi) << 16); }
DI float bflo(unsigned u) { return __uint_as_float(u << 16); }
DI float bfhi(unsigned u) { return __uint_as_float(u & 0xffff0000u); }
DI float wave_sum(float v) {
#pragma unroll
  for (int o = 32; o >= 1; o >>= 1) v += __shfl_xor(v, o);
  return v;
}
DI int opaque0() { int z = 0; asm volatile("" : "+v"(z)); return z; }
DI float sigmoidf_(float x) { return 1.f / (1.f + __expf(-x)); }
DI f32x16 mfma32(bf16x8 a, bf16x8 b, f32x16 c) { return __builtin_amdgcn_mfma_f32_32x32x16_bf16(a, b, c, 0, 0, 0); }
DI f32x4 mfma16(bf16x8 a, bf16x8 b, f32x4 c) { return __builtin_amdgcn_mfma_f32_16x16x32_bf16(a, b, c, 0, 0, 0); }
DI int swz(int row, int ch) { return row * 128 + ((ch ^ ((row >> 1) & 7)) << 4); }
DI bf16x8 lds_frag(const char* tile, int row, int ch) { return *(const bf16x8*)(tile + swz(row, ch)); }
DI bf16x8 pad_frag(const char* tile, int row, int ch) { return *(const bf16x8*)(tile + row * 144 + ch * 16); }
DI bf16x8 pack8(float a0, float a1, float a2, float a3, float a4, float a5, float a6, float a7) {
  u32x4 p;
  p[0] = pack2(a0, a1); p[1] = pack2(a2, a3); p[2] = pack2(a4, a5); p[3] = pack2(a6, a7);
  return __builtin_bit_cast(bf16x8, p);
}
DI int perm16(int o) { return (o & ~12) | ((o & 4) << 1) | ((o & 8) >> 1); }

DI int win_colmap(int n) {
  if (n < 2048) return n;
  if (n < 2560) return n - 2048 + 2064;
  if (n < 3328) return n - 2560 + 2576;
  if (n < 5376) return n - 3328 + 3368;
  if (n < 5392) return n - 5376 + 2048;
  if (n < 5416) return n - 5392 + 3344;
  return -1;
}
template <int MAPMODE>
DI void tconv_tile(const float* __restrict__ src, int K, int N, u16* __restrict__ dst, int kt, int nt, char* smem) {
  float* tile = (float*)smem;
  const int tid = threadIdx.x;
  const int nl = tid & 63, k0 = kt * 64, n0 = nt * 64;
  int col;
  if (MAPMODE == 1) col = win_colmap(n0 + nl); else col = (n0 + nl < N) ? (n0 + nl) : -1;
#pragma unroll 4
  for (int i = 0; i < 16; ++i) {
    int kl = (tid >> 6) + 4 * i;
    float v = (col >= 0) ? src[(size_t)(k0 + kl) * N + col] : 0.f;
    tile[kl * 65 + nl] = v;
  }
  __syncthreads();
  {
    const int n2 = tid >> 2, kp = tid & 3;
    u32x4 o0, o1;
#pragma unroll
    for (int i = 0; i < 4; ++i) {
      o0[i] = pack2(tile[(kp * 16 + 2 * i) * 65 + n2], tile[(kp * 16 + 2 * i + 1) * 65 + n2]);
      o1[i] = pack2(tile[(kp * 16 + 8 + 2 * i) * 65 + n2], tile[(kp * 16 + 8 + 2 * i + 1) * 65 + n2]);
    }
    u16* d = dst + (size_t)(n0 + n2) * K + k0 + kp * 16;
    *(u32x4*)d = o0;
    *(u32x4*)(d + 8) = o1;
  }
  __syncthreads();
}

DI void convert_flat(const float* __restrict__ src, u16* __restrict__ dst, size_t n, int bid, int nblk) {
  size_t nv = n / 8;
  for (size_t i = (size_t)bid * NTHREADS + threadIdx.x; i < nv; i += (size_t)nblk * NTHREADS) {
    f32x4 a = ((const f32x4*)src)[2 * i], b = ((const f32x4*)src)[2 * i + 1];
    u32x4 o;
    o[0] = pack2(a[0], a[1]); o[1] = pack2(a[2], a[3]); o[2] = pack2(b[0], b[1]); o[3] = pack2(b[2], b[3]);
    ((u32x4*)dst)[i] = o;
  }
}


typedef __attribute__((ext_vector_type(2))) float f32x2;
DI unsigned f32_to_e4m3(float x) {
  unsigned u = __float_as_uint(x);
  const unsigned sign = (u >> 24) & 0x80u;
  u &= 0x7fffffffu;
  const float ax = __uint_as_float(u);
  unsigned r;
  if (ax < 0.015625f) r = (unsigned)__float2int_rn(ax * 512.f);
  else { u += 0x7ffffu + ((u >> 20) & 1u); r = (u >> 20) - (120u << 3); if (r > 0x7eu) r = 0x7eu; }
  return sign | r;
}
DI void convert_fp8_rows(const float* __restrict__ src, unsigned char* __restrict__ dst, float* __restrict__ inv_scale, int nrows, int bid, int nblk) {
  const int lane = threadIdx.x & 63, wv = threadIdx.x >> 6;
  for (int row = bid * 4 + wv; row < nrows; row += nblk * 4) {
    const f32x4* sp = (const f32x4*)(src + (size_t)row * 1024 + 16 * lane);
    f32x4 v[4];
    float mx = 0.f;
#pragma unroll
    for (int i = 0; i < 4; ++i) { v[i] = sp[i]; mx = fmaxf(mx, fmaxf(fmaxf(fabsf(v[i][0]), fabsf(v[i][1])), fmaxf(fabsf(v[i][2]), fabsf(v[i][3])))); }
#pragma unroll
    for (int o = 32; o >= 1; o >>= 1) mx = fmaxf(mx, __shfl_xor(mx, o));
    const float sc = (mx > 0.f) ? 240.f / mx : 1.f;
    u32x4 o4;
#pragma unroll
    for (int i = 0; i < 4; ++i)
      o4[i] = f32_to_e4m3(v[i][0] * sc) | (f32_to_e4m3(v[i][1] * sc) << 8) | (f32_to_e4m3(v[i][2] * sc) << 16) | (f32_to_e4m3(v[i][3] * sc) << 24);
    *(u32x4*)(dst + (size_t)row * 1024 + 16 * lane) = o4;
    if (lane == 0) inv_scale[row] = (mx > 0.f) ? mx / 240.f : 1.f;
  }
}

DI void rmsnorm_rows_bf16(const float* __restrict__ src, const float* __restrict__ w, u16* __restrict__ dst, int nrows, int bid, int nblk) {
  const int lane = threadIdx.x & 63, wv = threadIdx.x >> 6;
  f32x4 wr[4];
#pragma unroll
  for (int i = 0; i < 4; ++i) wr[i] = ((const f32x4*)w)[lane + 64 * i];
  for (int row = bid * 4 + wv; row < nrows; row += nblk * 4) {
    const f32x4* s = (const f32x4*)(src + (size_t)row * 1024);
    f32x4 v[4];
    float ss = 0.f;
#pragma unroll
    for (int i = 0; i < 4; ++i) { v[i] = s[lane + 64 * i]; ss += v[i][0] * v[i][0] + v[i][1] * v[i][1] + v[i][2] * v[i][2] + v[i][3] * v[i][3]; }
    ss = wave_sum(ss);
    float rs = rsqrtf(ss * (1.f / 1024.f) + 1e-6f);
#pragma unroll
    for (int i = 0; i < 4; ++i) {
      u32x2 o;
      o[0] = pack2(v[i][0] * rs * wr[i][0], v[i][1] * rs * wr[i][1]);
      o[1] = pack2(v[i][2] * rs * wr[i][2], v[i][3] * rs * wr[i][3]);
      *(u32x2*)(dst + (size_t)row * 1024 + (lane + 64 * i) * 4) = o;
    }
  }
}

DI int t5_bucket(int d) {
  if (d < 16) return d < 0 ? 0 : d;
  const int th[16] = {16, 19, 21, 24, 27, 31, 35, 40, 46, 52, 59, 67, 77, 87, 99, 113};
  int b = 16;
#pragma unroll
  for (int k = 1; k < 16; ++k) b += (d >= th[k]) ? 1 : 0;
  return b;
}

DI void phase0(const Params& p, int bid, int nblk, char* smem) {
  char* ws = p.ws;
  const int n_win = 16 * 86, n_wa = 8 * 16, n_wo = 16 * 16, n_wq = 16 * 32, n_wc = 32 * 2;
  const int total = n_win + 2 * n_wa + n_wo + n_wq + 2 * n_wc;
  for (int it = bid; it < total; it += nblk) {
    int i = it;
    if (i < n_win) { tconv_tile<1>(p.w_in, 1024, NIN, (u16*)(ws + OFF_WINT), i / 86, i % 86, smem); continue; }
    i -= n_win;
    if (i < n_wa) { tconv_tile<0>(p.w_a, 512, 1024, (u16*)(ws + OFF_WAT), i / 16, i % 16, smem); continue; }
    i -= n_wa;
    if (i < n_wa) { tconv_tile<0>(p.w_b, 512, 1024, (u16*)(ws + OFF_WBT), i / 16, i % 16, smem); continue; }
    i -= n_wa;
    if (i < n_wo) { tconv_tile<0>(p.w_out, 1024, 1024, (u16*)(ws + OFF_WOT), i / 16, i % 16, smem); continue; }
    i -= n_wo;
    if (i < n_wq) { tconv_tile<0>(p.w_query, 1024, 2048, (u16*)(ws + OFF_WQT), i / 32, i % 32, smem); continue; }
    i -= n_wq;
    if (i < n_wc) { tconv_tile<0>(p.cmp_w_k, 2048, 64, (u16*)(ws + OFF_WKT), i / 2, i % 2, smem); continue; }
    i -= n_wc;
    tconv_tile<0>(p.cmp_w_v, 2048, 64, (u16*)(ws + OFF_WVT), i / 2, i % 2, smem);
  }
  convert_flat(p.sub_keys, (u16*)(ws + OFF_SK), (size_t)16 * 128 * 128, bid, nblk);
  convert_fp8_rows(p.expert_u, (unsigned char*)(ws + OFF_EU), (float*)(ws + OFF_MISC + MISC_SCU), 16384, bid, nblk);
  convert_fp8_rows(p.expert_v, (unsigned char*)(ws + OFF_EV), (float*)(ws + OFF_MISC + MISC_SCV), 16384, bid, nblk);
  rmsnorm_rows_bf16(p.x, p.norm_mix, (u16*)(ws + OFF_RH), NTOK, bid, nblk);
  const int tid = threadIdx.x;
  if (bid == nblk - 1) {
    float* ck = (float*)(ws + OFF_MISC + MISC_CK);
    float* cv = (float*)(ws + OFF_MISC + MISC_CV);
    if (tid < 128) {
      const int e = tid & 63;
      const float* pe = (tid < 64) ? p.cmp_pe_k : p.cmp_pe_v;
      const float* W = (tid < 64) ? p.cmp_w_k : p.cmp_w_v;
      float s = 0.f;
      for (int k = 0; k < 2048; ++k) s += pe[k] * W[(size_t)k * 64 + e];
      if (tid < 64) ck[e] = s; else cv[e] = s;
    }
  }
  if (bid == nblk - 2 || nblk == 1) {
    float* bt = (float*)(ws + OFF_MISC + MISC_BIAS);
    for (int i = tid; i < 8 * 132; i += NTHREADS) {
      int hd = i / 132, d = i % 132;
      bt[i] = p.rel_bias[t5_bucket(d) * 8 + hd] * L2E;
    }
    if (tid < 16) ((unsigned*)(ws + OFF_MISC + MISC_CNT))[tid] = 0u;
  }
}

struct GemmPtrs {
  const u16* a[4];
  const u16* b[4];
  long aks, bks;
};

DI void gemm_kloop(f32x16 (&acc)[2][2], const GemmPtrs& g, int nkt, char* smem) {
  const int tid = threadIdx.x, lane = tid & 63, w = tid >> 6, wm = w >> 1, wn = w & 1, r = lane & 31, h = lane >> 5;
  const int lrow = tid >> 3, lch = tid & 7;
  u32x4 ra[4], rb[4];
#pragma unroll
  for (int i = 0; i < 4; ++i) { ra[i] = *(const u32x4*)(g.a[i]); rb[i] = *(const u32x4*)(g.b[i]); }
#pragma unroll
  for (int i = 0; i < 4; ++i) {
    *(u32x4*)(smem + swz(lrow + 32 * i, lch)) = ra[i];
    *(u32x4*)(smem + 16384 + swz(lrow + 32 * i, lch)) = rb[i];
  }
  __syncthreads();
  for (int kt = 0; kt < nkt; ++kt) {
    const char* A = smem + (kt & 1) * 32768;
    const char* B = A + 16384;
    const bool more = (kt + 1 < nkt);
    if (more) {
#pragma unroll
      for (int i = 0; i < 4; ++i) {
        ra[i] = *(const u32x4*)(g.a[i] + (long)(kt + 1) * g.aks);
        rb[i] = *(const u32x4*)(g.b[i] + (long)(kt + 1) * g.bks);
      }
    }
#pragma unroll
    for (int s = 0; s < 4; ++s) {
      bf16x8 a0 = lds_frag(A, wm * 64 + r, 2 * s + h);
      bf16x8 a1 = lds_frag(A, wm * 64 + 32 + r, 2 * s + h);
      bf16x8 b0 = lds_frag(B, wn * 64 + r, 2 * s + h);
      bf16x8 b1 = lds_frag(B, wn * 64 + 32 + r, 2 * s + h);
      acc[0][0] = mfma32(a0, b0, acc[0][0]);
      acc[0][1] = mfma32(a0, b1, acc[0][1]);
      acc[1][0] = mfma32(a1, b0, acc[1][0]);
      acc[1][1] = mfma32(a1, b1, acc[1][1]);
    }
    if (more) {
      char* A2 = smem + ((kt + 1) & 1) * 32768;
#pragma unroll
      for (int i = 0; i < 4; ++i) {
        *(u32x4*)(A2 + swz(lrow + 32 * i, lch)) = ra[i];
        *(u32x4*)(A2 + 16384 + swz(lrow + 32 * i, lch)) = rb[i];
      }
    }
    __syncthreads();
  }
}

DI void zero_acc(f32x16 (&acc)[2][2]) {
#pragma unroll
  for (int i = 0; i < 2; ++i)
#pragma unroll
    for (int j = 0; j < 2; ++j)
#pragma unroll
      for (int k = 0; k < 16; ++k) acc[i][j][k] = 0.f;
}
DI void gemm_setup(GemmPtrs& g, const u16* A, long lda, int m0, const u16* Bt, long ldb, int n0) {
  const int lrow = threadIdx.x >> 3, lch = threadIdx.x & 7;
#pragma unroll
  for (int i = 0; i < 4; ++i) {
    g.a[i] = A + (size_t)(m0 + lrow + 32 * i) * lda + lch * 8;
    g.b[i] = Bt + (size_t)(n0 + lrow + 32 * i) * ldb + lch * 8;
  }
  g.aks = 64; g.bks = 64;
}
template <class F>
DI void gemm_epilogue(const f32x16 (&acc)[2][2], F f) {
  const int lane = threadIdx.x & 63, w = threadIdx.x >> 6, wm = w >> 1, wn = w & 1, r = lane & 31, h = lane >> 5;
#pragma unroll
  for (int i = 0; i < 2; ++i)
#pragma unroll
    for (int j = 0; j < 2; ++j) {
#pragma unroll
      for (int k = 0; k < 16; ++k) f(wm * 64 + i * 32 + (k & 3) + 8 * (k >> 2) + 4 * h, wn * 64 + j * 32 + r, acc[i][j][k]);
      asm volatile("" ::: "memory");
    }
}

template <class F>
DI void gemm_epilogue_lds(const f32x16 (&acc)[2][2], char* smem, F f) {
  float* T = (float*)smem;
  {
    const int lane = threadIdx.x & 63, w = threadIdx.x >> 6, wm = w >> 1, wn = w & 1, r = lane & 31, h = lane >> 5;
#pragma unroll
    for (int i = 0; i < 2; ++i)
#pragma unroll
      for (int j = 0; j < 2; ++j)
#pragma unroll
        for (int k = 0; k < 16; ++k) T[(wm * 64 + i * 32 + (k & 3) + 8 * (k >> 2) + 4 * h) * 132 + wn * 64 + j * 32 + r] = acc[i][j][k];
  }
  __syncthreads();
  const int c8 = (threadIdx.x & 15) * 8, r0 = threadIdx.x >> 4;
#pragma unroll 2
  for (int it = 0; it < 8; ++it) {
    const int row = r0 + 16 * it;
    const f32x4 a = *(const f32x4*)(T + row * 132 + c8), b = *(const f32x4*)(T + row * 132 + c8 + 4);
    const float v[8] = {a[0], a[1], a[2], a[3], b[0], b[1], b[2], b[3]};
    f(row, c8, v);
  }
  __syncthreads();
}
DI u32x4 pack8u(const float (&v)[8]) { u32x4 o; o[0] = pack2(v[0], v[1]); o[1] = pack2(v[2], v[3]); o[2] = pack2(v[4], v[5]); o[3] = pack2(v[6], v[7]); return o; }

DI void phase_inproj(const Params& p, int bid, int nblk, char* smem) {
  char* ws = p.ws;
  const u16* H = (const u16*)(ws + OFF_RH);
  const u16* W = (const u16*)(ws + OFF_WINT);
  const int NT = NP / 128;
  for (int t = bid; t < 256 * NT; t += nblk) {
    const int mt = t / NT, nt = t % NT, m0 = mt * 128, n0 = nt * 128;
    GemmPtrs g;
    gemm_setup(g, H, 1024, m0, W, 1024, n0);
    f32x16 acc[2][2];
    zero_acc(acc);
    gemm_kloop(acc, g, 16, smem);
    if (n0 >= 5376) {
      float* SM = (float*)(ws + OFF_SM);
      gemm_epilogue_lds(acc, smem, [&](int ml, int nl, const float (&v)[8]) {
        if (nl < 40) {
          float* d = SM + (size_t)(m0 + ml) * 40 + nl;
          *(f32x4*)d = f32x4{v[0], v[1], v[2], v[3]};
          *(f32x4*)(d + 4) = f32x4{v[4], v[5], v[6], v[7]};
        }
      });
    } else {
      u16* dst; int ld, c0;
      if (n0 < 1536) { dst = (u16*)(ws + OFF_QKV); ld = 1536; c0 = n0; }
      else if (n0 < 2048) { dst = (u16*)(ws + OFF_Z); ld = 512; c0 = n0 - 1536; }
      else if (n0 < 2560) { dst = (u16*)(ws + OFF_NQ); ld = 512; c0 = n0 - 2048; }
      else if (n0 < 3328) { dst = (u16*)(ws + OFF_NKV); ld = 768; c0 = n0 - 2560; }
      else { dst = (u16*)(ws + OFF_MG); ld = 2048; c0 = n0 - 3328; }
      gemm_epilogue_lds(acc, smem, [&](int ml, int nl, const float (&v)[8]) { *(u32x4*)(dst + (size_t)(m0 + ml) * ld + c0 + nl) = pack8u(v); });
    }
  }
}

DI void vtrans_item(const Params& p, int item, char* smem) {
  char* ws = p.ws;
  const int tile = item & 63, bg = (item >> 6) & 15, which = item >> 10;
  const int b = bg >> 1, g = bg & 1;
  const u16* NKV = (const u16*)(ws + OFF_NKV);
  u16* VT = (u16*)(ws + (which ? OFF_VWT : OFF_VST)) + (size_t)bg * 64 * 4096;
  const int col0 = (which ? 640 : 384) + g * 64;
  u16* t = (u16*)smem;
  const int tid = threadIdx.x;
  {
#pragma unroll
    for (int i = 0; i < 2; ++i) {
      int c = tid + 256 * i, row = c >> 3, ch = c & 7;
      u32x4 v = *(const u32x4*)(NKV + (size_t)(b * SEQ + tile * 64 + row) * 768 + col0 + ch * 8);
      *(u32x4*)(t + row * 72 + ch * 8) = v;
    }
  }
  __syncthreads();
  {
    const int d = tid >> 2, part = tid & 3;
    u32x4 o0, o1;
    u16 vals[16];
#pragma unroll
    for (int pp = 0; pp < 16; ++pp) vals[pp] = t[(part * 16 + perm16(pp)) * 72 + d];
#pragma unroll
    for (int i = 0; i < 4; ++i) {
      o0[i] = (unsigned)vals[2 * i] | ((unsigned)vals[2 * i + 1] << 16);
      o1[i] = (unsigned)vals[8 + 2 * i] | ((unsigned)vals[8 + 2 * i + 1] << 16);
    }
    u16* dst = VT + (size_t)d * 4096 + tile * 64 + part * 16;
    *(u32x4*)dst = o0;
    *(u32x4*)(dst + 8) = o1;
  }
  __syncthreads();
}

DI void cmp_gemm_item(const Params& p, int item, char* smem) {
  char* ws = p.ws;
  const int which = item >> 5, mt = item & 31, m0 = mt * 128;
  const u16* NKV = (const u16*)(ws + OFF_NKV);
  const u16* Wt = (const u16*)(ws + (which ? OFF_WVT : OFF_WKT));
  GemmPtrs g;
  const int lrow = threadIdx.x >> 3, lch = threadIdx.x & 7;
#pragma unroll
  for (int i = 0; i < 4; ++i) {
    int m = m0 + lrow + 32 * i, bg = m >> 8, n = m & 255;
    if (n > 254) n = 254;
    g.a[i] = NKV + (size_t)((bg >> 1) * SEQ + 16 * n) * 768 + which * 128 + (bg & 1) * 64 + lch * 8;
    g.b[i] = Wt + (size_t)(lrow + 32 * i) * 2048 + lch * 8;
  }
  g.aks = 768; g.bks = 64;
  f32x16 acc[2][2];
  zero_acc(acc);
  gemm_kloop(acc, g, 32, smem);
  const float* cc = (const float*)(ws + OFF_MISC + (which ? MISC_CV : MISC_CK));
  if (which == 0) {
    u16* KC = (u16*)(ws + OFF_KC);
    gemm_epilogue_lds(acc, smem, [&](int ml, int nl, const float (&v)[8]) {
      if (nl < 64) {
        float t[8];
#pragma unroll
        for (int e = 0; e < 8; ++e) t[e] = v[e] + cc[nl + e];
        *(u32x4*)(KC + (size_t)(m0 + ml) * 64 + nl) = pack8u(t);
      }
    });
  } else {
    u16* VCT = (u16*)(ws + OFF_VCT);
    gemm_epilogue_lds(acc, smem, [&](int ml, int nl, const float (&v)[8]) {
      if (nl < 64) {
        const int m = m0 + ml, bg = m >> 8, n = m & 255;
        u16* d = VCT + ((size_t)bg * 64 + nl) * 256 + (n & ~15) + perm16(n & 15);
#pragma unroll
        for (int e = 0; e < 8; ++e) d[e * 256] = f2bf(v[e] + cc[nl + e]);
      }
    });
  }
}

DI void gdn_store_frag(u16* dst, const char* tile, int idx  , float scale_is_row, const float* rowscale) {
  const int blk = idx >> 6, lane = idx & 63, rt = blk >> 1, ks = blk & 1, r = lane & 15, q = lane >> 4;
  const int row = 16 * rt + r;
  const int k0 = 32 * ks + 4 * q, k1 = k0 + 16;
  u32x2 lo = *(const u32x2*)(tile + swz(row, k0 >> 3) + (k0 & 7) * 2);
  u32x2 hi = *(const u32x2*)(tile + swz(row, k1 >> 3) + (k1 & 7) * 2);
  u32x4 o;
  if (rowscale) {
    float s = rowscale[row];
    o[0] = pack2(bflo(lo[0]) * s, bfhi(lo[0]) * s); o[1] = pack2(bflo(lo[1]) * s, bfhi(lo[1]) * s);
    o[2] = pack2(bflo(hi[0]) * s, bfhi(hi[0]) * s); o[3] = pack2(bflo(hi[1]) * s, bfhi(hi[1]) * s);
  } else { o[0] = lo[0]; o[1] = lo[1]; o[2] = hi[0]; o[3] = hi[1]; }
  *(u32x4*)(dst + (size_t)idx * 8) = o;
}

DI void gdn_chunk_item(const Params& p, int item, char* smem) {
  char* ws = p.ws;
  const int n = item & 63, bh = item >> 6, b = bh >> 3, hd = bh & 7;
  const int tid = threadIdx.x + opaque0(), lane = tid & 63, w = tid >> 6;
  char* Cq = smem;
  char* Ck = smem + 8192;
  char* Cv = smem + 16384;
  float* Am = (float*)(smem + 24576);
  char* ATT = smem + 40960;
  char* Wt = smem + 49152;
  float* gc = (float*)(smem + 57344);
  float* bet = gc + 64;
  float* eg = gc + 128;
  float* ekd = gc + 192;
  const u16* QKV = (const u16*)(ws + OFF_QKV);
  const size_t tok0 = (size_t)b * SEQ + n * 64;
  {
    const int ch = tid & 63, tg = tid >> 6;
#pragma unroll
    for (int part = 0; part < 3; ++part) {
      const int col = part * 512 + hd * 64 + ch;
      const float w0 = p.conv_w[col], w1 = p.conv_w[1536 + col], w2 = p.conv_w[3072 + col], w3 = p.conv_w[4608 + col];
      const int s0 = n * 64 + tg * 16;
      const u16* src = QKV + ((size_t)b * SEQ) * 1536 + col;
      float x0 = (s0 - 3 >= 0) ? bf2f(src[(size_t)(s0 - 3) * 1536]) : 0.f;
      float x1 = (s0 - 2 >= 0) ? bf2f(src[(size_t)(s0 - 2) * 1536]) : 0.f;
      float x2 = (s0 - 1 >= 0) ? bf2f(src[(size_t)(s0 - 1) * 1536]) : 0.f;
      char* C = smem + part * 8192;
#pragma unroll 4
      for (int i = 0; i < 16; ++i) {
        float x3 = bf2f(src[(size_t)(s0 + i) * 1536]);
        float y = w0 * x0 + w1 * x1 + w2 * x2 + w3 * x3;
        y = y / (1.f + __expf(-y));
        int tok = tg * 16 + i;
        *(u16*)(C + swz(tok, ch >> 3) + (ch & 7) * 2) = f2bf(y);
        x0 = x1; x1 = x2; x2 = x3;
      }
    }
  }
  if (w == 0) {
    const float* SM = (const float*)(ws + OFF_SM);
    float bi = SM[(tok0 + lane) * 40 + hd], ai = SM[(tok0 + lane) * 40 + 8 + hd];
    float xs = ai + p.dt_bias[hd];
    float sp = (xs > 20.f) ? xs : log1pf(__expf(xs));
    float gv = -__expf(p.a_log[hd]) * sp;
#pragma unroll
    for (int o = 1; o < 64; o <<= 1) { float t = __shfl_up(gv, o); if (lane >= o) gv += t; }
    float glast = __shfl(gv, 63);
    gc[lane] = gv; bet[lane] = sigmoidf_(bi); eg[lane] = __expf(gv); ekd[lane] = __expf(glast - gv);
    if (lane == 63) ((float*)(ws + OFF_MISC + MISC_GL))[item] = __expf(gv);
  }
  __syncthreads();
  if (tid < 128) {
    char* C = (tid < 64) ? Cq : Ck;
    const int row = tid & 63;
    u32x4 v[8];
    float ss = 0.f;
#pragma unroll
    for (int c = 0; c < 8; ++c) {
      v[c] = *(const u32x4*)(C + swz(row, c));
#pragma unroll
      for (int e = 0; e < 4; ++e) { float a = bflo(v[c][e]), bb = bfhi(v[c][e]); ss += a * a + bb * bb; }
    }
    float rs = rsqrtf(ss + 1e-6f) * ((tid < 64) ? 0.125f : 1.f);
#pragma unroll
    for (int c = 0; c < 8; ++c) {
      u32x4 o;
#pragma unroll
      for (int e = 0; e < 4; ++e) o[e] = pack2(bflo(v[c][e]) * rs, bfhi(v[c][e]) * rs);
      *(u32x4*)(C + swz(row, c)) = o;
    }
  }
  __syncthreads();
  {
    const int qa = w >> 1, qb = w & 1, r = lane & 31, h = lane >> 5;
    f32x16 akk, aqk;
#pragma unroll
    for (int k = 0; k < 16; ++k) { akk[k] = 0.f; aqk[k] = 0.f; }
    if (!(qa == 0 && qb == 1)) {
#pragma unroll
      for (int s = 0; s < 4; ++s) {
        bf16x8 ak = lds_frag(Ck, 32 * qa + r, 2 * s + h);
        bf16x8 aq = lds_frag(Cq, 32 * qa + r, 2 * s + h);
        bf16x8 bk = lds_frag(Ck, 32 * qb + r, 2 * s + h);
        akk = mfma32(ak, bk, akk);
        aqk = mfma32(aq, bk, aqk);
      }
    }
    const int j = 32 * qb + r;
    const float gj = gc[j];
#pragma unroll
    for (int k = 0; k < 16; ++k) {
      const int i = 32 * qa + (k & 3) + 8 * (k >> 2) + 4 * h;
      float dec = __expf(fminf(gc[i] - gj, 0.f));
      Am[i * 64 + j] = (j < i) ? akk[k] * bet[i] * dec : 0.f;
      *(u16*)(ATT + swz(i, j >> 3) + (j & 7) * 2) = f2bf((j <= i) ? aqk[k] * dec : 0.f);
    }
  }
  __syncthreads();
  u16* AMg = (u16*)p.out + (size_t)item * 16384;
  if (tid < 128) {
    const int c = tid;
    float x[64];
#pragma unroll
    for (int i = 0; i < 64; ++i) {
      const int dcol = c & 63;
      float rhs = bf2f(*(const u16*)(((c < 64) ? Cv : Ck) + swz(i, dcol >> 3) + (dcol & 7) * 2)) * bet[i] * ((c < 64) ? 1.f : eg[i]);
      float s0 = rhs, s1 = 0.f;
#pragma unroll
      for (int j4 = 0; j4 < (i + 3) / 4; ++j4) {
        f32x4 a = *(const f32x4*)(Am + i * 64 + j4 * 4);
#pragma unroll
        for (int e = 0; e < 4; ++e) {
          const int j = j4 * 4 + e;
          if (j < i) { if (e & 1) s1 -= a[e] * x[j]; else s0 -= a[e] * x[j]; }
        }
      }
      x[i] = s0 + s1;
      asm volatile("" : "+v"(x[i]) : : "memory");
    }
    if (c < 64) {
      float* U = (float*)(ws + OFF_RH) + ((size_t)item * 64 + c) * 64;
#pragma unroll
      for (int i = 0; i < 16; ++i) { f32x4 o = {x[4 * i], x[4 * i + 1], x[4 * i + 2], x[4 * i + 3]}; *(f32x4*)(U + 4 * i) = o; }
    } else {
      const int d = c - 64;
#pragma unroll
      for (int i = 0; i < 64; ++i) *(u16*)(Wt + swz(i, d >> 3) + (d & 7) * 2) = f2bf(x[i]);
    }
  } else {
    const int t2 = tid - 128;
#pragma unroll
    for (int i = 0; i < 4; ++i) {
      gdn_store_frag(AMg + 4096, Cq, t2 + 128 * i, 1.f, eg);
      gdn_store_frag(AMg + 8192, ATT, t2 + 128 * i, 0.f, nullptr);
    }
#pragma unroll
    for (int i = 0; i < 4; ++i) {
      const int idx = t2 + 128 * i, blk = idx >> 6, ln = idx & 63, rt = blk >> 1, ks = blk & 1, r = ln & 15, q = ln >> 4;
      const int d = 16 * rt + r;
      float vv[8];
#pragma unroll
      for (int j = 0; j < 8; ++j) {
        const int tk = 32 * ks + ((j < 4) ? (4 * q + j) : (16 + 4 * q + (j - 4)));
        vv[j] = bf2f(*(const u16*)(Ck + swz(tk, d >> 3) + (d & 7) * 2)) * ekd[tk];
      }
      *(bf16x8*)(AMg + 12288 + (size_t)idx * 8) = pack8(vv[0], vv[1], vv[2], vv[3], vv[4], vv[5], vv[6], vv[7]);
    }
  }
  __syncthreads();
#pragma unroll
  for (int i = 0; i < 2; ++i) gdn_store_frag(AMg, Wt, tid + 256 * i, 0.f, nullptr);
  __syncthreads();
}

DI void phase2(const Params& p, int bid, int nblk, char* smem) {
  const int total = 64 + 2048 + 4096;
  for (int it = bid; it < total; it += nblk) {
    if (it < 64) cmp_gemm_item(p, it, smem);
    else if (it < 2112) vtrans_item(p, it - 64, smem);
    else gdn_chunk_item(p, it - 2112, smem);
  }
}

DI void gdn_scan_item(const Params& p, int bh, char* smem) {
  char* ws = p.ws;
  const int tid = threadIdx.x, lane = tid & 63, w = tid >> 6, col = lane & 15, q = lane >> 4;
  const int b = bh >> 3, hd = bh & 7;
  const u16* AMg = (const u16*)p.out + (size_t)bh * 64 * 16384;
  const float* U = (const float*)(ws + OFF_RH) + (size_t)bh * 64 * 4096;
  const float* GL = (const float*)(ws + OFF_MISC + MISC_GL) + bh * 64;
  float* O = (float*)(ws + OFF_QKV);
  f32x4 S[4];
#pragma unroll
  for (int t = 0; t < 4; ++t) S[t] = f32x4{0.f, 0.f, 0.f, 0.f};
  u32x4 stg[8];
#pragma unroll
  for (int i = 0; i < 8; ++i) stg[i] = *(const u32x4*)(AMg + (size_t)(i * 256 + tid) * 8);
  f32x4 u[4];
#pragma unroll
  for (int ct = 0; ct < 4; ++ct) u[ct] = *(const f32x4*)(U + (size_t)(16 * w + col) * 64 + 16 * ct + 4 * q);
  float gl = GL[0];
  for (int n = 0; n < 64; ++n) {
    char* buf = smem + (n & 1) * 32768;
#pragma unroll
    for (int i = 0; i < 8; ++i) *(u32x4*)(buf + (i * 256 + tid) * 16) = stg[i];
    __syncthreads();
    f32x4 ucur[4];
#pragma unroll
    for (int ct = 0; ct < 4; ++ct) ucur[ct] = u[ct];
    const float glcur = gl;
    if (n + 1 < 64) {
      const u16* src = AMg + (size_t)(n + 1) * 16384;
#pragma unroll
      for (int i = 0; i < 8; ++i) stg[i] = *(const u32x4*)(src + (size_t)(i * 256 + tid) * 8);
      const float* un = U + (size_t)(n + 1) * 4096;
#pragma unroll
      for (int ct = 0; ct < 4; ++ct) u[ct] = *(const f32x4*)(un + (size_t)(16 * w + col) * 64 + 16 * ct + 4 * q);
      gl = GL[n + 1];
    }
    bf16x8 bS[2];
#pragma unroll
    for (int ks = 0; ks < 2; ++ks)
      bS[ks] = pack8(S[2 * ks][0], S[2 * ks][1], S[2 * ks][2], S[2 * ks][3], S[2 * ks + 1][0], S[2 * ks + 1][1], S[2 * ks + 1][2], S[2 * ks + 1][3]);
#define AFRAG(mat, rt, ks) (*(const bf16x8*)(buf + (mat) * 8192 + (((rt) * 2 + (ks)) * 64 + lane) * 16))
    f32x4 vn[4], o[4];
#pragma unroll
    for (int ct = 0; ct < 4; ++ct) {
      f32x4 a = f32x4{0.f, 0.f, 0.f, 0.f};
      a = mfma16(AFRAG(0, ct, 0), bS[0], a);
      a = mfma16(AFRAG(0, ct, 1), bS[1], a);
      vn[ct] = ucur[ct] - a;
      f32x4 oo = f32x4{0.f, 0.f, 0.f, 0.f};
      oo = mfma16(AFRAG(1, ct, 0), bS[0], oo);
      oo = mfma16(AFRAG(1, ct, 1), bS[1], oo);
      o[ct] = oo;
    }
    bf16x8 bV[2];
#pragma unroll
    for (int ks = 0; ks < 2; ++ks)
      bV[ks] = pack8(vn[2 * ks][0], vn[2 * ks][1], vn[2 * ks][2], vn[2 * ks][3], vn[2 * ks + 1][0], vn[2 * ks + 1][1], vn[2 * ks + 1][2], vn[2 * ks + 1][3]);
#pragma unroll
    for (int ct = 0; ct < 4; ++ct) {
      o[ct] = mfma16(AFRAG(2, ct, 0), bV[0], o[ct]);
      o[ct] = mfma16(AFRAG(2, ct, 1), bV[1], o[ct]);
      f32x4 sn = S[ct] * glcur;
      sn = mfma16(AFRAG(3, ct, 0), bV[0], sn);
      sn = mfma16(AFRAG(3, ct, 1), bV[1], sn);
      S[ct] = sn;
    }
#undef AFRAG
    float* od = O + ((size_t)b * SEQ + n * 64) * 512 + hd * 64 + 16 * w + col;
#pragma unroll
    for (int ct = 0; ct < 4; ++ct)
#pragma unroll
      for (int rg = 0; rg < 4; ++rg) od[(size_t)(16 * ct + 4 * q + rg) * 512] = o[ct][rg];
  }
  __syncthreads();
}

DI void phase_gdn_post(const Params& p, int bid, int nblk) {
  char* ws = p.ws;
  const float* O = (const float*)(ws + OFF_QKV);
  const u16* Z = (const u16*)(ws + OFF_Z);
  u16* OA = (u16*)(ws + OFF_NQ);
  const int sub = threadIdx.x & 15;
  const f32x4 gw = ((const f32x4*)p.gdn_norm)[sub];
  const size_t ngrp = (size_t)NTOK * 8;
  for (size_t gi = ((size_t)bid * NTHREADS + threadIdx.x) >> 4; gi < ngrp; gi += ((size_t)nblk * NTHREADS) >> 4) {
    f32x4 v = *(const f32x4*)(O + gi * 64 + sub * 4);
    float ss = v[0] * v[0] + v[1] * v[1] + v[2] * v[2] + v[3] * v[3];
    ss += __shfl_xor(ss, 1); ss += __shfl_xor(ss, 2); ss += __shfl_xor(ss, 4); ss += __shfl_xor(ss, 8);
    float rs = rsqrtf(ss * (1.f / 64.f) + 1e-6f);
    u32x2 zz = *(const u32x2*)(Z + gi * 64 + sub * 4);
    float z0 = bflo(zz[0]), z1 = bfhi(zz[0]), z2 = bflo(zz[1]), z3 = bfhi(zz[1]);
    u32x2 o;
    o[0] = pack2(v[0] * rs * gw[0] * (z0 * sigmoidf_(z0)), v[1] * rs * gw[1] * (z1 * sigmoidf_(z1)));
    o[1] = pack2(v[2] * rs * gw[2] * (z2 * sigmoidf_(z2)), v[3] * rs * gw[3] * (z3 * sigmoidf_(z3)));
    *(u32x2*)(OA + gi * 64 + sub * 4) = o;
  }
}

constexpr int NSA_LDS_K = 0, NSA_LDS_V = 9216, NSA_LDS_BIAS = 18432, NSA_LDS_IMP = 18432 + 8 * 132 * 4;
constexpr int NSA_LDS_Q = NSA_LDS_IMP + 4 * 8 * 68 * 4;
constexpr float NEGBIG = -1e30f;
constexpr float QK_SCALE = 0.125f * L2E;

template <int MODE>
DI void nsa_tile(const char* Kt, const char* Vt, const char* Qw, f32x16 (&O)[2], float& m, float& l,
                 const int t, const int key0, const bool slow, const bool lane_sel, const float* tab,
                 const float mfin, const float linv, float* impw) {
  const int lane = threadIdx.x & 63, r = lane & 31, h = lane >> 5;
#pragma unroll
  for (int a = 0; a < 2; ++a) {
    f32x16 S;
#pragma unroll
    for (int k = 0; k < 16; ++k) S[k] = 0.f;
#pragma unroll
    for (int s = 0; s < 4; ++s) S = mfma32(pad_frag(Kt, 32 * a + r, 2 * s + h), *(const bf16x8*)(Qw + (s * 64 + lane) * 16), S);
    if (MODE < 2 || slow) {
#pragma unroll
      for (int k = 0; k < 16; ++k) {
        const int kl = 32 * a + (k & 3) + 8 * (k >> 2) + 4 * h;
        int dist;
        if (MODE < 2) dist = t - (16 * (key0 + kl) + 31); else dist = t - (key0 + kl);
        bool valid = (dist >= 0) && lane_sel;
        if (MODE == 3) valid = valid && (dist < 512);
        int di = dist < 0 ? 0 : (dist > 128 ? 128 : dist);
        float bias = tab[di];
        S[k] = valid ? fmaf(S[k], QK_SCALE, bias) : NEGBIG;
      }
    } else {
      const float c31 = tab[128];
#pragma unroll
      for (int k = 0; k < 16; ++k) S[k] = lane_sel ? fmaf(S[k], QK_SCALE, c31) : NEGBIG;
    }
    if (MODE == 1) {
#pragma unroll
      for (int k = 0; k < 16; ++k) S[k] = (S[k] > -1e29f) ? exp2f(S[k] - mfin) * linv : 0.f;
    } else {
      float mx = S[0];
#pragma unroll
      for (int k = 1; k < 16; ++k) mx = fmaxf(mx, S[k]);
      mx = fmaxf(mx, __shfl_xor(mx, 32));
      const float mn = fmaxf(m, mx);
      const float alpha = exp2f(m - mn);
      float ps = 0.f;
#pragma unroll
      for (int k = 0; k < 16; ++k) { S[k] = (S[k] > -1e29f) ? exp2f(S[k] - mn) : 0.f; ps += S[k]; }
      l = l * alpha + ps;
      m = mn;
      if (MODE != 0) {
#pragma unroll
        for (int dt = 0; dt < 2; ++dt)
#pragma unroll
          for (int k = 0; k < 16; ++k) O[dt][k] *= alpha;
      }
    }
    if (MODE == 1) {
#pragma unroll
      for (int g4 = 0; g4 < 4; ++g4) {
        float mainv = S[4 * g4] + S[4 * g4 + 1] + S[4 * g4 + 2] + 0.5f * S[4 * g4 + 3];
        float spill = 0.5f * S[4 * g4 + 3];
        mainv += __shfl_xor(mainv, 8); mainv += __shfl_xor(mainv, 16);
        spill += __shfl_xor(spill, 8); spill += __shfl_xor(spill, 16);
        const int blk = ((key0 + 32 * a) >> 2) + 2 * g4 + h;
        if (r < 8) { atomicAdd(&impw[r * 68 + blk], mainv); atomicAdd(&impw[r * 68 + blk + 1], spill); }
      }
    }
    if (MODE != 0) {
      bf16x8 P0 = pack8(S[0], S[1], S[2], S[3], S[4], S[5], S[6], S[7]);
      bf16x8 P1 = pack8(S[8], S[9], S[10], S[11], S[12], S[13], S[14], S[15]);
#pragma unroll
      for (int dt = 0; dt < 2; ++dt) {
        O[dt] = mfma32(pad_frag(Vt, 32 * dt + r, 4 * a + h), P0, O[dt]);
        O[dt] = mfma32(pad_frag(Vt, 32 * dt + r, 4 * a + 2 + h), P1, O[dt]);
      }
    }
  }
}

struct NsaSrc { const u16* k; long kld; const u16* v; long vld; };

DI void nsa_item(const Params& p, const int bg, const int hq, char* smem) {
  char* ws = p.ws;
  const int tid = threadIdx.x, lane = tid & 63, w = tid >> 6, r = lane & 31, h = lane >> 5;
  const int b = bg >> 1, g = bg & 1, qi = hq >> 1;
  const int t = 32 * hq + 8 * w + (r & 7);
  const int head = g * 4 + (r >> 3);
  const size_t trow = (size_t)b * SEQ + t;
  char* Kt = smem + NSA_LDS_K;
  char* Vt = smem + NSA_LDS_V;
  float* biasl = (float*)(smem + NSA_LDS_BIAS);
  float* impw = (float*)(smem + NSA_LDS_IMP) + w * (8 * 68);
  char* Q = smem + NSA_LDS_Q + w * 4096;
  const u16* NKV = (const u16*)(ws + OFF_NKV);
  __syncthreads();
  for (int i = tid; i < 8 * 132; i += NTHREADS) biasl[i] = ((const float*)(ws + OFF_MISC + MISC_BIAS))[i];
  for (int i = lane; i < 8 * 68; i += 64) impw[i] = 0.f;
  {
    const u16* NQ = (const u16*)(ws + OFF_NQ);
#pragma unroll
    for (int s = 0; s < 4; ++s) *(bf16x8*)(Q + (s * 64 + lane) * 16) = *(const bf16x8*)(NQ + trow * 512 + head * 64 + 16 * s + 8 * h);
  }
  const float* tab = biasl + head * 132;
  __syncthreads();
  f32x16 O[2];
  float m, l, mfin = 0.f, linv = 0.f;
  u16* OB = (u16*)(ws + OFF_QKV + (size_t)NTOK * 512 * 4);
  auto reset = [&]() {
#pragma unroll
    for (int dt = 0; dt < 2; ++dt)
#pragma unroll
      for (int k = 0; k < 16; ++k) O[dt][k] = 0.f;
    m = NEGBIG; l = 0.f;
  };
  u32x4 sk[2], sv[2];
  auto stage_load = [&](const NsaSrc& s) {
#pragma unroll
    for (int i = 0; i < 2; ++i) {
      const int c = tid + 256 * i, row = c >> 3, ch = c & 7;
      sk[i] = *(const u32x4*)(s.k + (size_t)row * s.kld + ch * 8);
      sv[i] = *(const u32x4*)(s.v + (size_t)row * s.vld + ch * 8);
    }
  };
  auto stage_store = [&]() {
#pragma unroll
    for (int i = 0; i < 2; ++i) {
      const int c = tid + 256 * i, row = c >> 3, ch = c & 7;
      *(u32x4*)(Kt + row * 144 + ch * 16) = sk[i];
      *(u32x4*)(Vt + row * 144 + ch * 16) = sv[i];
    }
  };
  auto src_cmp = [&](int tt) { NsaSrc s; s.k = (const u16*)(ws + OFF_KC) + ((size_t)bg * 256 + 64 * tt) * 64; s.kld = 64;
                               s.v = (const u16*)(ws + OFF_VCT) + (size_t)bg * 64 * 256 + 64 * tt; s.vld = 256; return s; };
  auto src_slc = [&](int j) { NsaSrc s; s.k = NKV + ((size_t)b * SEQ + 64 * j) * 768 + 256 + g * 64; s.kld = 768;
                              s.v = (const u16*)(ws + OFF_VST) + (size_t)bg * 64 * 4096 + 64 * j; s.vld = 4096; return s; };
  auto src_win = [&](int j) { NsaSrc s; s.k = NKV + ((size_t)b * SEQ + 64 * j) * 768 + 512 + g * 64; s.kld = 768;
                              s.v = (const u16*)(ws + OFF_VWT) + (size_t)bg * 64 * 4096 + 64 * j; s.vld = 4096; return s; };
  auto gatev = [&](int br) { return sigmoidf_(((const float*)(ws + OFF_SM))[trow * 40 + 16 + head * 3 + br]); };
  auto emit = [&](const float wgt, bool first) {
#pragma unroll
    for (int dt = 0; dt < 2; ++dt)
#pragma unroll
      for (int g4 = 0; g4 < 4; ++g4) {
        u16* dst = OB + trow * 512 + head * 64 + 32 * dt + 8 * g4 + 4 * h;
        float v0 = O[dt][4 * g4] * wgt, v1 = O[dt][4 * g4 + 1] * wgt, v2 = O[dt][4 * g4 + 2] * wgt, v3 = O[dt][4 * g4 + 3] * wgt;
        if (!first) {
          u32x2 old = *(const u32x2*)dst;
          v0 += bflo(old[0]); v1 += bfhi(old[0]); v2 += bflo(old[1]); v3 += bfhi(old[1]);
        }
        u32x2 o; o[0] = pack2(v0, v1); o[1] = pack2(v2, v3);
        *(u32x2*)dst = o;
      }
  };

  const int ntc = (2 * hq + 1 + 63) >> 6;
  reset();
  stage_load(src_cmp(0));
  for (int tt = 0; tt < ntc; ++tt) {
    __syncthreads(); stage_store(); __syncthreads();
    if (tt + 1 < ntc) stage_load(src_cmp(tt + 1)); else stage_load(src_cmp(0));
    nsa_tile<0>(Kt, Vt, Q, O, m, l, t, 64 * tt, true, true, tab, mfin, linv, impw);
  }
  { float lt = l + __shfl_xor(l, 32); mfin = m; linv = lt > 0.f ? 1.f / lt : 0.f; }
  for (int tt = 0; tt < ntc; ++tt) {
    __syncthreads(); stage_store(); __syncthreads();
    if (tt + 1 < ntc) stage_load(src_cmp(tt + 1)); else stage_load(src_slc(0));
    nsa_tile<1>(Kt, Vt, Q, O, m, l, t, 64 * tt, true, true, tab, mfin, linv, impw);
  }
  emit(gatev(0), true);
  unsigned sel_lo, sel_hi;
  if (qi < 16) {
    unsigned long long mk = (2ull << qi) - 1ull;
    sel_lo = (unsigned)mk; sel_hi = (unsigned)(mk >> 32);
  } else {
    unsigned long long mk = 0ull;
    const float* row = impw + (lane & 7) * 68;
    const int part = lane >> 3, hiM = qi - 2;
    for (int mm = 1 + part; mm <= hiM; mm += 8) {
      const float v = row[mm];
      int rank = 0;
      for (int m2 = 1; m2 <= hiM; ++m2) { const float u = row[m2]; rank += ((u > v) || (u == v && m2 < mm)) ? 1 : 0; }
      if (rank < 13) mk |= 1ull << mm;
    }
    mk |= 1ull | (1ull << qi) | (1ull << (qi - 1));
    sel_lo = (unsigned)mk; sel_hi = (unsigned)(mk >> 32);
    sel_lo |= __shfl_xor(sel_lo, 8); sel_hi |= __shfl_xor(sel_hi, 8);
    sel_lo |= __shfl_xor(sel_lo, 16); sel_hi |= __shfl_xor(sel_hi, 16);
    sel_lo |= __shfl_xor(sel_lo, 32); sel_hi |= __shfl_xor(sel_hi, 32);
  }
  reset();
  for (int j = 0; j <= qi; ++j) {
    __syncthreads(); stage_store(); __syncthreads();
    if (j + 1 <= qi) stage_load(src_slc(j + 1)); else stage_load(src_win(qi >= 8 ? qi - 8 : 0));
    const bool lsel = ((j < 32 ? (sel_lo >> j) : (sel_hi >> (j - 32))) & 1u) != 0u;
    nsa_tile<2>(Kt, Vt, Q, O, m, l, t, 64 * j, (qi - j) <= 2, lsel, tab, mfin, linv, impw);
  }
  { float lt = l + __shfl_xor(l, 32); emit(lt > 0.f ? gatev(1) / lt : 0.f, false); }
  reset();
  const int j0 = qi >= 8 ? qi - 8 : 0;
  for (int j = j0; j <= qi; ++j) {
    __syncthreads(); stage_store(); __syncthreads();
    if (j + 1 <= qi) stage_load(src_win(j + 1));
    nsa_tile<3>(Kt, Vt, Q, O, m, l, t, 64 * j, ((qi - j) <= 2) || ((qi - j) == 8), true, tab, mfin, linv, impw);
  }
  { float lt = l + __shfl_xor(l, 32); emit(lt > 0.f ? gatev(2) / lt : 0.f, false); }
}

DI void phase4(const Params& p, char* smem, int cidx = 0) {
  unsigned* cnt = (unsigned*)(p.ws + OFF_MISC + MISC_CNT) + cidx;
  __shared__ int s_item;
  for (;;) {
    __syncthreads();
    if (threadIdx.x == 0) s_item = (int)atomicAdd(cnt, 1u);
    __syncthreads();
    const int it = __builtin_amdgcn_readfirstlane(s_item);
    if (it >= 64 + 2048) break;
    if (it < 64) gdn_scan_item(p, it, smem);
    else { const int k = it - 64; nsa_item(p, k & 15, 127 - (k >> 4), smem); }
  }
}

DI void phase_branch(const Params& p, int bid, int nblk, char* smem) {
  char* ws = p.ws;
  const u16* OA = (const u16*)(ws + OFF_NQ);
  const u16* OB = (const u16*)(ws + OFF_QKV + (size_t)NTOK * 512 * 4);
  const u16* MG = (const u16*)(ws + OFF_MG);
  u16* MIX = (u16*)(ws + OFF_RH);
  for (int t = bid; t < 256 * 8; t += nblk) {
    const int mt = t >> 3, nt = t & 7, m0 = mt * 128, n0 = nt * 128;
    GemmPtrs g;
    f32x16 acc[2][2];
    gemm_setup(g, OA, 512, m0, (const u16*)(ws + OFF_WAT), 512, n0);
    zero_acc(acc);
    gemm_kloop(acc, g, 8, smem);
    gemm_epilogue_lds(acc, smem, [&](int ml, int nl, const float (&v)[8]) {
      const size_t m = m0 + ml; const int n = n0 + nl;
      const u32x4 gt = *(const u32x4*)(MG + m * 2048 + n);
      float t[8];
#pragma unroll
      for (int e = 0; e < 4; ++e) { t[2 * e] = v[2 * e] * sigmoidf_(bflo(gt[e])); t[2 * e + 1] = v[2 * e + 1] * sigmoidf_(bfhi(gt[e])); }
      *(u32x4*)(MIX + m * 1024 + n) = pack8u(t);
    });
    gemm_setup(g, OB, 512, m0, (const u16*)(ws + OFF_WBT), 512, n0);
    zero_acc(acc);
    gemm_kloop(acc, g, 8, smem);
    gemm_epilogue_lds(acc, smem, [&](int ml, int nl, const float (&v)[8]) {
      const size_t m = m0 + ml; const int n = n0 + nl;
      const u32x4 gt = *(const u32x4*)(MG + m * 2048 + 1024 + n);
      const u32x4 old = *(const u32x4*)(MIX + m * 1024 + n);
      float t[8];
#pragma unroll
      for (int e = 0; e < 4; ++e) {
        t[2 * e] = bflo(old[e]) + v[2 * e] * sigmoidf_(bflo(gt[e]));
        t[2 * e + 1] = bfhi(old[e]) + v[2 * e + 1] * sigmoidf_(bfhi(gt[e]));
      }
      *(u32x4*)(MIX + m * 1024 + n) = pack8u(t);
    });
  }
}

DI void phase_outproj(const Params& p, int bid, int nblk, char* smem) {
  char* ws = p.ws;
  const u16* MIX = (const u16*)(ws + OFF_RH);
  for (int t = bid; t < 256 * 8; t += nblk) {
    const int mt = t >> 3, nt = t & 7, m0 = mt * 128, n0 = nt * 128;
    GemmPtrs g;
    f32x16 acc[2][2];
    gemm_setup(g, MIX, 1024, m0, (const u16*)(ws + OFF_WOT), 1024, n0);
    zero_acc(acc);
    gemm_kloop(acc, g, 16, smem);
    gemm_epilogue_lds(acc, smem, [&](int ml, int nl, const float (&v)[8]) {
      const size_t idx = (size_t)(m0 + ml) * 1024 + n0 + nl;
      const f32x4 x0 = *(const f32x4*)(p.x + idx), x1 = *(const f32x4*)(p.x + idx + 4);
      float* X1 = (float*)(ws + OFF_QKV);
      *(f32x4*)(X1 + idx) = f32x4{x0[0] + v[0], x0[1] + v[1], x0[2] + v[2], x0[3] + v[3]};
      *(f32x4*)(X1 + idx + 4) = f32x4{x1[0] + v[4], x1[1] + v[5], x1[2] + v[6], x1[3] + v[7]};
    });
  }
}

DI void phase_query(const Params& p, int bid, int nblk, char* smem) {
  char* ws = p.ws;
  const u16* H2 = (const u16*)(ws + OFF_RH);
  u16* QRY = (u16*)(ws + OFF_MG);
  for (int t = bid; t < 256 * 16; t += nblk) {
    const int mt = t >> 4, nt = t & 15, m0 = mt * 128, n0 = nt * 128;
    GemmPtrs g;
    f32x16 acc[2][2];
    gemm_setup(g, H2, 1024, m0, (const u16*)(ws + OFF_WQT), 1024, n0);
    zero_acc(acc);
    gemm_kloop(acc, g, 16, smem);
    gemm_epilogue_lds(acc, smem, [&](int ml, int nl, const float (&v)[8]) { *(u32x4*)(QRY + (size_t)(m0 + ml) * 2048 + n0 + nl) = pack8u(v); });
  }
}

DI unsigned f2ord(float f) { unsigned u = __float_as_uint(f); return (u & 0x80000000u) ? ~u : (u | 0x80000000u); }
DI float ord2f(unsigned o) { unsigned u = (o & 0x80000000u) ? (o & 0x7fffffffu) : ~o; return __uint_as_float(u); }

DI void peer_route_job(const Params& p, int job, char* smem) {
  char* ws = p.ws;
  const int mt = job >> 3, hd = job & 7, m0 = mt * 128;
  const u16* QRY = (const u16*)(ws + OFF_MG);
  const u16* SK = (const u16*)(ws + OFF_SK);
  unsigned* keys = (unsigned*)smem;
  const int tid = threadIdx.x + opaque0();
  unsigned top[2][16];
#pragma unroll
  for (int pp = 0; pp < 2; ++pp) {
    GemmPtrs g;
    f32x16 acc[2][2];
    gemm_setup(g, QRY + (hd * 2 + pp) * 128, 2048, m0, SK + (size_t)(hd * 2 + pp) * 128 * 128, 128, 0);
    zero_acc(acc);
    gemm_kloop(acc, g, 2, smem);
    gemm_epilogue(acc, [&](int ml, int nl, float v) { keys[ml * 129 + nl] = (f2ord(v) & ~127u) | (unsigned)(127 - nl); });
    __syncthreads();
    if (tid < 128) {
      const unsigned* row = keys + tid * 129;
      unsigned prev = 0xffffffffu;
#pragma unroll
      for (int rd = 0; rd < 16; ++rd) {
        unsigned best = 0u;
#pragma unroll 8
        for (int j = 0; j < 128; ++j) { unsigned k = row[j]; k = (k < prev) ? k : 0u; best = (k > best) ? k : best; }
        top[pp][rd] = best; prev = best;
      }
    }
    __syncthreads();
  }
  if (tid < 128) {
    float v1[16], v2[16];
    int i1[16], i2[16];
#pragma unroll
    for (int i = 0; i < 16; ++i) {
      v1[i] = ord2f(top[0][i] & ~127u); i1[i] = 127 - (int)(top[0][i] & 127u);
      v2[i] = ord2f(top[1][i] & ~127u); i2[i] = 127 - (int)(top[1][i] & 127u);
    }
    float pv = 3.0e38f; int pf = -1;
    float selv[16];
    int* EI = (int*)(ws + OFF_NQ) + ((size_t)(m0 + tid) * 128 + hd * 16);
    float* GT = (float*)(ws + OFF_NKV) + ((size_t)(m0 + tid) * 128 + hd * 16);
#pragma unroll
    for (int rd = 0; rd < 16; ++rd) {
      float bv = -3.0e38f; int bf = 1 << 20, be = 0;
#pragma unroll
      for (int i = 0; i < 16; ++i)
#pragma unroll
        for (int j = 0; j < 16; ++j)
          if ((i + 1) * (j + 1) <= 16) {
            const float c = v1[i] + v2[j];
            const int fl = i * 16 + j;
            const bool elig = (c < pv) || (c == pv && fl > pf);
            const bool better = elig && (c > bv);
            bv = better ? c : bv; bf = better ? fl : bf; be = better ? (i1[i] * 128 + i2[j]) : be;
          }
      selv[rd] = bv; pv = bv; pf = bf;
      EI[rd] = be;
    }
    float sum = 0.f;
    const float mx = selv[0];
#pragma unroll
    for (int k = 0; k < 16; ++k) { selv[k] = __expf(selv[k] - mx); sum += selv[k]; }
    const float inv = 1.f / sum;
#pragma unroll
    for (int k = 0; k < 16; ++k) GT[k] = selv[k] * inv;
  }
}

DI float gelu_tanh(float x) {
  const float u = 0.7978845608028654f * (x + 0.044715f * x * x * x);
  const float e = __expf(2.f * u);
  const float th = 1.f - 2.f / (e + 1.f);
  return 0.5f * x * (1.f + th);
}
DI void peer_expert_phase(const Params& p, int bid, int nblk) {
  char* ws = p.ws;
  const int lane = threadIdx.x & 63, wv = threadIdx.x >> 6;
  const unsigned char* EU = (const unsigned char*)(ws + OFF_EU);
  const unsigned char* EV = (const unsigned char*)(ws + OFF_EV);
  const float* SCU = (const float*)(ws + OFF_MISC + MISC_SCU);
  const float* SCV = (const float*)(ws + OFF_MISC + MISC_SCV);
  const int* EI = (const int*)(ws + OFF_NQ);
  const float* GT = (const float*)(ws + OFF_NKV);
  for (int tok = bid * 4 + wv; tok < NTOK; tok += nblk * 4) {
    const float* xr = (const float*)(ws + OFF_QKV) + (size_t)tok * 1024 + 16 * lane;
    f32x4 xa[4];
    float ss = 0.f;
#pragma unroll
    for (int i = 0; i < 4; ++i) { xa[i] = *(const f32x4*)(xr + 4 * i); ss += xa[i][0] * xa[i][0] + xa[i][1] * xa[i][1] + xa[i][2] * xa[i][2] + xa[i][3] * xa[i][3]; }
    ss = wave_sum(ss);
    const float rs = rsqrtf(ss * (1.f / 1024.f) + 1e-6f);
    f32x2 h2[8];
#pragma unroll
    for (int i = 0; i < 4; ++i) {
      const f32x4 w4 = *(const f32x4*)(p.norm_ffn + 16 * lane + 4 * i);
      h2[2 * i] = f32x2{bf2f(f2bf(xa[i][0] * rs * w4[0])), bf2f(f2bf(xa[i][1] * rs * w4[1]))};
      h2[2 * i + 1] = f32x2{bf2f(f2bf(xa[i][2] * rs * w4[2])), bf2f(f2bf(xa[i][3] * rs * w4[3]))};
    }
    f32x2 outv[8];
#pragma unroll
    for (int i = 0; i < 8; ++i) outv[i] = f32x2{0.f, 0.f};
#pragma unroll 1
    for (int bt = 0; bt < 2; ++bt) {
      const int eidx = EI[(size_t)tok * 128 + bt * 64 + lane];
      const float gt = GT[(size_t)tok * 128 + bt * 64 + lane];
      const float su = SCU[eidx], sv = SCV[eidx];
      float acc[64];
      {
        u32x4 cur[8], nxt[8];
#pragma unroll
        for (int j = 0; j < 8; ++j) cur[j] = *(const u32x4*)(EU + (size_t)__builtin_amdgcn_readlane(eidx, j) * 1024 + 16 * lane);
#pragma unroll
        for (int g = 0; g < 8; ++g) {
          if (g < 7) {
#pragma unroll
            for (int j = 0; j < 8; ++j) nxt[j] = *(const u32x4*)(EU + (size_t)__builtin_amdgcn_readlane(eidx, 8 * (g + 1) + j) * 1024 + 16 * lane);
          }
#pragma unroll
          for (int j = 0; j < 8; ++j) {
            f32x2 d = f32x2{0.f, 0.f};
#pragma unroll
            for (int i = 0; i < 4; ++i) {
              d += __builtin_amdgcn_cvt_pk_f32_fp8(cur[j][i], false) * h2[2 * i];
              d += __builtin_amdgcn_cvt_pk_f32_fp8(cur[j][i], true) * h2[2 * i + 1];
            }
            acc[8 * g + j] = d[0] + d[1];
          }
#pragma unroll
          for (int j = 0; j < 8; ++j) cur[j] = nxt[j];
        }
      }
#pragma unroll
      for (int st = 0; st < 6; ++st) {
        const int half = 32 >> st;
        const bool up = (lane & half) != 0;
#pragma unroll
        for (int k = 0; k < half; ++k) {
          const float send = up ? acc[k] : acc[k + half];
          const float keep = up ? acc[k + half] : acc[k];
          acc[k] = keep + __shfl_xor(send, half);
        }
      }
      const float wgt = gt * gelu_tanh(acc[0] * su) * sv;
      {
        u32x4 cur[8], nxt[8];
#pragma unroll
        for (int j = 0; j < 8; ++j) cur[j] = *(const u32x4*)(EV + (size_t)__builtin_amdgcn_readlane(eidx, j) * 1024 + 16 * lane);
#pragma unroll
        for (int g = 0; g < 8; ++g) {
          if (g < 7) {
#pragma unroll
            for (int j = 0; j < 8; ++j) nxt[j] = *(const u32x4*)(EV + (size_t)__builtin_amdgcn_readlane(eidx, 8 * (g + 1) + j) * 1024 + 16 * lane);
          }
#pragma unroll
          for (int j = 0; j < 8; ++j) {
            const float we = __uint_as_float((unsigned)__builtin_amdgcn_readlane((int)__float_as_uint(wgt), 8 * g + j));
            const f32x2 w2 = f32x2{we, we};
#pragma unroll
            for (int i = 0; i < 4; ++i) {
              outv[2 * i] += __builtin_amdgcn_cvt_pk_f32_fp8(cur[j][i], false) * w2;
              outv[2 * i + 1] += __builtin_amdgcn_cvt_pk_f32_fp8(cur[j][i], true) * w2;
            }
          }
#pragma unroll
          for (int j = 0; j < 8; ++j) cur[j] = nxt[j];
        }
      }
    }
    float s2 = 0.f;
#pragma unroll
    for (int i = 0; i < 4; ++i) {
      xa[i][0] += outv[2 * i][0]; xa[i][1] += outv[2 * i][1]; xa[i][2] += outv[2 * i + 1][0]; xa[i][3] += outv[2 * i + 1][1];
      s2 += xa[i][0] * xa[i][0] + xa[i][1] * xa[i][1] + xa[i][2] * xa[i][2] + xa[i][3] * xa[i][3];
    }
    s2 = wave_sum(s2);
    const float r2 = rsqrtf(s2 * (1.f / 1024.f) + 1e-6f);
    float* orow = p.out + (size_t)tok * 1024 + 16 * lane;
#pragma unroll
    for (int i = 0; i < 4; ++i) {
      const f32x4 nw = *(const f32x4*)(p.norm_final + 16 * lane + 4 * i);
      *(f32x4*)(orow + 4 * i) = f32x4{xa[i][0] * r2 * nw[0], xa[i][1] * r2 * nw[1], xa[i][2] * r2 * nw[2], xa[i][3] * r2 * nw[3]};
    }
  }
}

#ifndef MK_SINGLE
#define MK_SINGLE 1
#endif
#define SMEM_DECL __shared__ __attribute__((aligned(16))) char smem[SMEM_BYTES]

DI void run_phase(const Params& p, int ph, int bid, int nblk, char* smem) {
  switch (ph) {
    case 0: phase0(p, bid, nblk, smem); break;
    case 1: phase_inproj(p, bid, nblk, smem); break;
    case 2: phase2(p, bid, nblk, smem); break;
    case 3: phase4(p, smem); break;
    case 4: phase_gdn_post(p, bid, nblk); break;
    case 5: phase_branch(p, bid, nblk, smem); break;
    case 6: phase_outproj(p, bid, nblk, smem); break;
    case 7: rmsnorm_rows_bf16((const float*)(p.ws + OFF_QKV), p.norm_ffn, (u16*)(p.ws + OFF_RH), NTOK, bid, nblk); break;
    case 8: phase_query(p, bid, nblk, smem); break;
    case 9: for (int j = bid; j < 2048; j += nblk) peer_route_job(p, j, smem); break;
    case 10: peer_expert_phase(p, bid, nblk); break;
  }
}
constexpr int NPHASES = 11;

#if MK_SINGLE
__global__ void __launch_bounds__(NTHREADS, 2) fwd_megakernel(Params p) {
  SMEM_DECL;
  cg::grid_group grid = cg::this_grid();
  const int bid = blockIdx.x, nblk = gridDim.x;
  run_phase(p, 0, bid, nblk, smem); grid.sync();
  run_phase(p, 1, bid, nblk, smem); grid.sync();
  run_phase(p, 2, bid, nblk, smem); grid.sync();
  run_phase(p, 3, bid, nblk, smem); grid.sync();
  run_phase(p, 4, bid, nblk, smem); grid.sync();
  run_phase(p, 5, bid, nblk, smem); grid.sync();
  run_phase(p, 6, bid, nblk, smem); grid.sync();
  run_phase(p, 7, bid, nblk, smem); grid.sync();
  run_phase(p, 8, bid, nblk, smem); grid.sync();
  run_phase(p, 9, bid, nblk, smem); grid.sync();
  run_phase(p, 10, bid, nblk, smem);
}
#else
template <int PH>
__global__ void __launch_bounds__(NTHREADS, 2) phase_kernel(Params p) {
  SMEM_DECL;
  run_phase(p, PH, blockIdx.x, gridDim.x, smem);
}
__global__ void __launch_bounds__(NTHREADS, 2) phase4_again(Params p) { SMEM_DECL; phase4(p, smem, 1); }
#ifndef REPEAT_MASK
#define REPEAT_MASK 0
#endif
#endif

extern "C" void kernel_launch(void* const* d_in, const int* in_sizes, int n_in, void* d_out, int out_size, void* d_ws, size_t ws_size,
                              hipStream_t stream) {
  Params p{};
  const float** f = (const float**)&p;
  for (int i = 0; i < 21; ++i) f[i] = (const float*)d_in[i];
  p.out = (float*)d_out;
  p.ws = (char*)d_ws;
  if (ws_size < WS_NEEDED) return;
#if MK_SINGLE
  static int grid_blocks = 0;
  if (!grid_blocks) {
    int dev = 0, cus = 0, per_cu = 0;
    hipGetDevice(&dev);
    hipDeviceGetAttribute(&cus, hipDeviceAttributeMultiprocessorCount, dev);
    hipOccupancyMaxActiveBlocksPerMultiprocessor(&per_cu, fwd_megakernel, NTHREADS, 0);
    if (per_cu > 2) per_cu = 2;
    grid_blocks = cus * per_cu;
  }
  void* args[] = {&p};
  hipLaunchCooperativeKernel((void*)fwd_megakernel, dim3(grid_blocks), dim3(NTHREADS), args, 0, stream);
#else
  const int G = 512;
  phase_kernel<0><<<G, NTHREADS, 0, stream>>>(p);
#if REPEAT_MASK & (1 << 0)
  phase_kernel<0><<<G, NTHREADS, 0, stream>>>(p);
#endif
  phase_kernel<1><<<G, NTHREADS, 0, stream>>>(p);
#if REPEAT_MASK & (1 << 1)
  phase_kernel<1><<<G, NTHREADS, 0, stream>>>(p);
#endif
  phase_kernel<2><<<G, NTHREADS, 0, stream>>>(p);
#if REPEAT_MASK & (1 << 2)
  phase_kernel<2><<<G, NTHREADS, 0, stream>>>(p);
#endif
  phase_kernel<3><<<G, NTHREADS, 0, stream>>>(p);
#if REPEAT_MASK & (1 << 3)
  phase4_again<<<G, NTHREADS, 0, stream>>>(p);
#endif
  phase_kernel<4><<<G, NTHREADS, 0, stream>>>(p);
#if REPEAT_MASK & (1 << 4)
  phase_kernel<4><<<G, NTHREADS, 0, stream>>>(p);
#endif
  phase_kernel<5><<<G, NTHREADS, 0, stream>>>(p);
#if REPEAT_MASK & (1 << 5)
  phase_kernel<5><<<G, NTHREADS, 0, stream>>>(p);
#endif
  phase_kernel<6><<<G, NTHREADS, 0, stream>>>(p);
#if REPEAT_MASK & (1 << 6)
  phase_kernel<6><<<G, NTHREADS, 0, stream>>>(p);
#endif
  phase_kernel<7><<<G, NTHREADS, 0, stream>>>(p);
#if REPEAT_MASK & (1 << 7)
  phase_kernel<7><<<G, NTHREADS, 0, stream>>>(p);
#endif
  phase_kernel<8><<<G, NTHREADS, 0, stream>>>(p);
#if REPEAT_MASK & (1 << 8)
  phase_kernel<8><<<G, NTHREADS, 0, stream>>>(p);
#endif
  phase_kernel<9><<<G, NTHREADS, 0, stream>>>(p);
#if REPEAT_MASK & (1 << 9)
  phase_kernel<9><<<G, NTHREADS, 0, stream>>>(p);
#endif
  phase_kernel<10><<<G, NTHREADS, 0, stream>>>(p);
#if REPEAT_MASK & (1 << 10)
  phase_kernel<10><<<G, NTHREADS, 0, stream>>>(p);
#endif
#endif
}
```

```cpp
#include <hip/hip_runtime.h>
#include <hip/hip_cooperative_groups.h>
#include <stdint.h>
namespace cg = cooperative_groups;

#define DI __device__ __forceinline__
typedef unsigned short u16;
typedef __attribute__((ext_vector_type(8))) short bf16x8;
typedef __attribute__((ext_vector_type(16))) float f32x16;
typedef __attribute__((ext_vector_type(4))) float f32x4;
typedef __attribute__((ext_vector_type(4))) unsigned u32x4;
typedef __attribute__((ext_vector_type(2))) unsigned u32x2;
typedef __attribute__((ext_vector_type(2))) __bf16 bf16x2v;

constexpr int BATCH = 8, SEQ = 4096, DM = 1024, NTOK = BATCH * SEQ;
constexpr int NIN = 5416, NP = 5504;
constexpr int NTHREADS = 256;
constexpr int SMEM_BYTES = 72 * 1024;
constexpr float L2E = 1.4426950408889634f;

constexpr size_t AL(size_t x) { return (x + 255) & ~(size_t)255; }
constexpr size_t OFF_WINT = 0;
constexpr size_t OFF_WAT = OFF_WINT + AL((size_t)NP * 1024 * 2);
constexpr size_t OFF_WBT = OFF_WAT + AL((size_t)1024 * 512 * 2);
constexpr size_t OFF_WOT = OFF_WBT + AL((size_t)1024 * 512 * 2);
constexpr size_t OFF_WQT = OFF_WOT + AL((size_t)1024 * 1024 * 2);
constexpr size_t OFF_SK = OFF_WQT + AL((size_t)2048 * 1024 * 2);
constexpr size_t OFF_WKT = OFF_SK + AL((size_t)16 * 128 * 128 * 2);
constexpr size_t OFF_WVT = OFF_WKT + AL((size_t)128 * 2048 * 2);
constexpr size_t OFF_EU = OFF_WVT + AL((size_t)128 * 2048 * 2);
constexpr size_t OFF_EV = OFF_EU + AL((size_t)16384 * 1024 * 2);
constexpr size_t OFF_MISC = OFF_EV + AL((size_t)16384 * 1024 * 2);
constexpr size_t MISC_CK = 0, MISC_CV = 256, MISC_BIAS = 512, MISC_CNT = 512 + 8 * 132 * 4 + 256, MISC_GL = 8192;
constexpr size_t MISC_SCU = 65536, MISC_SCV = 131072;
constexpr size_t OFF_RH = OFF_MISC + 262144;
constexpr size_t OFF_QKV = OFF_RH + (size_t)NTOK * 1024 * 2;
constexpr size_t OFF_Z = OFF_QKV + (size_t)NTOK * 1536 * 2;
constexpr size_t OFF_NQ = OFF_Z + (size_t)NTOK * 512 * 2;
constexpr size_t OFF_NKV = OFF_NQ + (size_t)NTOK * 512 * 2;
constexpr size_t OFF_MG = OFF_NKV + (size_t)NTOK * 768 * 2;
constexpr size_t OFF_SM = OFF_MG + (size_t)NTOK * 2048 * 2;
constexpr size_t OFF_VST = OFF_SM + AL((size_t)NTOK * 40 * 4);
constexpr size_t OFF_VWT = OFF_VST + (size_t)16 * 64 * 4096 * 2;
constexpr size_t OFF_KC = OFF_VWT + (size_t)16 * 64 * 4096 * 2;
constexpr size_t OFF_VCT = OFF_KC + (size_t)16 * 256 * 64 * 2;
constexpr size_t WS_NEEDED = OFF_VCT + (size_t)16 * 64 * 256 * 2;

struct Params {
  const float *x, *rel_bias, *norm_final, *norm_mix, *w_in, *conv_w, *a_log, *dt_bias, *gdn_norm, *cmp_pe_k, *cmp_pe_v,
      *cmp_w_k, *cmp_w_v, *w_a, *w_b, *w_out, *norm_ffn, *w_query, *sub_keys, *expert_u, *expert_v;
  float* out;
  char* ws;
};

DI u16 f2bf(float x) { return __builtin_bit_cast(u16, (__bf16)x); }
DI float bf2f(u16 b) { return __uint_as_float(((unsigned)b) << 16); }
DI unsigned pack2(float lo, float hi) { return (unsigned)f2bf(lo) | ((unsigned)f2bf(hi) << 16); }
DI float bflo(unsigned u) { return __uint_as_float(u << 16); }
DI float bfhi(unsigned u) { return __uint_as_float(u & 0xffff0000u); }
DI float wave_sum(float v) {
#pragma unroll
  for (int o = 32; o >= 1; o >>= 1) v += __shfl_xor(v, o);
  return v;
}
DI int tidx() { int t = (int)__builtin_amdgcn_workitem_id_x(); asm volatile("" : "+v"(t)); return t; }
DI int opaque0() { int z = 0; asm volatile("" : "+v"(z)); return z; }
DI float sigmoidf_(float x) { return 1.f / (1.f + __expf(-x)); }
DI f32x16 mfma32(bf16x8 a, bf16x8 b, f32x16 c) { return __builtin_amdgcn_mfma_f32_32x32x16_bf16(a, b, c, 0, 0, 0); }
DI f32x4 mfma16(bf16x8 a, bf16x8 b, f32x4 c) { return __builtin_amdgcn_mfma_f32_16x16x32_bf16(a, b, c, 0, 0, 0); }
DI int swz(int row, int ch) { return row * 128 + ((ch ^ ((row >> 1) & 7)) << 4); }
DI bf16x8 lds_frag(const char* tile, int row, int ch) { return *(const bf16x8*)(tile + swz(row, ch)); }
DI bf16x8 pad_frag(const char* tile, int row, int ch) { return *(const bf16x8*)(tile + row * 144 + ch * 16); }
DI bf16x8 pack8(float a0, float a1, float a2, float a3, float a4, float a5, float a6, float a7) {
  u32x4 p;
  p[0] = pack2(a0, a1); p[1] = pack2(a2, a3); p[2] = pack2(a4, a5); p[3] = pack2(a6, a7);
  return __builtin_bit_cast(bf16x8, p);
}
DI int perm16(int o) { return (o & ~12) | ((o & 4) << 1) | ((o & 8) >> 1); }

DI int win_colmap(int n) {
  if (n < 2048) return n;
  if (n < 2560) return n - 2048 + 2064;
  if (n < 3328) return n - 2560 + 2576;
  if (n < 5376) return n - 3328 + 3368;
  if (n < 5392) return n - 5376 + 2048;
  if (n < 5416) return n - 5392 + 3344;
  return -1;
}
template <int MAPMODE>
DI void tconv_tile(const float* __restrict__ src, int K, int N, u16* __restrict__ dst, int kt, int nt, char* smem) {
  float* tile = (float*)smem;
  const int tid = tidx();
  const int nl = tid & 63, k0 = kt * 64, n0 = nt * 64;
  int col;
  if (MAPMODE == 1) col = win_colmap(n0 + nl); else col = (n0 + nl < N) ? (n0 + nl) : -1;
#pragma unroll 4
  for (int i = 0; i < 16; ++i) {
    int kl = (tid >> 6) + 4 * i;
    float v = (col >= 0) ? src[(size_t)(k0 + kl) * N + col] : 0.f;
    tile[kl * 65 + nl] = v;
  }
  __syncthreads();
  {
    const int n2 = tid >> 2, kp = tid & 3;
    u32x4 o0, o1;
#pragma unroll
    for (int i = 0; i < 4; ++i) {
      o0[i] = pack2(tile[(kp * 16 + 2 * i) * 65 + n2], tile[(kp * 16 + 2 * i + 1) * 65 + n2]);
      o1[i] = pack2(tile[(kp * 16 + 8 + 2 * i) * 65 + n2], tile[(kp * 16 + 8 + 2 * i + 1) * 65 + n2]);
    }
    u16* d = dst + (size_t)(n0 + n2) * K + k0 + kp * 16;
    *(u32x4*)d = o0;
    *(u32x4*)(d + 8) = o1;
  }
  __syncthreads();
}

DI void convert_flat(const float* __restrict__ src, u16* __restrict__ dst, size_t n, int bid, int nblk) {
  size_t nv = n / 8;
  for (size_t i = (size_t)bid * NTHREADS + tidx(); i < nv; i += (size_t)nblk * NTHREADS) {
    f32x4 a = ((const f32x4*)src)[2 * i], b = ((const f32x4*)src)[2 * i + 1];
    u32x4 o;
    o[0] = pack2(a[0], a[1]); o[1] = pack2(a[2], a[3]); o[2] = pack2(b[0], b[1]); o[3] = pack2(b[2], b[3]);
    ((u32x4*)dst)[i] = o;
  }
}


typedef __attribute__((ext_vector_type(2))) float f32x2;
DI unsigned f32_to_e4m3(float x) {
  unsigned u = __float_as_uint(x);
  const unsigned sign = (u >> 24) & 0x80u;
  u &= 0x7fffffffu;
  const float ax = __uint_as_float(u);
  unsigned r;
  if (ax < 0.015625f) r = (unsigned)__float2int_rn(ax * 512.f);
  else { u += 0x7ffffu + ((u >> 20) & 1u); r = (u >> 20) - (120u << 3); if (r > 0x7eu) r = 0x7eu; }
  return sign | r;
}
DI void convert_fp8_rows(const float* __restrict__ src, unsigned char* __restrict__ dst, float* __restrict__ inv_scale, int nrows, int bid, int nblk) {
  const int lane = tidx() & 63, wv = tidx() >> 6;
  for (int row = bid * 4 + wv; row < nrows; row += nblk * 4) {
    const f32x4* sp = (const f32x4*)(src + (size_t)row * 1024 + 16 * lane);
    f32x4 v[4];
    float mx = 0.f;
#pragma unroll
    for (int i = 0; i < 4; ++i) { v[i] = sp[i]; mx = fmaxf(mx, fmaxf(fmaxf(fabsf(v[i][0]), fabsf(v[i][1])), fmaxf(fabsf(v[i][2]), fabsf(v[i][3])))); }
#pragma unroll
    for (int o = 32; o >= 1; o >>= 1) mx = fmaxf(mx, __shfl_xor(mx, o));
    const float sc = (mx > 0.f) ? 240.f / mx : 1.f;
    u32x4 o4;
#pragma unroll
    for (int i = 0; i < 4; ++i)
      o4[i] = f32_to_e4m3(v[i][0] * sc) | (f32_to_e4m3(v[i][1] * sc) << 8) | (f32_to_e4m3(v[i][2] * sc) << 16) | (f32_to_e4m3(v[i][3] * sc) << 24);
    *(u32x4*)(dst + (size_t)row * 1024 + 16 * lane) = o4;
    if (lane == 0) inv_scale[row] = (mx > 0.f) ? mx / 240.f : 1.f;
  }
}

DI void rmsnorm_rows_bf16(const float* __restrict__ src, const float* __restrict__ w, u16* __restrict__ dst, int nrows, int bid, int nblk) {
  const int lane = tidx() & 63, wv = tidx() >> 6;
  f32x4 wr[4];
#pragma unroll
  for (int i = 0; i < 4; ++i) wr[i] = ((const f32x4*)w)[lane + 64 * i];
  for (int row = bid * 4 + wv; row < nrows; row += nblk * 4) {
    const f32x4* s = (const f32x4*)(src + (size_t)row * 1024);
    f32x4 v[4];
    float ss = 0.f;
#pragma unroll
    for (int i = 0; i < 4; ++i) { v[i] = s[lane + 64 * i]; ss += v[i][0] * v[i][0] + v[i][1] * v[i][1] + v[i][2] * v[i][2] + v[i][3] * v[i][3]; }
    ss = wave_sum(ss);
    float rs = rsqrtf(ss * (1.f / 1024.f) + 1e-6f);
#pragma unroll
    for (int i = 0; i < 4; ++i) {
      u32x2 o;
      o[0] = pack2(v[i][0] * rs * wr[i][0], v[i][1] * rs * wr[i][1]);
      o[1] = pack2(v[i][2] * rs * wr[i][2], v[i][3] * rs * wr[i][3]);
      *(u32x2*)(dst + (size_t)row * 1024 + (lane + 64 * i) * 4) = o;
    }
  }
}

DI int t5_bucket(int d) {
  if (d < 16) return d < 0 ? 0 : d;
  const int th[16] = {16, 19, 21, 24, 27, 31, 35, 40, 46, 52, 59, 67, 77, 87, 99, 113};
  int b = 16;
#pragma unroll
  for (int k = 1; k < 16; ++k) b += (d >= th[k]) ? 1 : 0;
  return b;
}

DI void phase0(const Params& p, int bid, int nblk, char* smem) {
  char* ws = p.ws;
  const int n_win = 16 * 86, n_wa = 8 * 16, n_wo = 16 * 16, n_wq = 16 * 32, n_wc = 32 * 2;
  const int total = n_win + 2 * n_wa + n_wo + n_wq + 2 * n_wc;
  for (int it = bid; it < total; it += nblk) {
    int i = it;
    if (i < n_win) { tconv_tile<1>(p.w_in, 1024, NIN, (u16*)(ws + OFF_WINT), i / 86, i % 86, smem); continue; }
    i -= n_win;
    if (i < n_wa) { tconv_tile<0>(p.w_a, 512, 1024, (u16*)(ws + OFF_WAT), i / 16, i % 16, smem); continue; }
    i -= n_wa;
    if (i < n_wa) { tconv_tile<0>(p.w_b, 512, 1024, (u16*)(ws + OFF_WBT), i / 16, i % 16, smem); continue; }
    i -= n_wa;
    if (i < n_wo) { tconv_tile<0>(p.w_out, 1024, 1024, (u16*)(ws + OFF_WOT), i / 16, i % 16, smem); continue; }
    i -= n_wo;
    if (i < n_wq) { tconv_tile<0>(p.w_query, 1024, 2048, (u16*)(ws + OFF_WQT), i / 32, i % 32, smem); continue; }
    i -= n_wq;
    if (i < n_wc) { tconv_tile<0>(p.cmp_w_k, 2048, 64, (u16*)(ws + OFF_WKT), i / 2, i % 2, smem); continue; }
    i -= n_wc;
    tconv_tile<0>(p.cmp_w_v, 2048, 64, (u16*)(ws + OFF_WVT), i / 2, i % 2, smem);
  }
  convert_flat(p.sub_keys, (u16*)(ws + OFF_SK), (size_t)16 * 128 * 128, bid, nblk);
  convert_fp8_rows(p.expert_u, (unsigned char*)(ws + OFF_EU), (float*)(ws + OFF_MISC + MISC_SCU), 16384, bid, nblk);
  convert_fp8_rows(p.expert_v, (unsigned char*)(ws + OFF_EV), (float*)(ws + OFF_MISC + MISC_SCV), 16384, bid, nblk);
  rmsnorm_rows_bf16(p.x, p.norm_mix, (u16*)(ws + OFF_RH), NTOK, bid, nblk);
  const int tid = tidx();
  if (bid == nblk - 1) {
    float* ck = (float*)(ws + OFF_MISC + MISC_CK);
    float* cv = (float*)(ws + OFF_MISC + MISC_CV);
    if (tid < 128) {
      const int e = tid & 63;
      const float* pe = (tid < 64) ? p.cmp_pe_k : p.cmp_pe_v;
      const float* W = (tid < 64) ? p.cmp_w_k : p.cmp_w_v;
      float s = 0.f;
      for (int k = 0; k < 2048; ++k) s += pe[k] * W[(size_t)k * 64 + e];
      if (tid < 64) ck[e] = s; else cv[e] = s;
    }
  }
  if (bid == nblk - 2 || nblk == 1) {
    float* bt = (float*)(ws + OFF_MISC + MISC_BIAS);
    for (int i = tid; i < 8 * 132; i += NTHREADS) {
      int hd = i / 132, d = i % 132;
      bt[i] = p.rel_bias[t5_bucket(d) * 8 + hd] * L2E;
    }
    if (tid < 16) ((unsigned*)(ws + OFF_MISC + MISC_CNT))[tid] = 0u;
  }
}

struct GemmPtrs {
  const u16* a[4];
  const u16* b[4];
  long aks, bks;
};

typedef __attribute__((address_space(3))) unsigned* lds_u32p;
DI void glds16(const u16* gsrc, const char* lds_dst) {
  __builtin_amdgcn_global_load_lds((const unsigned*)gsrc, (lds_u32p)(unsigned)(size_t)lds_dst, 16, 0, 0);
}
DI void gemm_kloop(f32x16 (&acc)[2][2], const GemmPtrs& g, int nkt, char* smem) {
  const int tid = tidx(), lane = tid & 63, w = tid >> 6, wm = w >> 1, wn = w & 1, r = lane & 31, h = lane >> 5;
  const char* dstA = smem + (w * 4) * 1024 + lane * 16;
#pragma unroll
  for (int i = 0; i < 4; ++i) { glds16(g.a[i], dstA + i * 1024); glds16(g.b[i], dstA + 16384 + i * 1024); }
  asm volatile("s_waitcnt vmcnt(0)" ::: "memory");
  __syncthreads();
  for (int kt = 0; kt < nkt; ++kt) {
    const char* A = smem + (kt & 1) * 32768;
    const char* B = A + 16384;
    if (kt + 1 < nkt) {
      const char* d2 = dstA + ((kt + 1) & 1) * 32768;
#pragma unroll
      for (int i = 0; i < 4; ++i) { glds16(g.a[i] + (long)(kt + 1) * g.aks, d2 + i * 1024); glds16(g.b[i] + (long)(kt + 1) * g.bks, d2 + 16384 + i * 1024); }
    }
#pragma unroll
    for (int s = 0; s < 4; ++s) {
      bf16x8 a0 = lds_frag(A, wm * 64 + r, 2 * s + h);
      bf16x8 a1 = lds_frag(A, wm * 64 + 32 + r, 2 * s + h);
      bf16x8 b0 = lds_frag(B, wn * 64 + r, 2 * s + h);
      bf16x8 b1 = lds_frag(B, wn * 64 + 32 + r, 2 * s + h);
      acc[0][0] = mfma32(a0, b0, acc[0][0]);
      acc[0][1] = mfma32(a0, b1, acc[0][1]);
      acc[1][0] = mfma32(a1, b0, acc[1][0]);
      acc[1][1] = mfma32(a1, b1, acc[1][1]);
    }
    asm volatile("s_waitcnt vmcnt(0)" ::: "memory");
    __syncthreads();
  }
}

DI void zero_acc(f32x16 (&acc)[2][2]) {
#pragma unroll
  for (int i = 0; i < 2; ++i)
#pragma unroll
    for (int j = 0; j < 2; ++j)
#pragma unroll
      for (int k = 0; k < 16; ++k) acc[i][j][k] = 0.f;
}
DI int glds_row(int i) { return ((tidx() >> 6) * 4 + i) * 8 + ((tidx() & 63) >> 3); }
DI int glds_chunk(int row) { return (tidx() & 7) ^ ((row >> 1) & 7); }
DI void gemm_setup(GemmPtrs& g, const u16* A, long lda, int m0, const u16* Bt, long ldb, int n0) {
#pragma unroll
  for (int i = 0; i < 4; ++i) {
    const int row = glds_row(i), ch = glds_chunk(row);
    g.a[i] = A + (size_t)(m0 + row) * lda + ch * 8;
    g.b[i] = Bt + (size_t)(n0 + row) * ldb + ch * 8;
  }
  g.aks = 64; g.bks = 64;
}
template <class F>
DI void gemm_epilogue(const f32x16 (&acc)[2][2], F f) {
  const int lane = tidx() & 63, w = tidx() >> 6, wm = w >> 1, wn = w & 1, r = lane & 31, h = lane >> 5;
#pragma unroll
  for (int i = 0; i < 2; ++i)
#pragma unroll
    for (int j = 0; j < 2; ++j) {
#pragma unroll
      for (int k = 0; k < 16; ++k) f(wm * 64 + i * 32 + (k & 3) + 8 * (k >> 2) + 4 * h, wn * 64 + j * 32 + r, acc[i][j][k]);
      asm volatile("" ::: "memory");
    }
}

template <class F>
DI void gemm_epilogue_lds(const f32x16 (&acc)[2][2], char* smem, F f) {
  float* T = (float*)smem;
  {
    const int lane = tidx() & 63, w = tidx() >> 6, wm = w >> 1, wn = w & 1, r = lane & 31, h = lane >> 5;
#pragma unroll
    for (int i = 0; i < 2; ++i)
#pragma unroll
      for (int j = 0; j < 2; ++j)
#pragma unroll
        for (int k = 0; k < 16; ++k) T[(wm * 64 + i * 32 + (k & 3) + 8 * (k >> 2) + 4 * h) * 132 + wn * 64 + j * 32 + r] = acc[i][j][k];
  }
  __syncthreads();
  const int c8 = (tidx() & 15) * 8, r0 = tidx() >> 4;
#pragma unroll 2
  for (int it = 0; it < 8; ++it) {
    const int row = r0 + 16 * it;
    const f32x4 a = *(const f32x4*)(T + row * 132 + c8), b = *(const f32x4*)(T + row * 132 + c8 + 4);
    const float v[8] = {a[0], a[1], a[2], a[3], b[0], b[1], b[2], b[3]};
    f(row, c8, v);
  }
  __syncthreads();
}
DI u32x4 pack8u(const float (&v)[8]) { u32x4 o; o[0] = pack2(v[0], v[1]); o[1] = pack2(v[2], v[3]); o[2] = pack2(v[4], v[5]); o[3] = pack2(v[6], v[7]); return o; }

DI bool xcd_tile(int k, int bid, int nblk, int NMT, int NNT, int& mt, int& nt) {
  if ((nblk & 7) != 0 || nblk < 8) {
    const int t = bid + k * nblk;
    if (t >= NMT * NNT) return false;
    mt = t / NNT; nt = t % NNT; return true;
  }
  const int x = bid & 7, j = bid >> 3, per = nblk >> 3;
  const int groups = NMT >> 6;
  const int i = j + k * per;
  if (i >= groups * 8 * NNT) return false;
  const int g = i / (8 * NNT), rem = i - g * (8 * NNT);
  nt = rem >> 3; mt = ((x + 8 * g) << 3) + (rem & 7);
  return true;
}

DI void phase_inproj(const Params& p, int bid, int nblk, char* smem) {
  char* ws = p.ws;
  const u16* H = (const u16*)(ws + OFF_RH);
  const u16* W = (const u16*)(ws + OFF_WINT);
  const int NT = NP / 128;
  for (int k = 0;; ++k) {
    int mt, nt;
    if (!xcd_tile(k, bid, nblk, 256, NT, mt, nt)) break;
    const int m0 = mt * 128, n0 = nt * 128;
    GemmPtrs g;
    gemm_setup(g, H, 1024, m0, W, 1024, n0);
    f32x16 acc[2][2];
    zero_acc(acc);
    gemm_kloop(acc, g, 16, smem);
    if (n0 >= 5376) {
      float* SM = (float*)(ws + OFF_SM);
      gemm_epilogue_lds(acc, smem, [&](int ml, int nl, const float (&v)[8]) {
        if (nl < 40) {
          float* d = SM + (size_t)(m0 + ml) * 40 + nl;
          *(f32x4*)d = f32x4{v[0], v[1], v[2], v[3]};
          *(f32x4*)(d + 4) = f32x4{v[4], v[5], v[6], v[7]};
        }
      });
    } else {
      u16* dst; int ld, c0;
      if (n0 < 1536) { dst = (u16*)(ws + OFF_QKV); ld = 1536; c0 = n0; }
      else if (n0 < 2048) { dst = (u16*)(ws + OFF_Z); ld = 512; c0 = n0 - 1536; }
      else if (n0 < 2560) { dst = (u16*)(ws + OFF_NQ); ld = 512; c0 = n0 - 2048; }
      else if (n0 < 3328) { dst = (u16*)(ws + OFF_NKV); ld = 768; c0 = n0 - 2560; }
      else { dst = (u16*)(ws + OFF_MG); ld = 2048; c0 = n0 - 3328; }
      gemm_epilogue_lds(acc, smem, [&](int ml, int nl, const float (&v)[8]) { *(u32x4*)(dst + (size_t)(m0 + ml) * ld + c0 + nl) = pack8u(v); });
    }
  }
}

DI void vtrans_item(const Params& p, int item, char* smem) {
  char* ws = p.ws;
  const int tile = item & 63, bg = (item >> 6) & 15, which = item >> 10;
  const int b = bg >> 1, g = bg & 1;
  const u16* NKV = (const u16*)(ws + OFF_NKV);
  u16* VT = (u16*)(ws + (which ? OFF_VWT : OFF_VST)) + (size_t)bg * 64 * 4096;
  const int col0 = (which ? 640 : 384) + g * 64;
  u16* t = (u16*)smem;
  const int tid = tidx();
  {
#pragma unroll
    for (int i = 0; i < 2; ++i) {
      int c = tid + 256 * i, row = c >> 3, ch = c & 7;
      u32x4 v = *(const u32x4*)(NKV + (size_t)(b * SEQ + tile * 64 + row) * 768 + col0 + ch * 8);
      *(u32x4*)(t + row * 72 + ch * 8) = v;
    }
  }
  __syncthreads();
  {
    const int d = tid >> 2, part = tid & 3;
    u32x4 o0, o1;
    u16 vals[16];
#pragma unroll
    for (int pp = 0; pp < 16; ++pp) vals[pp] = t[(part * 16 + perm16(pp)) * 72 + d];
#pragma unroll
    for (int i = 0; i < 4; ++i) {
      o0[i] = (unsigned)vals[2 * i] | ((unsigned)vals[2 * i + 1] << 16);
      o1[i] = (unsigned)vals[8 + 2 * i] | ((unsigned)vals[8 + 2 * i + 1] << 16);
    }
    u16* dst = VT + (size_t)d * 4096 + tile * 64 + part * 16;
    *(u32x4*)dst = o0;
    *(u32x4*)(dst + 8) = o1;
  }
  __syncthreads();
}

DI void cmp_gemm_item(const Params& p, int item, char* smem) {
  char* ws = p.ws;
  const int which = item >> 5, mt = item & 31, m0 = mt * 128;
  const u16* NKV = (const u16*)(ws + OFF_NKV);
  const u16* Wt = (const u16*)(ws + (which ? OFF_WVT : OFF_WKT));
  GemmPtrs g;
#pragma unroll
  for (int i = 0; i < 4; ++i) {
    const int row = glds_row(i), ch = glds_chunk(row);
    int m = m0 + row, bg = m >> 8, n = m & 255;
    if (n > 254) n = 254;
    g.a[i] = NKV + (size_t)((bg >> 1) * SEQ + 16 * n) * 768 + which * 128 + (bg & 1) * 64 + ch * 8;
    g.b[i] = Wt + (size_t)row * 2048 + ch * 8;
  }
  g.aks = 768; g.bks = 64;
  f32x16 acc[2][2];
  zero_acc(acc);
  gemm_kloop(acc, g, 32, smem);
  const float* cc = (const float*)(ws + OFF_MISC + (which ? MISC_CV : MISC_CK));
  if (which == 0) {
    u16* KC = (u16*)(ws + OFF_KC);
    gemm_epilogue_lds(acc, smem, [&](int ml, int nl, const float (&v)[8]) {
      if (nl < 64) {
        float t[8];
#pragma unroll
        for (int e = 0; e < 8; ++e) t[e] = v[e] + cc[nl + e];
        *(u32x4*)(KC + (size_t)(m0 + ml) * 64 + nl) = pack8u(t);
      }
    });
  } else {
    u16* VCT = (u16*)(ws + OFF_VCT);
    gemm_epilogue_lds(acc, smem, [&](int ml, int nl, const float (&v)[8]) {
      if (nl < 64) {
        const int m = m0 + ml, bg = m >> 8, n = m & 255;
        u16* d = VCT + ((size_t)bg * 64 + nl) * 256 + (n & ~15) + perm16(n & 15);
#pragma unroll
        for (int e = 0; e < 8; ++e) d[e * 256] = f2bf(v[e] + cc[nl + e]);
      }
    });
  }
}

DI void gdn_store_frag(u16* dst, const char* tile, int idx  , float scale_is_row, const float* rowscale) {
  const int blk = idx >> 6, lane = idx & 63, rt = blk >> 1, ks = blk & 1, r = lane & 15, q = lane >> 4;
  const int row = 16 * rt + r;
  const int k0 = 32 * ks + 4 * q, k1 = k0 + 16;
  u32x2 lo = *(const u32x2*)(tile + swz(row, k0 >> 3) + (k0 & 7) * 2);
  u32x2 hi = *(const u32x2*)(tile + swz(row, k1 >> 3) + (k1 & 7) * 2);
  u32x4 o;
  if (rowscale) {
    float s = rowscale[row];
    o[0] = pack2(bflo(lo[0]) * s, bfhi(lo[0]) * s); o[1] = pack2(bflo(lo[1]) * s, bfhi(lo[1]) * s);
    o[2] = pack2(bflo(hi[0]) * s, bfhi(hi[0]) * s); o[3] = pack2(bflo(hi[1]) * s, bfhi(hi[1]) * s);
  } else { o[0] = lo[0]; o[1] = lo[1]; o[2] = hi[0]; o[3] = hi[1]; }
  *(u32x4*)(dst + (size_t)idx * 8) = o;
}

DI void gdn_chunk_item(const Params& p, int item, char* smem) {
  char* ws = p.ws;
  const int n = item & 63, bh = item >> 6, b = bh >> 3, hd = bh & 7;
  const int tid = tidx() + opaque0(), lane = tid & 63, w = tid >> 6;
  char* Cq = smem;
  char* Ck = smem + 8192;
  char* Cv = smem + 16384;
  float* Am = (float*)(smem + 24576);
  char* ATT = smem + 40960;
  char* Wt = smem + 49152;
  float* gc = (float*)(smem + 57344);
  float* bet = gc + 64;
  float* eg = gc + 128;
  float* ekd = gc + 192;
  const u16* QKV = (const u16*)(ws + OFF_QKV);
  const size_t tok0 = (size_t)b * SEQ + n * 64;
  {
    const int ch = tid & 63, tg = tid >> 6;
#pragma unroll
    for (int part = 0; part < 3; ++part) {
      const int col = part * 512 + hd * 64 + ch;
      const float w0 = p.conv_w[col], w1 = p.conv_w[1536 + col], w2 = p.conv_w[3072 + col], w3 = p.conv_w[4608 + col];
      const int s0 = n * 64 + tg * 16;
      const u16* src = QKV + ((size_t)b * SEQ) * 1536 + col;
      float x0 = (s0 - 3 >= 0) ? bf2f(src[(size_t)(s0 - 3) * 1536]) : 0.f;
      float x1 = (s0 - 2 >= 0) ? bf2f(src[(size_t)(s0 - 2) * 1536]) : 0.f;
      float x2 = (s0 - 1 >= 0) ? bf2f(src[(size_t)(s0 - 1) * 1536]) : 0.f;
      char* C = smem + part * 8192;
#pragma unroll 4
      for (int i = 0; i < 16; ++i) {
        float x3 = bf2f(src[(size_t)(s0 + i) * 1536]);
        float y = w0 * x0 + w1 * x1 + w2 * x2 + w3 * x3;
        y = y / (1.f + __expf(-y));
        int tok = tg * 16 + i;
        *(u16*)(C + swz(tok, ch >> 3) + (ch & 7) * 2) = f2bf(y);
        x0 = x1; x1 = x2; x2 = x3;
      }
    }
  }
  if (w == 0) {
    const float* SM = (const float*)(ws + OFF_SM);
    float bi = SM[(tok0 + lane) * 40 + hd], ai = SM[(tok0 + lane) * 40 + 8 + hd];
    float xs = ai + p.dt_bias[hd];
    float sp = (xs > 20.f) ? xs : log1pf(__expf(xs));
    float gv = -__expf(p.a_log[hd]) * sp;
#pragma unroll
    for (int o = 1; o < 64; o <<= 1) { float t = __shfl_up(gv, o); if (lane >= o) gv += t; }
    float glast = __shfl(gv, 63);
    gc[lane] = gv; bet[lane] = sigmoidf_(bi); eg[lane] = __expf(gv); ekd[lane] = __expf(glast - gv);
    if (lane == 63) ((float*)(ws + OFF_MISC + MISC_GL))[item] = __expf(gv);
  }
  __syncthreads();
  if (tid < 128) {
    char* C = (tid < 64) ? Cq : Ck;
    const int row = tid & 63;
    u32x4 v[8];
    float ss = 0.f;
#pragma unroll
    for (int c = 0; c < 8; ++c) {
      v[c] = *(const u32x4*)(C + swz(row, c));
#pragma unroll
      for (int e = 0; e < 4; ++e) { float a = bflo(v[c][e]), bb = bfhi(v[c][e]); ss += a * a + bb * bb; }
    }
    float rs = rsqrtf(ss + 1e-6f) * ((tid < 64) ? 0.125f : 1.f);
#pragma unroll
    for (int c = 0; c < 8; ++c) {
      u32x4 o;
#pragma unroll
      for (int e = 0; e < 4; ++e) o[e] = pack2(bflo(v[c][e]) * rs, bfhi(v[c][e]) * rs);
      *(u32x4*)(C + swz(row, c)) = o;
    }
  }
  __syncthreads();
  {
    const int qa = w >> 1, qb = w & 1, r = lane & 31, h = lane >> 5;
    f32x16 akk, aqk;
#pragma unroll
    for (int k = 0; k < 16; ++k) { akk[k] = 0.f; aqk[k] = 0.f; }
    if (!(qa == 0 && qb == 1)) {
#pragma unroll
      for (int s = 0; s < 4; ++s) {
        bf16x8 ak = lds_frag(Ck, 32 * qa + r, 2 * s + h);
        bf16x8 aq = lds_frag(Cq, 32 * qa + r, 2 * s + h);
        bf16x8 bk = lds_frag(Ck, 32 * qb + r, 2 * s + h);
        akk = mfma32(ak, bk, akk);
        aqk = mfma32(aq, bk, aqk);
      }
    }
    const int j = 32 * qb + r;
    const float gj = gc[j];
#pragma unroll
    for (int k = 0; k < 16; ++k) {
      const int i = 32 * qa + (k & 3) + 8 * (k >> 2) + 4 * h;
      float dec = __expf(fminf(gc[i] - gj, 0.f));
      Am[i * 64 + j] = (j < i) ? akk[k] * bet[i] * dec : 0.f;
      *(u16*)(ATT + swz(i, j >> 3) + (j & 7) * 2) = f2bf((j <= i) ? aqk[k] * dec : 0.f);
    }
  }
  __syncthreads();
  u16* AMg = (u16*)p.out + (size_t)item * 16384;
  if (tid < 128) {
    const int c = tid;
    float x[64];
#pragma unroll
    for (int i = 0; i < 64; ++i) {
      const int dcol = c & 63;
      float rhs = bf2f(*(const u16*)(((c < 64) ? Cv : Ck) + swz(i, dcol >> 3) + (dcol & 7) * 2)) * bet[i] * ((c < 64) ? 1.f : eg[i]);
      float s0 = rhs, s1 = 0.f;
#pragma unroll
      for (int j4 = 0; j4 < (i + 3) / 4; ++j4) {
        f32x4 a = *(const f32x4*)(Am + i * 64 + j4 * 4);
#pragma unroll
        for (int e = 0; e < 4; ++e) {
          const int j = j4 * 4 + e;
          if (j < i) { if (e & 1) s1 -= a[e] * x[j]; else s0 -= a[e] * x[j]; }
        }
      }
      x[i] = s0 + s1;
      asm volatile("" : "+v"(x[i]) : : "memory");
    }
    if (c < 64) {
      float* U = (float*)(ws + OFF_RH) + ((size_t)item * 64 + c) * 64;
#pragma unroll
      for (int i = 0; i < 16; ++i) { f32x4 o = {x[4 * i], x[4 * i + 1], x[4 * i + 2], x[4 * i + 3]}; *(f32x4*)(U + 4 * i) = o; }
    } else {
      const int d = c - 64;
#pragma unroll
      for (int i = 0; i < 64; ++i) *(u16*)(Wt + swz(i, d >> 3) + (d & 7) * 2) = f2bf(x[i]);
    }
  } else {
    const int t2 = tid - 128;
#pragma unroll
    for (int i = 0; i < 4; ++i) {
      gdn_store_frag(AMg + 4096, Cq, t2 + 128 * i, 1.f, eg);
      gdn_store_frag(AMg + 8192, ATT, t2 + 128 * i, 0.f, nullptr);
    }
#pragma unroll
    for (int i = 0; i < 4; ++i) {
      const int idx = t2 + 128 * i, blk = idx >> 6, ln = idx & 63, rt = blk >> 1, ks = blk & 1, r = ln & 15, q = ln >> 4;
      const int d = 16 * rt + r;
      float vv[8];
#pragma unroll
      for (int j = 0; j < 8; ++j) {
        const int tk = 32 * ks + ((j < 4) ? (4 * q + j) : (16 + 4 * q + (j - 4)));
        vv[j] = bf2f(*(const u16*)(Ck + swz(tk, d >> 3) + (d & 7) * 2)) * ekd[tk];
      }
      *(bf16x8*)(AMg + 12288 + (size_t)idx * 8) = pack8(vv[0], vv[1], vv[2], vv[3], vv[4], vv[5], vv[6], vv[7]);
    }
  }
  __syncthreads();
#pragma unroll
  for (int i = 0; i < 2; ++i) gdn_store_frag(AMg, Wt, tid + 256 * i, 0.f, nullptr);
  __syncthreads();
}

DI void phase2(const Params& p, int bid, int nblk, char* smem) {
  const int total = 64 + 2048 + 4096;
  for (int it = bid; it < total; it += nblk) {
    if (it < 64) cmp_gemm_item(p, it, smem);
    else if (it < 2112) vtrans_item(p, it - 64, smem);
    else gdn_chunk_item(p, it - 2112, smem);
  }
}

DI void gdn_scan_item(const Params& p, int bh, char* smem) {
  char* ws = p.ws;
  const int tid = tidx(), lane = tid & 63, w = tid >> 6, col = lane & 15, q = lane >> 4;
  const int b = bh >> 3, hd = bh & 7;
  const u16* AMg = (const u16*)p.out + (size_t)bh * 64 * 16384;
  const float* U = (const float*)(ws + OFF_RH) + (size_t)bh * 64 * 4096;
  const float* GL = (const float*)(ws + OFF_MISC + MISC_GL) + bh * 64;
  float* O = (float*)(ws + OFF_QKV);
  f32x4 S[4];
#pragma unroll
  for (int t = 0; t < 4; ++t) S[t] = f32x4{0.f, 0.f, 0.f, 0.f};
  u32x4 stg[8];
#pragma unroll
  for (int i = 0; i < 8; ++i) stg[i] = *(const u32x4*)(AMg + (size_t)(i * 256 + tid) * 8);
  f32x4 u[4];
#pragma unroll
  for (int ct = 0; ct < 4; ++ct) u[ct] = *(const f32x4*)(U + (size_t)(16 * w + col) * 64 + 16 * ct + 4 * q);
  float gl = GL[0];
  for (int n = 0; n < 64; ++n) {
    char* buf = smem + (n & 1) * 32768;
#pragma unroll
    for (int i = 0; i < 8; ++i) *(u32x4*)(buf + (i * 256 + tid) * 16) = stg[i];
    __syncthreads();
    f32x4 ucur[4];
#pragma unroll
    for (int ct = 0; ct < 4; ++ct) ucur[ct] = u[ct];
    const float glcur = gl;
    if (n + 1 < 64) {
      const u16* src = AMg + (size_t)(n + 1) * 16384;
#pragma unroll
      for (int i = 0; i < 8; ++i) stg[i] = *(const u32x4*)(src + (size_t)(i * 256 + tid) * 8);
      const float* un = U + (size_t)(n + 1) * 4096;
#pragma unroll
      for (int ct = 0; ct < 4; ++ct) u[ct] = *(const f32x4*)(un + (size_t)(16 * w + col) * 64 + 16 * ct + 4 * q);
      gl = GL[n + 1];
    }
    bf16x8 bS[2];
#pragma unroll
    for (int ks = 0; ks < 2; ++ks)
      bS[ks] = pack8(S[2 * ks][0], S[2 * ks][1], S[2 * ks][2], S[2 * ks][3], S[2 * ks + 1][0], S[2 * ks + 1][1], S[2 * ks + 1][2], S[2 * ks + 1][3]);
#define AFRAG(mat, rt, ks) (*(const bf16x8*)(buf + (mat) * 8192 + (((rt) * 2 + (ks)) * 64 + lane) * 16))
    f32x4 vn[4], o[4];
#pragma unroll
    for (int ct = 0; ct < 4; ++ct) {
      f32x4 a = f32x4{0.f, 0.f, 0.f, 0.f};
      a = mfma16(AFRAG(0, ct, 0), bS[0], a);
      a = mfma16(AFRAG(0, ct, 1), bS[1], a);
      vn[ct] = ucur[ct] - a;
      f32x4 oo = f32x4{0.f, 0.f, 0.f, 0.f};
      oo = mfma16(AFRAG(1, ct, 0), bS[0], oo);
      oo = mfma16(AFRAG(1, ct, 1), bS[1], oo);
      o[ct] = oo;
    }
    bf16x8 bV[2];
#pragma unroll
    for (int ks = 0; ks < 2; ++ks)
      bV[ks] = pack8(vn[2 * ks][0], vn[2 * ks][1], vn[2 * ks][2], vn[2 * ks][3], vn[2 * ks + 1][0], vn[2 * ks + 1][1], vn[2 * ks + 1][2], vn[2 * ks + 1][3]);
#pragma unroll
    for (int ct = 0; ct < 4; ++ct) {
      o[ct] = mfma16(AFRAG(2, ct, 0), bV[0], o[ct]);
      o[ct] = mfma16(AFRAG(2, ct, 1), bV[1], o[ct]);
      f32x4 sn = S[ct] * glcur;
      sn = mfma16(AFRAG(3, ct, 0), bV[0], sn);
      sn = mfma16(AFRAG(3, ct, 1), bV[1], sn);
      S[ct] = sn;
    }
#undef AFRAG
    float* od = O + ((size_t)b * SEQ + n * 64) * 512 + hd * 64 + 16 * w + col;
#pragma unroll
    for (int ct = 0; ct < 4; ++ct)
#pragma unroll
      for (int rg = 0; rg < 4; ++rg) od[(size_t)(16 * ct + 4 * q + rg) * 512] = o[ct][rg];
  }
  __syncthreads();
}

DI void phase_gdn_post(const Params& p, int bid, int nblk) {
  char* ws = p.ws;
  const float* O = (const float*)(ws + OFF_QKV);
  const u16* Z = (const u16*)(ws + OFF_Z);
  u16* OA = (u16*)(ws + OFF_NQ);
  const int sub = tidx() & 15;
  const f32x4 gw = ((const f32x4*)p.gdn_norm)[sub];
  const size_t ngrp = (size_t)NTOK * 8;
  for (size_t gi = ((size_t)bid * NTHREADS + tidx()) >> 4; gi < ngrp; gi += ((size_t)nblk * NTHREADS) >> 4) {
    f32x4 v = *(const f32x4*)(O + gi * 64 + sub * 4);
    float ss = v[0] * v[0] + v[1] * v[1] + v[2] * v[2] + v[3] * v[3];
    ss += __shfl_xor(ss, 1); ss += __shfl_xor(ss, 2); ss += __shfl_xor(ss, 4); ss += __shfl_xor(ss, 8);
    float rs = rsqrtf(ss * (1.f / 64.f) + 1e-6f);
    u32x2 zz = *(const u32x2*)(Z + gi * 64 + sub * 4);
    float z0 = bflo(zz[0]), z1 = bfhi(zz[0]), z2 = bflo(zz[1]), z3 = bfhi(zz[1]);
    u32x2 o;
    o[0] = pack2(v[0] * rs * gw[0] * (z0 * sigmoidf_(z0)), v[1] * rs * gw[1] * (z1 * sigmoidf_(z1)));
    o[1] = pack2(v[2] * rs * gw[2] * (z2 * sigmoidf_(z2)), v[3] * rs * gw[3] * (z3 * sigmoidf_(z3)));
    *(u32x2*)(OA + gi * 64 + sub * 4) = o;
  }
}

constexpr int NSA_LDS_K = 0, NSA_LDS_V = 9216, NSA_LDS_BIAS = 18432, NSA_LDS_IMP = 18432 + 8 * 132 * 4;
constexpr int NSA_LDS_Q = NSA_LDS_IMP + 4 * 8 * 68 * 4;
constexpr float NEGBIG = -1e30f;
constexpr float QK_SCALE = 0.125f * L2E;

template <int MODE>
DI void nsa_tile(const char* Kt, const char* Vt, const char* Qw, f32x16 (&O)[2], float& m, float& l,
                 const int t, const int key0, const bool slow, const bool lane_sel, const float* tab,
                 const float mfin, const float linv, float* impw) {
  const int lane = tidx() & 63, r = lane & 31, h = lane >> 5;
#pragma unroll
  for (int a = 0; a < 2; ++a) {
    f32x16 S;
#pragma unroll
    for (int k = 0; k < 16; ++k) S[k] = 0.f;
#pragma unroll
    for (int s = 0; s < 4; ++s) S = mfma32(pad_frag(Kt, 32 * a + r, 2 * s + h), *(const bf16x8*)(Qw + (s * 64 + lane) * 16), S);
    if (MODE < 2 || slow) {
#pragma unroll
      for (int k = 0; k < 16; ++k) {
        const int kl = 32 * a + (k & 3) + 8 * (k >> 2) + 4 * h;
        int dist;
        if (MODE < 2) dist = t - (16 * (key0 + kl) + 31); else dist = t - (key0 + kl);
        bool valid = (dist >= 0) && lane_sel;
        if (MODE == 3) valid = valid && (dist < 512);
        int di = dist < 0 ? 0 : (dist > 128 ? 128 : dist);
        float bias = tab[di];
        S[k] = valid ? fmaf(S[k], QK_SCALE, bias) : NEGBIG;
      }
    } else {
      const float c31 = tab[128];
#pragma unroll
      for (int k = 0; k < 16; ++k) S[k] = lane_sel ? fmaf(S[k], QK_SCALE, c31) : NEGBIG;
    }
    if (MODE == 1) {
#pragma unroll
      for (int k = 0; k < 16; ++k) S[k] = (S[k] > -1e29f) ? exp2f(S[k] - mfin) * linv : 0.f;
    } else {
      float mx = S[0];
#pragma unroll
      for (int k = 1; k < 16; ++k) mx = fmaxf(mx, S[k]);
      mx = fmaxf(mx, __shfl_xor(mx, 32));
      const float mn = fmaxf(m, mx);
      const float alpha = exp2f(m - mn);
      float ps = 0.f;
#pragma unroll
      for (int k = 0; k < 16; ++k) { S[k] = (S[k] > -1e29f) ? exp2f(S[k] - mn) : 0.f; ps += S[k]; }
      l = l * alpha + ps;
      m = mn;
      if (MODE != 0) {
#pragma unroll
        for (int dt = 0; dt < 2; ++dt)
#pragma unroll
          for (int k = 0; k < 16; ++k) O[dt][k] *= alpha;
      }
    }
    if (MODE == 1) {
#pragma unroll
      for (int g4 = 0; g4 < 4; ++g4) {
        float mainv = S[4 * g4] + S[4 * g4 + 1] + S[4 * g4 + 2] + 0.5f * S[4 * g4 + 3];
        float spill = 0.5f * S[4 * g4 + 3];
        mainv += __shfl_xor(mainv, 8); mainv += __shfl_xor(mainv, 16);
        spill += __shfl_xor(spill, 8); spill += __shfl_xor(spill, 16);
        const int blk = ((key0 + 32 * a) >> 2) + 2 * g4 + h;
        if (r < 8) { atomicAdd(&impw[r * 68 + blk], mainv); atomicAdd(&impw[r * 68 + blk + 1], spill); }
      }
    }
    if (MODE != 0) {
      bf16x8 P0 = pack8(S[0], S[1], S[2], S[3], S[4], S[5], S[6], S[7]);
      bf16x8 P1 = pack8(S[8], S[9], S[10], S[11], S[12], S[13], S[14], S[15]);
#pragma unroll
      for (int dt = 0; dt < 2; ++dt) {
        O[dt] = mfma32(pad_frag(Vt, 32 * dt + r, 4 * a + h), P0, O[dt]);
        O[dt] = mfma32(pad_frag(Vt, 32 * dt + r, 4 * a + 2 + h), P1, O[dt]);
      }
    }
  }
}

struct NsaSrc { const u16* k; long kld; const u16* v; long vld; };

DI void nsa_item(const Params& p, const int bg, const int hq, char* smem) {
  char* ws = p.ws;
  const int tid = tidx(), lane = tid & 63, w = tid >> 6, r = lane & 31, h = lane >> 5;
  const int b = bg >> 1, g = bg & 1, qi = hq >> 1;
  const int t = 32 * hq + 8 * w + (r & 7);
  const int head = g * 4 + (r >> 3);
  const size_t trow = (size_t)b * SEQ + t;
  char* Kt = smem + NSA_LDS_K;
  char* Vt = smem + NSA_LDS_V;
  float* biasl = (float*)(smem + NSA_LDS_BIAS);
  float* impw = (float*)(smem + NSA_LDS_IMP) + w * (8 * 68);
  char* Q = smem + NSA_LDS_Q + w * 4096;
  const u16* NKV = (const u16*)(ws + OFF_NKV);
  __syncthreads();
  for (int i = tid; i < 8 * 132; i += NTHREADS) biasl[i] = ((const float*)(ws + OFF_MISC + MISC_BIAS))[i];
  for (int i = lane; i < 8 * 68; i += 64) impw[i] = 0.f;
  {
    const u16* NQ = (const u16*)(ws + OFF_NQ);
#pragma unroll
    for (int s = 0; s < 4; ++s) *(bf16x8*)(Q + (s * 64 + lane) * 16) = *(const bf16x8*)(NQ + trow * 512 + head * 64 + 16 * s + 8 * h);
  }
  const float* tab = biasl + head * 132;
  __syncthreads();
  f32x16 O[2];
  float m, l, mfin = 0.f, linv = 0.f;
  u16* OB = (u16*)(ws + OFF_QKV + (size_t)NTOK * 512 * 4);
  auto reset = [&]() {
#pragma unroll
    for (int dt = 0; dt < 2; ++dt)
#pragma unroll
      for (int k = 0; k < 16; ++k) O[dt][k] = 0.f;
    m = NEGBIG; l = 0.f;
  };
  u32x4 sk[2], sv[2];
  auto stage_load = [&](const NsaSrc& s) {
#pragma unroll
    for (int i = 0; i < 2; ++i) {
      const int c = tid + 256 * i, row = c >> 3, ch = c & 7;
      sk[i] = *(const u32x4*)(s.k + (size_t)row * s.kld + ch * 8);
      sv[i] = *(const u32x4*)(s.v + (size_t)row * s.vld + ch * 8);
    }
  };
  auto stage_store = [&]() {
#pragma unroll
    for (int i = 0; i < 2; ++i) {
      const int c = tid + 256 * i, row = c >> 3, ch = c & 7;
      *(u32x4*)(Kt + row * 144 + ch * 16) = sk[i];
      *(u32x4*)(Vt + row * 144 + ch * 16) = sv[i];
    }
  };
  auto src_cmp = [&](int tt) { NsaSrc s; s.k = (const u16*)(ws + OFF_KC) + ((size_t)bg * 256 + 64 * tt) * 64; s.kld = 64;
                               s.v = (const u16*)(ws + OFF_VCT) + (size_t)bg * 64 * 256 + 64 * tt; s.vld = 256; return s; };
  auto src_slc = [&](int j) { NsaSrc s; s.k = NKV + ((size_t)b * SEQ + 64 * j) * 768 + 256 + g * 64; s.kld = 768;
                              s.v = (const u16*)(ws + OFF_VST) + (size_t)bg * 64 * 4096 + 64 * j; s.vld = 4096; return s; };
  auto src_win = [&](int j) { NsaSrc s; s.k = NKV + ((size_t)b * SEQ + 64 * j) * 768 + 512 + g * 64; s.kld = 768;
                              s.v = (const u16*)(ws + OFF_VWT) + (size_t)bg * 64 * 4096 + 64 * j; s.vld = 4096; return s; };
  auto gatev = [&](int br) { return sigmoidf_(((const float*)(ws + OFF_SM))[trow * 40 + 16 + head * 3 + br]); };
  auto emit = [&](const float wgt, bool first) {
#pragma unroll
    for (int dt = 0; dt < 2; ++dt)
#pragma unroll
      for (int g4 = 0; g4 < 4; ++g4) {
        u16* dst = OB + trow * 512 + head * 64 + 32 * dt + 8 * g4 + 4 * h;
        float v0 = O[dt][4 * g4] * wgt, v1 = O[dt][4 * g4 + 1] * wgt, v2 = O[dt][4 * g4 + 2] * wgt, v3 = O[dt][4 * g4 + 3] * wgt;
        if (!first) {
          u32x2 old = *(const u32x2*)dst;
          v0 += bflo(old[0]); v1 += bfhi(old[0]); v2 += bflo(old[1]); v3 += bfhi(old[1]);
        }
        u32x2 o; o[0] = pack2(v0, v1); o[1] = pack2(v2, v3);
        *(u32x2*)dst = o;
      }
  };

  const int ntc = (2 * hq + 1 + 63) >> 6;
  reset();
  stage_load(src_cmp(0));
  for (int tt = 0; tt < ntc; ++tt) {
    __syncthreads(); stage_store(); __syncthreads();
    if (tt + 1 < ntc) stage_load(src_cmp(tt + 1)); else stage_load(src_cmp(0));
    nsa_tile<0>(Kt, Vt, Q, O, m, l, t, 64 * tt, true, true, tab, mfin, linv, impw);
  }
  { float lt = l + __shfl_xor(l, 32); mfin = m; linv = lt > 0.f ? 1.f / lt : 0.f; }
  for (int tt = 0; tt < ntc; ++tt) {
    __syncthreads(); stage_store(); __syncthreads();
    if (tt + 1 < ntc) stage_load(src_cmp(tt + 1)); else stage_load(src_slc(0));
    nsa_tile<1>(Kt, Vt, Q, O, m, l, t, 64 * tt, true, true, tab, mfin, linv, impw);
  }
  emit(gatev(0), true);
  unsigned sel_lo, sel_hi;
  if (qi < 16) {
    unsigned long long mk = (2ull << qi) - 1ull;
    sel_lo = (unsigned)mk; sel_hi = (unsigned)(mk >> 32);
  } else {
    unsigned long long mk = 0ull;
    const float* row = impw + (lane & 7) * 68;
    const int part = lane >> 3, hiM = qi - 2;
    for (int mm = 1 + part; mm <= hiM; mm += 8) {
      const float v = row[mm];
      int rank = 0;
      for (int m2 = 1; m2 <= hiM; ++m2) { const float u = row[m2]; rank += ((u > v) || (u == v && m2 < mm)) ? 1 : 0; }
      if (rank < 13) mk |= 1ull << mm;
    }
    mk |= 1ull | (1ull << qi) | (1ull << (qi - 1));
    sel_lo = (unsigned)mk; sel_hi = (unsigned)(mk >> 32);
    sel_lo |= __shfl_xor(sel_lo, 8); sel_hi |= __shfl_xor(sel_hi, 8);
    sel_lo |= __shfl_xor(sel_lo, 16); sel_hi |= __shfl_xor(sel_hi, 16);
    sel_lo |= __shfl_xor(sel_lo, 32); sel_hi |= __shfl_xor(sel_hi, 32);
  }
  reset();
  for (int j = 0; j <= qi; ++j) {
    __syncthreads(); stage_store(); __syncthreads();
    if (j + 1 <= qi) stage_load(src_slc(j + 1)); else stage_load(src_win(qi >= 8 ? qi - 8 : 0));
    const bool lsel = ((j < 32 ? (sel_lo >> j) : (sel_hi >> (j - 32))) & 1u) != 0u;
    nsa_tile<2>(Kt, Vt, Q, O, m, l, t, 64 * j, (qi - j) <= 2, lsel, tab, mfin, linv, impw);
  }
  { float lt = l + __shfl_xor(l, 32); emit(lt > 0.f ? gatev(1) / lt : 0.f, false); }
  reset();
  const int j0 = qi >= 8 ? qi - 8 : 0;
  for (int j = j0; j <= qi; ++j) {
    __syncthreads(); stage_store(); __syncthreads();
    if (j + 1 <= qi) stage_load(src_win(j + 1));
    nsa_tile<3>(Kt, Vt, Q, O, m, l, t, 64 * j, ((qi - j) <= 2) || ((qi - j) == 8), true, tab, mfin, linv, impw);
  }
  { float lt = l + __shfl_xor(l, 32); emit(lt > 0.f ? gatev(2) / lt : 0.f, false); }
}

DI void phase4(const Params& p, char* smem, int cidx = 0) {
  unsigned* cnt = (unsigned*)(p.ws + OFF_MISC + MISC_CNT) + cidx;
  __shared__ int s_item;
  for (;;) {
    __syncthreads();
    if (tidx() == 0) s_item = (int)atomicAdd(cnt, 1u);
    __syncthreads();
    const int it = __builtin_amdgcn_readfirstlane(s_item);
    if (it >= 64 + 2048) break;
    if (it < 64) gdn_scan_item(p, it, smem);
    else { const int k = it - 64; nsa_item(p, k & 15, 127 - (k >> 4), smem); }
  }
}

DI void phase_branch(const Params& p, int bid, int nblk, char* smem) {
  char* ws = p.ws;
  const u16* OA = (const u16*)(ws + OFF_NQ);
  const u16* OB = (const u16*)(ws + OFF_QKV + (size_t)NTOK * 512 * 4);
  const u16* MG = (const u16*)(ws + OFF_MG);
  u16* MIX = (u16*)(ws + OFF_RH);
  for (int k = 0;; ++k) {
    int mt, nt;
    if (!xcd_tile(k, bid, nblk, 256, 8, mt, nt)) break;
    const int m0 = mt * 128, n0 = nt * 128;
    GemmPtrs g;
    f32x16 acc[2][2];
    gemm_setup(g, OA, 512, m0, (const u16*)(ws + OFF_WAT), 512, n0);
    zero_acc(acc);
    gemm_kloop(acc, g, 8, smem);
    gemm_epilogue_lds(acc, smem, [&](int ml, int nl, const float (&v)[8]) {
      const size_t m = m0 + ml; const int n = n0 + nl;
      const u32x4 gt = *(const u32x4*)(MG + m * 2048 + n);
      float t[8];
#pragma unroll
      for (int e = 0; e < 4; ++e) { t[2 * e] = v[2 * e] * sigmoidf_(bflo(gt[e])); t[2 * e + 1] = v[2 * e + 1] * sigmoidf_(bfhi(gt[e])); }
      *(u32x4*)(MIX + m * 1024 + n) = pack8u(t);
    });
    gemm_setup(g, OB, 512, m0, (const u16*)(ws + OFF_WBT), 512, n0);
    zero_acc(acc);
    gemm_kloop(acc, g, 8, smem);
    gemm_epilogue_lds(acc, smem, [&](int ml, int nl, const float (&v)[8]) {
      const size_t m = m0 + ml; const int n = n0 + nl;
      const u32x4 gt = *(const u32x4*)(MG + m * 2048 + 1024 + n);
      const u32x4 old = *(const u32x4*)(MIX + m * 1024 + n);
      float t[8];
#pragma unroll
      for (int e = 0; e < 4; ++e) {
        t[2 * e] = bflo(old[e]) + v[2 * e] * sigmoidf_(bflo(gt[e]));
        t[2 * e + 1] = bfhi(old[e]) + v[2 * e + 1] * sigmoidf_(bfhi(gt[e]));
      }
      *(u32x4*)(MIX + m * 1024 + n) = pack8u(t);
    });
  }
}

DI void phase_outproj(const Params& p, int bid, int nblk, char* smem) {
  char* ws = p.ws;
  const u16* MIX = (const u16*)(ws + OFF_RH);
  for (int k = 0;; ++k) {
    int mt, nt;
    if (!xcd_tile(k, bid, nblk, 256, 8, mt, nt)) break;
    const int m0 = mt * 128, n0 = nt * 128;
    GemmPtrs g;
    f32x16 acc[2][2];
    gemm_setup(g, MIX, 1024, m0, (const u16*)(ws + OFF_WOT), 1024, n0);
    zero_acc(acc);
    gemm_kloop(acc, g, 16, smem);
    gemm_epilogue_lds(acc, smem, [&](int ml, int nl, const float (&v)[8]) {
      const size_t idx = (size_t)(m0 + ml) * 1024 + n0 + nl;
      const f32x4 x0 = *(const f32x4*)(p.x + idx), x1 = *(const f32x4*)(p.x + idx + 4);
      float* X1 = (float*)(ws + OFF_QKV);
      *(f32x4*)(X1 + idx) = f32x4{x0[0] + v[0], x0[1] + v[1], x0[2] + v[2], x0[3] + v[3]};
      *(f32x4*)(X1 + idx + 4) = f32x4{x1[0] + v[4], x1[1] + v[5], x1[2] + v[6], x1[3] + v[7]};
    });
  }
}

DI void phase_query(const Params& p, int bid, int nblk, char* smem) {
  char* ws = p.ws;
  const u16* H2 = (const u16*)(ws + OFF_RH);
  u16* QRY = (u16*)(ws + OFF_MG);
  for (int k = 0;; ++k) {
    int mt, nt;
    if (!xcd_tile(k, bid, nblk, 256, 16, mt, nt)) break;
    const int m0 = mt * 128, n0 = nt * 128;
    GemmPtrs g;
    f32x16 acc[2][2];
    gemm_setup(g, H2, 1024, m0, (const u16*)(ws + OFF_WQT), 1024, n0);
    zero_acc(acc);
    gemm_kloop(acc, g, 16, smem);
    gemm_epilogue_lds(acc, smem, [&](int ml, int nl, const float (&v)[8]) { *(u32x4*)(QRY + (size_t)(m0 + ml) * 2048 + n0 + nl) = pack8u(v); });
  }
}

DI unsigned f2ord(float f) { unsigned u = __float_as_uint(f); return (u & 0x80000000u) ? ~u : (u | 0x80000000u); }
DI float ord2f(unsigned o) { unsigned u = (o & 0x80000000u) ? (o & 0x7fffffffu) : ~o; return __uint_as_float(u); }

DI void peer_route_job(const Params& p, int job, char* smem) {
  char* ws = p.ws;
  const int mt = job >> 3, hd = job & 7, m0 = mt * 128;
  const u16* QRY = (const u16*)(ws + OFF_MG);
  const u16* SK = (const u16*)(ws + OFF_SK);
  unsigned* keys = (unsigned*)smem;
  unsigned char* idxs = (unsigned char*)(smem + 66048);
  const int tid = tidx() + opaque0();
  const int row = tid >> 1, half = tid & 1;
  float v1[16], v2[16];
#pragma unroll
  for (int pp = 0; pp < 2; ++pp) {
    GemmPtrs g;
    f32x16 acc[2][2];
    gemm_setup(g, QRY + (hd * 2 + pp) * 128, 2048, m0, SK + (size_t)(hd * 2 + pp) * 128 * 128, 128, 0);
    zero_acc(acc);
    gemm_kloop(acc, g, 2, smem);
    gemm_epilogue(acc, [&](int ml, int nl, float v) { keys[ml * 129 + nl] = (f2ord(v) & ~127u) | (unsigned)(127 - nl); });
    __syncthreads();
    {
      const unsigned* rp = keys + row * 129 + half * 64;
      unsigned prev = 0xffffffffu;
#pragma unroll
      for (int rd = 0; rd < 16; ++rd) {
        unsigned best = 0u;
#pragma unroll 4
        for (int j = 0; j < 64; ++j) { unsigned k = rp[j]; k = (k < prev) ? k : 0u; best = (k > best) ? k : best; }
        const unsigned other = (unsigned)__shfl_xor((int)best, 1);
        best = best > other ? best : other;
        prev = best;
        const float val = ord2f(best & ~127u);
        if (pp == 0) v1[rd] = val; else v2[rd] = val;
        if (half == 0) idxs[row * 32 + pp * 16 + rd] = (unsigned char)(127u - (best & 127u));
      }
    }
    __syncthreads();
  }
  unsigned ck[25];
  {
    constexpr int CI[50] = {0,0,0,0,0,0,0,0,0,0,0,0,0,0,0,0, 1,1,1,1,1,1,1,1, 2,2,2,2,2, 3,3,3,3, 4,4,4, 5,5, 6,6, 7,7, 8, 9, 10, 11, 12, 13, 14, 15};
    constexpr int CJ[50] = {0,1,2,3,4,5,6,7,8,9,10,11,12,13,14,15, 0,1,2,3,4,5,6,7, 0,1,2,3,4, 0,1,2,3, 0,1,2, 0,1, 0,1, 0,1, 0, 0, 0, 0, 0, 0, 0, 0};
#pragma unroll
    for (int c = 0; c < 25; ++c) {
      const float a = half ? v1[CI[2 * c + 1]] : v1[CI[2 * c]];
      const float b = half ? v2[CJ[2 * c + 1]] : v2[CJ[2 * c]];
      const int fl = half ? (16 * CI[2 * c + 1] + CJ[2 * c + 1]) : (16 * CI[2 * c] + CJ[2 * c]);
      ck[c] = (f2ord(a + b) & ~255u) | (unsigned)(255 - fl);
    }
  }
  int* EI = (int*)(ws + OFF_NQ) + ((size_t)(m0 + row) * 128 + hd * 16);
  float* GT = (float*)(ws + OFF_NKV) + ((size_t)(m0 + row) * 128 + hd * 16);
  float selv[16];
  unsigned prev = 0xffffffffu;
#pragma unroll
  for (int rd = 0; rd < 16; ++rd) {
    unsigned best = 0u;
#pragma unroll
    for (int c = 0; c < 25; ++c) { unsigned k = (ck[c] < prev) ? ck[c] : 0u; best = (k > best) ? k : best; }
    const unsigned other = (unsigned)__shfl_xor((int)best, 1);
    best = best > other ? best : other;
    prev = best;
    const int flat = 255 - (int)(best & 255u);
    selv[rd] = ord2f(best & ~255u);
    if (half == 0) EI[rd] = (int)idxs[row * 32 + (flat >> 4)] * 128 + (int)idxs[row * 32 + 16 + (flat & 15)];
  }
  float sum = 0.f;
  const float mx = selv[0];
#pragma unroll
  for (int k = 0; k < 16; ++k) { selv[k] = __expf(selv[k] - mx); sum += selv[k]; }
  const float inv = 1.f / sum;
  if (half == 0) {
#pragma unroll
    for (int k = 0; k < 16; ++k) GT[k] = selv[k] * inv;
  }
}

DI float gelu_tanh(float x) {
  const float u = 0.7978845608028654f * (x + 0.044715f * x * x * x);
  const float e = __expf(2.f * u);
  const float th = 1.f - 2.f / (e + 1.f);
  return 0.5f * x * (1.f + th);
}
DI void peer_expert_phase(const Params& p, int bid, int nblk) {
  char* ws = p.ws;
  const int lane = tidx() & 63, wv = tidx() >> 6;
  const unsigned char* EU = (const unsigned char*)(ws + OFF_EU);
  const unsigned char* EV = (const unsigned char*)(ws + OFF_EV);
  const float* SCU = (const float*)(ws + OFF_MISC + MISC_SCU);
  const float* SCV = (const float*)(ws + OFF_MISC + MISC_SCV);
  const int* EI = (const int*)(ws + OFF_NQ);
  const float* GT = (const float*)(ws + OFF_NKV);
  for (int tok = bid * 4 + wv; tok < NTOK; tok += nblk * 4) {
    const float* xr = (const float*)(ws + OFF_QKV) + (size_t)tok * 1024 + 16 * lane;
    f32x4 xa[4];
    float ss = 0.f;
#pragma unroll
    for (int i = 0; i < 4; ++i) { xa[i] = *(const f32x4*)(xr + 4 * i); ss += xa[i][0] * xa[i][0] + xa[i][1] * xa[i][1] + xa[i][2] * xa[i][2] + xa[i][3] * xa[i][3]; }
    ss = wave_sum(ss);
    const float rs = rsqrtf(ss * (1.f / 1024.f) + 1e-6f);
    f32x2 h2[8];
#pragma unroll
    for (int i = 0; i < 4; ++i) {
      const f32x4 w4 = *(const f32x4*)(p.norm_ffn + 16 * lane + 4 * i);
      h2[2 * i] = f32x2{bf2f(f2bf(xa[i][0] * rs * w4[0])), bf2f(f2bf(xa[i][1] * rs * w4[1]))};
      h2[2 * i + 1] = f32x2{bf2f(f2bf(xa[i][2] * rs * w4[2])), bf2f(f2bf(xa[i][3] * rs * w4[3]))};
    }
    f32x2 outv[8];
#pragma unroll
    for (int i = 0; i < 8; ++i) outv[i] = f32x2{0.f, 0.f};
#pragma unroll 1
    for (int bt = 0; bt < 2; ++bt) {
      const int eidx = EI[(size_t)tok * 128 + bt * 64 + lane];
      const float gt = GT[(size_t)tok * 128 + bt * 64 + lane];
      const float su = SCU[eidx], sv = SCV[eidx];
      float acc[64];
      {
        u32x4 cur[8], nxt[8];
#pragma unroll
        for (int j = 0; j < 8; ++j) cur[j] = *(const u32x4*)(EU + (size_t)__builtin_amdgcn_readlane(eidx, j) * 1024 + 16 * lane);
#pragma unroll
        for (int g = 0; g < 8; ++g) {
          if (g < 7) {
#pragma unroll
            for (int j = 0; j < 8; ++j) nxt[j] = *(const u32x4*)(EU + (size_t)__builtin_amdgcn_readlane(eidx, 8 * (g + 1) + j) * 1024 + 16 * lane);
          }
#pragma unroll
          for (int j = 0; j < 8; ++j) {
            f32x2 d = f32x2{0.f, 0.f};
#pragma unroll
            for (int i = 0; i < 4; ++i) {
              d += __builtin_amdgcn_cvt_pk_f32_fp8(cur[j][i], false) * h2[2 * i];
              d += __builtin_amdgcn_cvt_pk_f32_fp8(cur[j][i], true) * h2[2 * i + 1];
            }
            acc[8 * g + j] = d[0] + d[1];
          }
#pragma unroll
          for (int j = 0; j < 8; ++j) cur[j] = nxt[j];
        }
      }
#pragma unroll
      for (int st = 0; st < 6; ++st) {
        const int half = 32 >> st;
        const bool up = (lane & half) != 0;
#pragma unroll
        for (int k = 0; k < half; ++k) {
          const float send = up ? acc[k] : acc[k + half];
          const float keep = up ? acc[k + half] : acc[k];
          acc[k] = keep + __shfl_xor(send, half);
        }
      }
      const float wgt = gt * gelu_tanh(acc[0] * su) * sv;
      {
        u32x4 cur[8], nxt[8];
#pragma unroll
        for (int j = 0; j < 8; ++j) cur[j] = *(const u32x4*)(EV + (size_t)__builtin_amdgcn_readlane(eidx, j) * 1024 + 16 * lane);
#pragma unroll
        for (int g = 0; g < 8; ++g) {
          if (g < 7) {
#pragma unroll
            for (int j = 0; j < 8; ++j) nxt[j] = *(const u32x4*)(EV + (size_t)__builtin_amdgcn_readlane(eidx, 8 * (g + 1) + j) * 1024 + 16 * lane);
          }
#pragma unroll
          for (int j = 0; j < 8; ++j) {
            const float we = __uint_as_float((unsigned)__builtin_amdgcn_readlane((int)__float_as_uint(wgt), 8 * g + j));
            const f32x2 w2 = f32x2{we, we};
#pragma unroll
            for (int i = 0; i < 4; ++i) {
              outv[2 * i] += __builtin_amdgcn_cvt_pk_f32_fp8(cur[j][i], false) * w2;
              outv[2 * i + 1] += __builtin_amdgcn_cvt_pk_f32_fp8(cur[j][i], true) * w2;
            }
          }
#pragma unroll
          for (int j = 0; j < 8; ++j) cur[j] = nxt[j];
        }
      }
    }
    float s2 = 0.f;
#pragma unroll
    for (int i = 0; i < 4; ++i) {
      xa[i][0] += outv[2 * i][0]; xa[i][1] += outv[2 * i][1]; xa[i][2] += outv[2 * i + 1][0]; xa[i][3] += outv[2 * i + 1][1];
      s2 += xa[i][0] * xa[i][0] + xa[i][1] * xa[i][1] + xa[i][2] * xa[i][2] + xa[i][3] * xa[i][3];
    }
    s2 = wave_sum(s2);
    const float r2 = rsqrtf(s2 * (1.f / 1024.f) + 1e-6f);
    float* orow = p.out + (size_t)tok * 1024 + 16 * lane;
#pragma unroll
    for (int i = 0; i < 4; ++i) {
      const f32x4 nw = *(const f32x4*)(p.norm_final + 16 * lane + 4 * i);
      *(f32x4*)(orow + 4 * i) = f32x4{xa[i][0] * r2 * nw[0], xa[i][1] * r2 * nw[1], xa[i][2] * r2 * nw[2], xa[i][3] * r2 * nw[3]};
    }
  }
}

#ifndef MK_SINGLE
#define MK_SINGLE 1
#endif
#define SMEM_DECL __shared__ __attribute__((aligned(16))) char smem[SMEM_BYTES]

DI void run_phase(const Params& p, int ph, int bid, int nblk, char* smem) {
  switch (ph) {
    case 0: phase0(p, bid, nblk, smem); break;
    case 1: phase_inproj(p, bid, nblk, smem); break;
    case 2: phase2(p, bid, nblk, smem); break;
    case 3: phase4(p, smem); break;
    case 4: phase_gdn_post(p, bid, nblk); break;
    case 5: phase_branch(p, bid, nblk, smem); break;
    case 6: phase_outproj(p, bid, nblk, smem); break;
    case 7: rmsnorm_rows_bf16((const float*)(p.ws + OFF_QKV), p.norm_ffn, (u16*)(p.ws + OFF_RH), NTOK, bid, nblk); break;
    case 8: phase_query(p, bid, nblk, smem); break;
    case 9: for (int j = bid; j < 2048; j += nblk) peer_route_job(p, j, smem); break;
    case 10: peer_expert_phase(p, bid, nblk); break;
  }
}
constexpr int NPHASES = 11;

#if MK_SINGLE
DI void grid_barrier(unsigned* ctr, unsigned target) {
  asm volatile("s_waitcnt vmcnt(0)" ::: "memory");
  __syncthreads();
  if (tidx() == 0) {
    __builtin_amdgcn_fence(__ATOMIC_RELEASE, "agent");
    asm volatile("s_waitcnt vmcnt(0)" ::: "memory");
    __hip_atomic_fetch_add(ctr, 1u, __ATOMIC_RELAXED, __HIP_MEMORY_SCOPE_AGENT);
    while (__hip_atomic_load(ctr, __ATOMIC_RELAXED, __HIP_MEMORY_SCOPE_AGENT) < target) __builtin_amdgcn_s_sleep(2);
    __builtin_amdgcn_fence(__ATOMIC_ACQUIRE, "agent");
    asm volatile("s_waitcnt vmcnt(0)" ::: "memory");
  }
  __syncthreads();
}
#ifndef MK_PROBE_SPLIT
#define MK_PROBE_SPLIT 0
#endif
#if MK_PROBE_SPLIT
__global__ void __launch_bounds__(NTHREADS, 2) fwd_megakernel(Params p, int phase_sel) {
#else
__global__ void __launch_bounds__(NTHREADS, 2) fwd_megakernel(Params p) {
#endif
  SMEM_DECL;
  cg::grid_group grid = cg::this_grid();
  const int bid = blockIdx.x, nblk = gridDim.x;
  unsigned* bar = (unsigned*)(p.ws + OFF_MISC + MISC_CNT) + 8;
#if MK_PROBE_SPLIT
  switch (phase_sel) {
    case 0: run_phase(p, 0, bid, nblk, smem); break;
    case 1: run_phase(p, 1, bid, nblk, smem); break;
    case 2: run_phase(p, 2, bid, nblk, smem); break;
    case 3: run_phase(p, 3, bid, nblk, smem); break;
    case 4: run_phase(p, 4, bid, nblk, smem); break;
    case 5: run_phase(p, 5, bid, nblk, smem); break;
    case 6: run_phase(p, 6, bid, nblk, smem); break;
    case 7: run_phase(p, 7, bid, nblk, smem); break;
    case 8: run_phase(p, 8, bid, nblk, smem); break;
    case 9: run_phase(p, 9, bid, nblk, smem); break;
    default: run_phase(p, 10, bid, nblk, smem); break;
  }
  if (phase_sel < 0) { grid.sync(); grid_barrier(bar, 1u); }
#else
  run_phase(p, 0, bid, nblk, smem); grid.sync();
  run_phase(p, 1, bid, nblk, smem); grid_barrier(bar, 1u * nblk);
  run_phase(p, 2, bid, nblk, smem); grid_barrier(bar, 2u * nblk);
  run_phase(p, 3, bid, nblk, smem); grid_barrier(bar, 3u * nblk);
  run_phase(p, 4, bid, nblk, smem); grid_barrier(bar, 4u * nblk);
  run_phase(p, 5, bid, nblk, smem); grid_barrier(bar, 5u * nblk);
  run_phase(p, 6, bid, nblk, smem); grid_barrier(bar, 6u * nblk);
  run_phase(p, 7, bid, nblk, smem); grid_barrier(bar, 7u * nblk);
  run_phase(p, 8, bid, nblk, smem); grid_barrier(bar, 8u * nblk);
  run_phase(p, 9, bid, nblk, smem); grid_barrier(bar, 9u * nblk);
  run_phase(p, 10, bid, nblk, smem);
#endif
}
#else
template <int PH>
__global__ void __launch_bounds__(NTHREADS, 2) phase_kernel(Params p) {
  SMEM_DECL;
  run_phase(p, PH, blockIdx.x, gridDim.x, smem);
}
__global__ void __launch_bounds__(NTHREADS, 2) phase4_again(Params p) { SMEM_DECL; phase4(p, smem, 1); }
#ifndef REPEAT_MASK
#define REPEAT_MASK 0
#endif
#endif

extern "C" void kernel_launch(void* const* d_in, const int* in_sizes, int n_in, void* d_out, int out_size, void* d_ws, size_t ws_size,
                              hipStream_t stream) {
  Params p{};
  const float** f = (const float**)&p;
  for (int i = 0; i < 21; ++i) f[i] = (const float*)d_in[i];
  p.out = (float*)d_out;
  p.ws = (char*)d_ws;
  if (ws_size < WS_NEEDED) return;
#if MK_SINGLE
  static int grid_blocks = 0;
  if (!grid_blocks) {
    int dev = 0, cus = 0, per_cu = 0;
    hipGetDevice(&dev);
    hipDeviceGetAttribute(&cus, hipDeviceAttributeMultiprocessorCount, dev);
    hipOccupancyMaxActiveBlocksPerMultiprocessor(&per_cu, fwd_megakernel, NTHREADS, 0);
    if (per_cu > 2) per_cu = 2;
    grid_blocks = cus * per_cu;
  }
#if MK_PROBE_SPLIT
  for (int ph = 0; ph < NPHASES; ++ph) fwd_megakernel<<<grid_blocks, NTHREADS, 0, stream>>>(p, ph);
#else
  void* args[] = {&p};
  hipLaunchCooperativeKernel((void*)fwd_megakernel, dim3(grid_blocks), dim3(NTHREADS), args, 0, stream);
#endif
#else
  const int G = 512;
  phase_kernel<0><<<G, NTHREADS, 0, stream>>>(p);
#if REPEAT_MASK & (1 << 0)
  phase_kernel<0><<<G, NTHREADS, 0, stream>>>(p);
#endif
  phase_kernel<1><<<G, NTHREADS, 0, stream>>>(p);
#if REPEAT_MASK & (1 << 1)
  phase_kernel<1><<<G, NTHREADS, 0, stream>>>(p);
#endif
  phase_kernel<2><<<G, NTHREADS, 0, stream>>>(p);
#if REPEAT_MASK & (1 << 2)
  phase_kernel<2><<<G, NTHREADS, 0, stream>>>(p);
#endif
  phase_kernel<3><<<G, NTHREADS, 0, stream>>>(p);
#if REPEAT_MASK & (1 << 3)
  phase4_again<<<G, NTHREADS, 0, stream>>>(p);
#endif
  phase_kernel<4><<<G, NTHREADS, 0, stream>>>(p);
#if REPEAT_MASK & (1 << 4)
  phase_kernel<4><<<G, NTHREADS, 0, stream>>>(p);
#endif
  phase_kernel<5><<<G, NTHREADS, 0, stream>>>(p);
#if REPEAT_MASK & (1 << 5)
  phase_kernel<5><<<G, NTHREADS, 0, stream>>>(p);
#endif
  phase_kernel<6><<<G, NTHREADS, 0, stream>>>(p);
#if REPEAT_MASK & (1 << 6)
  phase_kernel<6><<<G, NTHREADS, 0, stream>>>(p);
#endif
  phase_kernel<7><<<G, NTHREADS, 0, stream>>>(p);
#if REPEAT_MASK & (1 << 7)
  phase_kernel<7><<<G, NTHREADS, 0, stream>>>(p);
#endif
  phase_kernel<8><<<G, NTHREADS, 0, stream>>>(p);
#if REPEAT_MASK & (1 << 8)
  phase_kernel<8><<<G, NTHREADS, 0, stream>>>(p);
#endif
  phase_kernel<9><<<G, NTHREADS, 0, stream>>>(p);
#if REPEAT_MASK & (1 << 9)
  phase_kernel<9><<<G, NTHREADS, 0, stream>>>(p);
#endif
  phase_kernel<10><<<G, NTHREADS, 0, stream>>>(p);
#if REPEAT_MASK & (1 << 10)
  phase_kernel<10><<<G, NTHREADS, 0, stream>>>(p);
#endif
#endif
}
```

```cpp
#include <hip/hip_runtime.h>
#include <hip/hip_cooperative_groups.h>
#include <stdint.h>
namespace cg = cooperative_groups;

#define DI __device__ __forceinline__
typedef unsigned short u16;
typedef __attribute__((ext_vector_type(8))) short bf16x8;
typedef __attribute__((ext_vector_type(16))) float f32x16;
typedef __attribute__((ext_vector_type(4))) float f32x4;
typedef __attribute__((ext_vector_type(4))) unsigned u32x4;
typedef __attribute__((ext_vector_type(2))) unsigned u32x2;
typedef __attribute__((ext_vector_type(2))) __bf16 bf16x2v;

constexpr int BATCH = 8, SEQ = 4096, DM = 1024, NTOK = BATCH * SEQ;
constexpr int NIN = 5416, NP = 5504;
constexpr int NTHREADS = 256;
constexpr int SMEM_BYTES = 72 * 1024;
constexpr float L2E = 1.4426950408889634f;

constexpr size_t AL(size_t x) { return (x + 255) & ~(size_t)255; }
constexpr size_t OFF_WINT = 0;
constexpr size_t OFF_WAT = OFF_WINT + AL((size_t)NP * 1024 * 2);
constexpr size_t OFF_WBT = OFF_WAT + AL((size_t)1024 * 512 * 2);
constexpr size_t OFF_WOT = OFF_WBT + AL((size_t)1024 * 512 * 2);
constexpr size_t OFF_WQT = OFF_WOT + AL((size_t)1024 * 1024 * 2);
constexpr size_t OFF_SK = OFF_WQT + AL((size_t)2048 * 1024 * 2);
constexpr size_t OFF_WKT = OFF_SK + AL((size_t)16 * 128 * 128 * 2);
constexpr size_t OFF_WVT = OFF_WKT + AL((size_t)128 * 2048 * 2);
constexpr size_t OFF_EU = OFF_WVT + AL((size_t)128 * 2048 * 2);
constexpr size_t OFF_EV = OFF_EU + AL((size_t)16384 * 1024 * 2);
constexpr size_t OFF_MISC = OFF_EV + AL((size_t)16384 * 1024 * 2);
constexpr size_t MISC_CK = 0, MISC_CV = 256, MISC_BIAS = 512, MISC_CNT = 512 + 8 * 132 * 4 + 256, MISC_GL = 8192;
constexpr size_t MISC_SCU = 65536, MISC_SCV = 131072;
constexpr size_t OFF_RH = OFF_MISC + 262144;
constexpr size_t OFF_QKV = OFF_RH + (size_t)NTOK * 1024 * 2;
constexpr size_t OFF_Z = OFF_QKV + (size_t)NTOK * 1536 * 2;
constexpr size_t OFF_NQ = OFF_Z + (size_t)NTOK * 512 * 2;
constexpr size_t OFF_NKV = OFF_NQ + (size_t)NTOK * 512 * 2;
constexpr size_t OFF_MG = OFF_NKV + (size_t)NTOK * 768 * 2;
constexpr size_t OFF_SM = OFF_MG + (size_t)NTOK * 2048 * 2;
constexpr size_t OFF_VST = OFF_SM + AL((size_t)NTOK * 40 * 4);
constexpr size_t OFF_VWT = OFF_VST + (size_t)16 * 64 * 4096 * 2;
constexpr size_t OFF_KC = OFF_VWT + (size_t)16 * 64 * 4096 * 2;
constexpr size_t OFF_VCT = OFF_KC + (size_t)16 * 256 * 64 * 2;
constexpr size_t WS_NEEDED = OFF_VCT + (size_t)16 * 64 * 256 * 2;

struct Params {
  const float *x, *rel_bias, *norm_final, *norm_mix, *w_in, *conv_w, *a_log, *dt_bias, *gdn_norm, *cmp_pe_k, *cmp_pe_v,
      *cmp_w_k, *cmp_w_v, *w_a, *w_b, *w_out, *norm_ffn, *w_query, *sub_keys, *expert_u, *expert_v;
  float* out;
  char* ws;
};

DI u16 f2bf(float x) { return __builtin_bit_cast(u16, (__bf16)x); }
DI float bf2f(u16 b) { return __uint_as_float(((unsigned)b) << 16); }
typedef __attribute__((ext_vector_type(2))) float f32x2_;
typedef __attribute__((ext_vector_type(2))) __bf16 bf16x2_;
DI unsigned pack2(float lo, float hi) { f32x2_ v = {lo, hi}; return __builtin_bit_cast(unsigned, __builtin_convertvector(v, bf16x2_)); }
DI float bflo(unsigned u) { return __uint_as_float(u << 16); }
DI float bfhi(unsigned u) { return __uint_as_float(u & 0xffff0000u); }
DI float wave_sum(float v) {
#pragma unroll
  for (int o = 32; o >= 1; o >>= 1) v += __shfl_xor(v, o);
  return v;
}
DI int tidx() { int t = (int)__builtin_amdgcn_workitem_id_x(); asm volatile("" : "+v"(t)); return t; }
DI int opaque0() { int z = 0; asm volatile("" : "+v"(z)); return z; }
DI float sigmoidf_(float x) { return 1.f / (1.f + __expf(-x)); }
DI f32x16 mfma32(bf16x8 a, bf16x8 b, f32x16 c) { return __builtin_amdgcn_mfma_f32_32x32x16_bf16(a, b, c, 0, 0, 0); }
DI f32x4 mfma16(bf16x8 a, bf16x8 b, f32x4 c) { return __builtin_amdgcn_mfma_f32_16x16x32_bf16(a, b, c, 0, 0, 0); }
DI int swz(int row, int ch) { return row * 128 + ((ch ^ ((row >> 1) & 7)) << 4); }
DI bf16x8 lds_frag(const char* tile, int row, int ch) { return *(const bf16x8*)(tile + swz(row, ch)); }
DI bf16x8 pad_frag(const char* tile, int row, int ch) { return *(const bf16x8*)(tile + row * 144 + ch * 16); }
DI bf16x8 pack8(float a0, float a1, float a2, float a3, float a4, float a5, float a6, float a7) {
  u32x4 p;
  p[0] = pack2(a0, a1); p[1] = pack2(a2, a3); p[2] = pack2(a4, a5); p[3] = pack2(a6, a7);
  return __builtin_bit_cast(bf16x8, p);
}
DI int perm16(int o) { return (o & ~12) | ((o & 4) << 1) | ((o & 8) >> 1); }

DI int win_colmap(int n) {
  if (n < 2048) return n;
  if (n < 2560) return n - 2048 + 2064;
  if (n < 3328) return n - 2560 + 2576;
  if (n < 5376) return n - 3328 + 3368;
  if (n < 5392) return n - 5376 + 2048;
  if (n < 5416) return n - 5392 + 3344;
  return -1;
}
template <int MAPMODE>
DI void tconv_tile(const float* __restrict__ src, int K, int N, u16* __restrict__ dst, int kt, int nt, char* smem) {
  float* tile = (float*)smem;
  const int tid = tidx();
  const int nl = tid & 63, k0 = kt * 64, n0 = nt * 64;
  int col;
  if (MAPMODE == 1) col = win_colmap(n0 + nl); else col = (n0 + nl < N) ? (n0 + nl) : -1;
#pragma unroll 4
  for (int i = 0; i < 16; ++i) {
    int kl = (tid >> 6) + 4 * i;
    float v = (col >= 0) ? src[(size_t)(k0 + kl) * N + col] : 0.f;
    tile[kl * 65 + nl] = v;
  }
  __syncthreads();
  {
    const int n2 = tid >> 2, kp = tid & 3;
    u32x4 o0, o1;
#pragma unroll
    for (int i = 0; i < 4; ++i) {
      o0[i] = pack2(tile[(kp * 16 + 2 * i) * 65 + n2], tile[(kp * 16 + 2 * i + 1) * 65 + n2]);
      o1[i] = pack2(tile[(kp * 16 + 8 + 2 * i) * 65 + n2], tile[(kp * 16 + 8 + 2 * i + 1) * 65 + n2]);
    }
    u16* d = dst + (size_t)(n0 + n2) * K + k0 + kp * 16;
    *(u32x4*)d = o0;
    *(u32x4*)(d + 8) = o1;
  }
  __syncthreads();
}

DI void convert_flat(const float* __restrict__ src, u16* __restrict__ dst, size_t n, int bid, int nblk) {
  size_t nv = n / 8;
  for (size_t i = (size_t)bid * NTHREADS + tidx(); i < nv; i += (size_t)nblk * NTHREADS) {
    f32x4 a = ((const f32x4*)src)[2 * i], b = ((const f32x4*)src)[2 * i + 1];
    u32x4 o;
    o[0] = pack2(a[0], a[1]); o[1] = pack2(a[2], a[3]); o[2] = pack2(b[0], b[1]); o[3] = pack2(b[2], b[3]);
    ((u32x4*)dst)[i] = o;
  }
}


typedef __attribute__((ext_vector_type(2))) float f32x2;
DI unsigned f32_to_e4m3(float x) {
  unsigned u = __float_as_uint(x);
  const unsigned sign = (u >> 24) & 0x80u;
  u &= 0x7fffffffu;
  const float ax = __uint_as_float(u);
  unsigned r;
  if (ax < 0.015625f) r = (unsigned)__float2int_rn(ax * 512.f);
  else { u += 0x7ffffu + ((u >> 20) & 1u); r = (u >> 20) - (120u << 3); if (r > 0x7eu) r = 0x7eu; }
  return sign | r;
}
DI void convert_fp8_rows(const float* __restrict__ src, unsigned char* __restrict__ dst, float* __restrict__ inv_scale, int nrows, int bid, int nblk) {
  const int lane = tidx() & 63, wv = tidx() >> 6;
  for (int row = bid * 4 + wv; row < nrows; row += nblk * 4) {
    const f32x4* sp = (const f32x4*)(src + (size_t)row * 1024 + 16 * lane);
    f32x4 v[4];
    float mx = 0.f;
#pragma unroll
    for (int i = 0; i < 4; ++i) { v[i] = sp[i]; mx = fmaxf(mx, fmaxf(fmaxf(fabsf(v[i][0]), fabsf(v[i][1])), fmaxf(fabsf(v[i][2]), fabsf(v[i][3])))); }
#pragma unroll
    for (int o = 32; o >= 1; o >>= 1) mx = fmaxf(mx, __shfl_xor(mx, o));
    const float sc = (mx > 0.f) ? 240.f / mx : 1.f;
    u32x4 o4;
#pragma unroll
    for (int i = 0; i < 4; ++i)
      o4[i] = f32_to_e4m3(v[i][0] * sc) | (f32_to_e4m3(v[i][1] * sc) << 8) | (f32_to_e4m3(v[i][2] * sc) << 16) | (f32_to_e4m3(v[i][3] * sc) << 24);
    *(u32x4*)(dst + (size_t)row * 1024 + 16 * lane) = o4;
    if (lane == 0) inv_scale[row] = (mx > 0.f) ? mx / 240.f : 1.f;
  }
}

DI void rmsnorm_rows_bf16(const float* __restrict__ src, const float* __restrict__ w, u16* __restrict__ dst, int nrows, int bid, int nblk) {
  const int lane = tidx() & 63, wv = tidx() >> 6;
  f32x4 wr[4];
#pragma unroll
  for (int i = 0; i < 4; ++i) wr[i] = ((const f32x4*)w)[lane + 64 * i];
  for (int row = bid * 4 + wv; row < nrows; row += nblk * 4) {
    const f32x4* s = (const f32x4*)(src + (size_t)row * 1024);
    f32x4 v[4];
    float ss = 0.f;
#pragma unroll
    for (int i = 0; i < 4; ++i) { v[i] = s[lane + 64 * i]; ss += v[i][0] * v[i][0] + v[i][1] * v[i][1] + v[i][2] * v[i][2] + v[i][3] * v[i][3]; }
    ss = wave_sum(ss);
    float rs = rsqrtf(ss * (1.f / 1024.f) + 1e-6f);
#pragma unroll
    for (int i = 0; i < 4; ++i) {
      u32x2 o;
      o[0] = pack2(v[i][0] * rs * wr[i][0], v[i][1] * rs * wr[i][1]);
      o[1] = pack2(v[i][2] * rs * wr[i][2], v[i][3] * rs * wr[i][3]);
      *(u32x2*)(dst + (size_t)row * 1024 + (lane + 64 * i) * 4) = o;
    }
  }
}

DI int t5_bucket(int d) {
  if (d < 16) return d < 0 ? 0 : d;
  const int th[16] = {16, 19, 21, 24, 27, 31, 35, 40, 46, 52, 59, 67, 77, 87, 99, 113};
  int b = 16;
#pragma unroll
  for (int k = 1; k < 16; ++k) b += (d >= th[k]) ? 1 : 0;
  return b;
}

DI void phase0(const Params& p, int bid, int nblk, char* smem) {
  char* ws = p.ws;
  const int n_win = 16 * 86, n_wa = 8 * 16, n_wo = 16 * 16, n_wq = 16 * 32, n_wc = 32 * 2;
  const int total = n_win + 2 * n_wa + n_wo + n_wq + 2 * n_wc;
  for (int it = bid; it < total; it += nblk) {
    int i = it;
    if (i < n_win) { tconv_tile<1>(p.w_in, 1024, NIN, (u16*)(ws + OFF_WINT), i / 86, i % 86, smem); continue; }
    i -= n_win;
    if (i < n_wa) { tconv_tile<0>(p.w_a, 512, 1024, (u16*)(ws + OFF_WAT), i / 16, i % 16, smem); continue; }
    i -= n_wa;
    if (i < n_wa) { tconv_tile<0>(p.w_b, 512, 1024, (u16*)(ws + OFF_WBT), i / 16, i % 16, smem); continue; }
    i -= n_wa;
    if (i < n_wo) { tconv_tile<0>(p.w_out, 1024, 1024, (u16*)(ws + OFF_WOT), i / 16, i % 16, smem); continue; }
    i -= n_wo;
    if (i < n_wq) { tconv_tile<0>(p.w_query, 1024, 2048, (u16*)(ws + OFF_WQT), i / 32, i % 32, smem); continue; }
    i -= n_wq;
    if (i < n_wc) { tconv_tile<0>(p.cmp_w_k, 2048, 64, (u16*)(ws + OFF_WKT), i / 2, i % 2, smem); continue; }
    i -= n_wc;
    tconv_tile<0>(p.cmp_w_v, 2048, 64, (u16*)(ws + OFF_WVT), i / 2, i % 2, smem);
  }
  convert_flat(p.sub_keys, (u16*)(ws + OFF_SK), (size_t)16 * 128 * 128, bid, nblk);
  convert_fp8_rows(p.expert_u, (unsigned char*)(ws + OFF_EU), (float*)(ws + OFF_MISC + MISC_SCU), 16384, bid, nblk);
  convert_fp8_rows(p.expert_v, (unsigned char*)(ws + OFF_EV), (float*)(ws + OFF_MISC + MISC_SCV), 16384, bid, nblk);
  rmsnorm_rows_bf16(p.x, p.norm_mix, (u16*)(ws + OFF_RH), NTOK, bid, nblk);
  const int tid = tidx();
  if (bid == nblk - 1) {
    float* ck = (float*)(ws + OFF_MISC + MISC_CK);
    float* cv = (float*)(ws + OFF_MISC + MISC_CV);
    if (tid < 128) {
      const int e = tid & 63;
      const float* pe = (tid < 64) ? p.cmp_pe_k : p.cmp_pe_v;
      const float* W = (tid < 64) ? p.cmp_w_k : p.cmp_w_v;
      float s = 0.f;
      for (int k = 0; k < 2048; ++k) s += pe[k] * W[(size_t)k * 64 + e];
      if (tid < 64) ck[e] = s; else cv[e] = s;
    }
  }
  if (bid == nblk - 2 || nblk == 1) {
    float* bt = (float*)(ws + OFF_MISC + MISC_BIAS);
    for (int i = tid; i < 8 * 132; i += NTHREADS) {
      int hd = i / 132, d = i % 132;
      bt[i] = p.rel_bias[t5_bucket(d) * 8 + hd] * L2E;
    }
    if (tid < 16) ((unsigned*)(ws + OFF_MISC + MISC_CNT))[tid] = 0u;
  }
}

struct GemmPtrs {
  const u16* a[4];
  const u16* b[4];
  long aks, bks;
};

typedef __attribute__((address_space(3))) unsigned* lds_u32p;
DI void glds16(const u16* gsrc, const char* lds_dst) {
  __builtin_amdgcn_global_load_lds((const unsigned*)gsrc, (lds_u32p)(unsigned)(size_t)lds_dst, 16, 0, 0);
}
DI void gemm_kloop(f32x16 (&acc)[2][2], const GemmPtrs& g, int nkt, char* smem) {
  const int tid = tidx(), lane = tid & 63, w = tid >> 6, wm = w >> 1, wn = w & 1, r = lane & 31, h = lane >> 5;
  const char* dstA = smem + (w * 4) * 1024 + lane * 16;
#pragma unroll
  for (int i = 0; i < 4; ++i) { glds16(g.a[i], dstA + i * 1024); glds16(g.b[i], dstA + 16384 + i * 1024); }
  asm volatile("s_waitcnt vmcnt(0)" ::: "memory");
  __syncthreads();
  for (int kt = 0; kt < nkt; ++kt) {
    const char* A = smem + (kt & 1) * 32768;
    const char* B = A + 16384;
    if (kt + 1 < nkt) {
      const char* d2 = dstA + ((kt + 1) & 1) * 32768;
#pragma unroll
      for (int i = 0; i < 4; ++i) { glds16(g.a[i] + (long)(kt + 1) * g.aks, d2 + i * 1024); glds16(g.b[i] + (long)(kt + 1) * g.bks, d2 + 16384 + i * 1024); }
    }
#pragma unroll
    for (int s = 0; s < 4; ++s) {
      bf16x8 a0 = lds_frag(A, wm * 64 + r, 2 * s + h);
      bf16x8 a1 = lds_frag(A, wm * 64 + 32 + r, 2 * s + h);
      bf16x8 b0 = lds_frag(B, wn * 64 + r, 2 * s + h);
      bf16x8 b1 = lds_frag(B, wn * 64 + 32 + r, 2 * s + h);
      acc[0][0] = mfma32(a0, b0, acc[0][0]);
      acc[0][1] = mfma32(a0, b1, acc[0][1]);
      acc[1][0] = mfma32(a1, b0, acc[1][0]);
      acc[1][1] = mfma32(a1, b1, acc[1][1]);
    }
    asm volatile("s_waitcnt vmcnt(0)" ::: "memory");
    __syncthreads();
  }
}

DI void zero_acc(f32x16 (&acc)[2][2]) {
#pragma unroll
  for (int i = 0; i < 2; ++i)
#pragma unroll
    for (int j = 0; j < 2; ++j)
#pragma unroll
      for (int k = 0; k < 16; ++k) acc[i][j][k] = 0.f;
}
DI int glds_row(int i) { return ((tidx() >> 6) * 4 + i) * 8 + ((tidx() & 63) >> 3); }
DI int glds_chunk(int row) { return (tidx() & 7) ^ ((row >> 1) & 7); }
DI void gemm_setup(GemmPtrs& g, const u16* A, long lda, int m0, const u16* Bt, long ldb, int n0) {
#pragma unroll
  for (int i = 0; i < 4; ++i) {
    const int row = glds_row(i), ch = glds_chunk(row);
    g.a[i] = A + (size_t)(m0 + row) * lda + ch * 8;
    g.b[i] = Bt + (size_t)(n0 + row) * ldb + ch * 8;
  }
  g.aks = 64; g.bks = 64;
}
template <class F>
DI void gemm_epilogue(const f32x16 (&acc)[2][2], F f) {
  const int lane = tidx() & 63, w = tidx() >> 6, wm = w >> 1, wn = w & 1, r = lane & 31, h = lane >> 5;
#pragma unroll
  for (int i = 0; i < 2; ++i)
#pragma unroll
    for (int j = 0; j < 2; ++j) {
#pragma unroll
      for (int k = 0; k < 16; ++k) f(wm * 64 + i * 32 + (k & 3) + 8 * (k >> 2) + 4 * h, wn * 64 + j * 32 + r, acc[i][j][k]);
      asm volatile("" ::: "memory");
    }
}

template <class F>
DI void gemm_epilogue_lds(const f32x16 (&acc)[2][2], char* smem, F f) {
  float* T = (float*)smem;
  {
    const int lane = tidx() & 63, w = tidx() >> 6, wm = w >> 1, wn = w & 1, r = lane & 31, h = lane >> 5;
#pragma unroll
    for (int i = 0; i < 2; ++i)
#pragma unroll
      for (int j = 0; j < 2; ++j)
#pragma unroll
        for (int k = 0; k < 16; ++k) T[(wm * 64 + i * 32 + (k & 3) + 8 * (k >> 2) + 4 * h) * 132 + wn * 64 + j * 32 + r] = acc[i][j][k];
  }
  __syncthreads();
  const int c8 = (tidx() & 15) * 8, r0 = tidx() >> 4;
#pragma unroll 2
  for (int it = 0; it < 8; ++it) {
    const int row = r0 + 16 * it;
    const f32x4 a = *(const f32x4*)(T + row * 132 + c8), b = *(const f32x4*)(T + row * 132 + c8 + 4);
    const float v[8] = {a[0], a[1], a[2], a[3], b[0], b[1], b[2], b[3]};
    f(row, c8, v);
  }
  __syncthreads();
}
DI u32x4 pack8u(const float (&v)[8]) { u32x4 o; o[0] = pack2(v[0], v[1]); o[1] = pack2(v[2], v[3]); o[2] = pack2(v[4], v[5]); o[3] = pack2(v[6], v[7]); return o; }

DI bool xcd_tile(int k, int bid, int nblk, int NMT, int NNT, int& mt, int& nt) {
  if ((nblk & 7) != 0 || nblk < 8) {
    const int t = bid + k * nblk;
    if (t >= NMT * NNT) return false;
    mt = t / NNT; nt = t % NNT; return true;
  }
  const int x = bid & 7, j = bid >> 3, per = nblk >> 3;
  const int groups = NMT >> 6;
  const int i = j + k * per;
  if (i >= groups * 8 * NNT) return false;
  const int g = i / (8 * NNT), rem = i - g * (8 * NNT);
  nt = rem >> 3; mt = ((x + 8 * g) << 3) + (rem & 7);
  return true;
}

DI void phase_inproj(const Params& p, int bid, int nblk, char* smem) {
  char* ws = p.ws;
  const u16* H = (const u16*)(ws + OFF_RH);
  const u16* W = (const u16*)(ws + OFF_WINT);
  const int NT = NP / 128;
  for (int k = 0;; ++k) {
    int mt, nt;
    if (!xcd_tile(k, bid, nblk, 256, NT, mt, nt)) break;
    const int m0 = mt * 128, n0 = nt * 128;
    GemmPtrs g;
    gemm_setup(g, H, 1024, m0, W, 1024, n0);
    f32x16 acc[2][2];
    zero_acc(acc);
    gemm_kloop(acc, g, 16, smem);
    if (n0 >= 5376) {
      float* SM = (float*)(ws + OFF_SM);
      gemm_epilogue_lds(acc, smem, [&](int ml, int nl, const float (&v)[8]) {
        if (nl < 40) {
          float* d = SM + (size_t)(m0 + ml) * 40 + nl;
          *(f32x4*)d = f32x4{v[0], v[1], v[2], v[3]};
          *(f32x4*)(d + 4) = f32x4{v[4], v[5], v[6], v[7]};
        }
      });
    } else {
      u16* dst; int ld, c0;
      if (n0 < 1536) { dst = (u16*)(ws + OFF_QKV); ld = 1536; c0 = n0; }
      else if (n0 < 2048) { dst = (u16*)(ws + OFF_Z); ld = 512; c0 = n0 - 1536; }
      else if (n0 < 2560) { dst = (u16*)(ws + OFF_NQ); ld = 512; c0 = n0 - 2048; }
      else if (n0 < 3328) { dst = (u16*)(ws + OFF_NKV); ld = 768; c0 = n0 - 2560; }
      else { dst = (u16*)(ws + OFF_MG); ld = 2048; c0 = n0 - 3328; }
      gemm_epilogue_lds(acc, smem, [&](int ml, int nl, const float (&v)[8]) { *(u32x4*)(dst + (size_t)(m0 + ml) * ld + c0 + nl) = pack8u(v); });
    }
  }
}

DI void vtrans_item(const Params& p, int item, char* smem) {
  char* ws = p.ws;
  const int tile = item & 63, bg = (item >> 6) & 15, which = item >> 10;
  const int b = bg >> 1, g = bg & 1;
  const u16* NKV = (const u16*)(ws + OFF_NKV);
  u16* VT = (u16*)(ws + (which ? OFF_VWT : OFF_VST)) + (size_t)bg * 64 * 4096;
  const int col0 = (which ? 640 : 384) + g * 64;
  u16* t = (u16*)smem;
  const int tid = tidx();
  {
#pragma unroll
    for (int i = 0; i < 2; ++i) {
      int c = tid + 256 * i, row = c >> 3, ch = c & 7;
      u32x4 v = *(const u32x4*)(NKV + (size_t)(b * SEQ + tile * 64 + row) * 768 + col0 + ch * 8);
      *(u32x4*)(t + row * 72 + ch * 8) = v;
    }
  }
  __syncthreads();
  {
    const int d = tid >> 2, part = tid & 3;
    u32x4 o0, o1;
    u16 vals[16];
#pragma unroll
    for (int pp = 0; pp < 16; ++pp) vals[pp] = t[(part * 16 + perm16(pp)) * 72 + d];
#pragma unroll
    for (int i = 0; i < 4; ++i) {
      o0[i] = (unsigned)vals[2 * i] | ((unsigned)vals[2 * i + 1] << 16);
      o1[i] = (unsigned)vals[8 + 2 * i] | ((unsigned)vals[8 + 2 * i + 1] << 16);
    }
    u16* dst = VT + (size_t)d * 4096 + tile * 64 + part * 16;
    *(u32x4*)dst = o0;
    *(u32x4*)(dst + 8) = o1;
  }
  __syncthreads();
}

DI void cmp_gemm_item(const Params& p, int item, char* smem) {
  char* ws = p.ws;
  const int which = item >> 5, mt = item & 31, m0 = mt * 128;
  const u16* NKV = (const u16*)(ws + OFF_NKV);
  const u16* Wt = (const u16*)(ws + (which ? OFF_WVT : OFF_WKT));
  GemmPtrs g;
#pragma unroll
  for (int i = 0; i < 4; ++i) {
    const int row = glds_row(i), ch = glds_chunk(row);
    int m = m0 + row, bg = m >> 8, n = m & 255;
    if (n > 254) n = 254;
    g.a[i] = NKV + (size_t)((bg >> 1) * SEQ + 16 * n) * 768 + which * 128 + (bg & 1) * 64 + ch * 8;
    g.b[i] = Wt + (size_t)row * 2048 + ch * 8;
  }
  g.aks = 768; g.bks = 64;
  f32x16 acc[2][2];
  zero_acc(acc);
  gemm_kloop(acc, g, 32, smem);
  const float* cc = (const float*)(ws + OFF_MISC + (which ? MISC_CV : MISC_CK));
  if (which == 0) {
    u16* KC = (u16*)(ws + OFF_KC);
    gemm_epilogue_lds(acc, smem, [&](int ml, int nl, const float (&v)[8]) {
      if (nl < 64) {
        float t[8];
#pragma unroll
        for (int e = 0; e < 8; ++e) t[e] = v[e] + cc[nl + e];
        *(u32x4*)(KC + (size_t)(m0 + ml) * 64 + nl) = pack8u(t);
      }
    });
  } else {
    u16* VCT = (u16*)(ws + OFF_VCT);
    gemm_epilogue_lds(acc, smem, [&](int ml, int nl, const float (&v)[8]) {
      if (nl < 64) {
        const int m = m0 + ml, bg = m >> 8, n = m & 255;
        u16* d = VCT + ((size_t)bg * 64 + nl) * 256 + (n & ~15) + perm16(n & 15);
#pragma unroll
        for (int e = 0; e < 8; ++e) d[e * 256] = f2bf(v[e] + cc[nl + e]);
      }
    });
  }
}

DI void gdn_store_frag(u16* dst, const char* tile, int idx  , float scale_is_row, const float* rowscale) {
  const int blk = idx >> 6, lane = idx & 63, rt = blk >> 1, ks = blk & 1, r = lane & 15, q = lane >> 4;
  const int row = 16 * rt + r;
  const int k0 = 32 * ks + 4 * q, k1 = k0 + 16;
  u32x2 lo = *(const u32x2*)(tile + swz(row, k0 >> 3) + (k0 & 7) * 2);
  u32x2 hi = *(const u32x2*)(tile + swz(row, k1 >> 3) + (k1 & 7) * 2);
  u32x4 o;
  if (rowscale) {
    float s = rowscale[row];
    o[0] = pack2(bflo(lo[0]) * s, bfhi(lo[0]) * s); o[1] = pack2(bflo(lo[1]) * s, bfhi(lo[1]) * s);
    o[2] = pack2(bflo(hi[0]) * s, bfhi(hi[0]) * s); o[3] = pack2(bflo(hi[1]) * s, bfhi(hi[1]) * s);
  } else { o[0] = lo[0]; o[1] = lo[1]; o[2] = hi[0]; o[3] = hi[1]; }
  *(u32x4*)(dst + (size_t)idx * 8) = o;
}

DI void gdn_chunk_item(const Params& p, int item, char* smem) {
  char* ws = p.ws;
  const int n = item & 63, bh = item >> 6, b = bh >> 3, hd = bh & 7;
  const int tid = tidx() + opaque0(), lane = tid & 63, w = tid >> 6;
  char* Cq = smem;
  char* Ck = smem + 8192;
  char* Cv = smem + 16384;
  float* Am = (float*)(smem + 24576);
  char* ATT = smem + 40960;
  char* Wt = smem + 49152;
  float* gc = (float*)(smem + 57344);
  float* bet = gc + 64;
  float* eg = gc + 128;
  float* ekd = gc + 192;
  const u16* QKV = (const u16*)(ws + OFF_QKV);
  const size_t tok0 = (size_t)b * SEQ + n * 64;
  {
    const int cg = tid & 7, tp = tid >> 3;
#pragma unroll
    for (int part = 0; part < 3; ++part) {
      const int col = part * 512 + hd * 64 + cg * 8;
      const int s0 = n * 64 + 2 * tp;
      const u16* src = QKV + ((size_t)b * SEQ) * 1536 + col;
      u32x4 xr[5];
#pragma unroll
      for (int j = 0; j < 5; ++j) {
        const int ss = s0 - 3 + j;
        xr[j] = (ss >= 0) ? *(const u32x4*)(src + (size_t)ss * 1536) : u32x4{0u, 0u, 0u, 0u};
      }
      float wv[4][8];
#pragma unroll
      for (int j = 0; j < 4; ++j) {
        const f32x4 wa = *(const f32x4*)(p.conv_w + j * 1536 + col), wb = *(const f32x4*)(p.conv_w + j * 1536 + col + 4);
        wv[j][0] = wa[0]; wv[j][1] = wa[1]; wv[j][2] = wa[2]; wv[j][3] = wa[3]; wv[j][4] = wb[0]; wv[j][5] = wb[1]; wv[j][6] = wb[2]; wv[j][7] = wb[3];
      }
      char* C = smem + part * 8192;
#pragma unroll
      for (int tt = 0; tt < 2; ++tt) {
        float y[8];
#pragma unroll
        for (int e = 0; e < 8; ++e) {
          float acc = 0.f;
#pragma unroll
          for (int j = 0; j < 4; ++j) {
            const unsigned wd = xr[tt + j][e >> 1];
            acc += wv[j][e] * ((e & 1) ? bfhi(wd) : bflo(wd));
          }
          y[e] = acc / (1.f + __expf(-acc));
        }
        u32x4 o; o[0] = pack2(y[0], y[1]); o[1] = pack2(y[2], y[3]); o[2] = pack2(y[4], y[5]); o[3] = pack2(y[6], y[7]);
        *(u32x4*)(C + swz(2 * tp + tt, cg)) = o;
      }
    }
  }
  if (w == 0) {
    const float* SM = (const float*)(ws + OFF_SM);
    float bi = SM[(tok0 + lane) * 40 + hd], ai = SM[(tok0 + lane) * 40 + 8 + hd];
    float xs = ai + p.dt_bias[hd];
    float sp = (xs > 20.f) ? xs : log1pf(__expf(xs));
    float gv = -__expf(p.a_log[hd]) * sp;
#pragma unroll
    for (int o = 1; o < 64; o <<= 1) { float t = __shfl_up(gv, o); if (lane >= o) gv += t; }
    float glast = __shfl(gv, 63);
    gc[lane] = gv; bet[lane] = sigmoidf_(bi); eg[lane] = __expf(gv); ekd[lane] = __expf(glast - gv);
    if (lane == 63) ((float*)(ws + OFF_MISC + MISC_GL))[item] = __expf(gv);
  }
  __syncthreads();
  if (tid < 128) {
    char* C = (tid < 64) ? Cq : Ck;
    const int row = tid & 63;
    u32x4 v[8];
    float ss = 0.f;
#pragma unroll
    for (int c = 0; c < 8; ++c) {
      v[c] = *(const u32x4*)(C + swz(row, c));
#pragma unroll
      for (int e = 0; e < 4; ++e) { float a = bflo(v[c][e]), bb = bfhi(v[c][e]); ss += a * a + bb * bb; }
    }
    float rs = rsqrtf(ss + 1e-6f) * ((tid < 64) ? 0.125f : 1.f);
#pragma unroll
    for (int c = 0; c < 8; ++c) {
      u32x4 o;
#pragma unroll
      for (int e = 0; e < 4; ++e) o[e] = pack2(bflo(v[c][e]) * rs, bfhi(v[c][e]) * rs);
      *(u32x4*)(C + swz(row, c)) = o;
    }
  }
  __syncthreads();
  {
    const int qa = w >> 1, qb = w & 1, r = lane & 31, h = lane >> 5;
    f32x16 akk, aqk;
#pragma unroll
    for (int k = 0; k < 16; ++k) { akk[k] = 0.f; aqk[k] = 0.f; }
    if (!(qa == 0 && qb == 1)) {
#pragma unroll
      for (int s = 0; s < 4; ++s) {
        bf16x8 ak = lds_frag(Ck, 32 * qa + r, 2 * s + h);
        bf16x8 aq = lds_frag(Cq, 32 * qa + r, 2 * s + h);
        bf16x8 bk = lds_frag(Ck, 32 * qb + r, 2 * s + h);
        akk = mfma32(ak, bk, akk);
        aqk = mfma32(aq, bk, aqk);
      }
    }
    const int j = 32 * qb + r;
    const float gj = gc[j];
#pragma unroll
    for (int k = 0; k < 16; ++k) {
      const int i = 32 * qa + (k & 3) + 8 * (k >> 2) + 4 * h;
      float dec = __expf(fminf(gc[i] - gj, 0.f));
      Am[i * 64 + j] = (j < i) ? akk[k] * bet[i] * dec : 0.f;
      *(u16*)(ATT + swz(i, j >> 3) + (j & 7) * 2) = f2bf((j <= i) ? aqk[k] * dec : 0.f);
    }
  }
  __syncthreads();
  u16* AMg = (u16*)p.out + (size_t)item * 16384;
  {
    const int c = tid >> 1, half = tid & 1, dcol = c & 63;
    const char* Rt = (c < 64) ? Cv : Ck;
    float xh[32];
#pragma unroll
    for (int k = 0; k < 32; ++k) xh[k] = 0.f;
#pragma unroll
    for (int i = 0; i < 64; ++i) {
      const float rhs = bf2f(*(const u16*)(Rt + swz(i, dcol >> 3) + (dcol & 7) * 2)) * bet[i] * ((c < 64) ? 1.f : eg[i]);
      float s0 = 0.f, s1 = 0.f;
#pragma unroll
      for (int j4 = 0; j4 < (i + 3) / 4; ++j4) {
        const f32x4 a = *(const f32x4*)(Am + i * 64 + j4 * 4);
        s0 += (half ? a[1] : a[0]) * xh[2 * j4];
        s1 += (half ? a[3] : a[2]) * xh[2 * j4 + 1];
      }
      float tot = s0 + s1;
      tot += __shfl_xor(tot, 1);
      float xi = rhs - tot;
      asm volatile("" : "+v"(xi) : : "memory");
      if ((i & 1) == 0) { if (half == 0) xh[i >> 1] = xi; } else { if (half == 1) xh[i >> 1] = xi; }
    }
    if (c < 64) {
      float* U = (float*)(ws + OFF_RH) + ((size_t)item * 64 + c) * 64;
#pragma unroll
      for (int k = 0; k < 32; ++k) U[2 * k + half] = xh[k];
    } else {
#pragma unroll
      for (int k = 0; k < 32; ++k) { const int i = 2 * k + half; *(u16*)(Wt + swz(i, dcol >> 3) + (dcol & 7) * 2) = f2bf(xh[k]); }
    }
  }
  {
#pragma unroll
    for (int i = 0; i < 2; ++i) {
      gdn_store_frag(AMg + 4096, Cq, tid + 256 * i, 1.f, eg);
      gdn_store_frag(AMg + 8192, ATT, tid + 256 * i, 0.f, nullptr);
    }
#pragma unroll
    for (int i = 0; i < 2; ++i) {
      const int idx = tid + 256 * i, blk = idx >> 6, ln = idx & 63, rt = blk >> 1, ks = blk & 1, r = ln & 15, q = ln >> 4;
      const int d = 16 * rt + r;
      float vv[8];
#pragma unroll
      for (int j = 0; j < 8; ++j) {
        const int tk = 32 * ks + ((j < 4) ? (4 * q + j) : (16 + 4 * q + (j - 4)));
        vv[j] = bf2f(*(const u16*)(Ck + swz(tk, d >> 3) + (d & 7) * 2)) * ekd[tk];
      }
      *(bf16x8*)(AMg + 12288 + (size_t)idx * 8) = pack8(vv[0], vv[1], vv[2], vv[3], vv[4], vv[5], vv[6], vv[7]);
    }
  }
  __syncthreads();
#pragma unroll
  for (int i = 0; i < 2; ++i) gdn_store_frag(AMg, Wt, tid + 256 * i, 0.f, nullptr);
  __syncthreads();
}

DI void phase2(const Params& p, int bid, int nblk, char* smem) {
  const int total = 64 + 2048 + 4096;
  for (int it = bid; it < total; it += nblk) {
    if (it < 64) cmp_gemm_item(p, it, smem);
    else if (it < 2112) vtrans_item(p, it - 64, smem);
    else gdn_chunk_item(p, it - 2112, smem);
  }
}

DI void gdn_scan_item(const Params& p, int bh, char* smem) {
  char* ws = p.ws;
  const int tid = tidx(), lane = tid & 63, w = tid >> 6, col = lane & 15, q = lane >> 4;
  const int b = bh >> 3, hd = bh & 7;
  const u16* AMg = (const u16*)p.out + (size_t)bh * 64 * 16384;
  const float* U = (const float*)(ws + OFF_RH) + (size_t)bh * 64 * 4096;
  const float* GL = (const float*)(ws + OFF_MISC + MISC_GL) + bh * 64;
  float* O = (float*)(ws + OFF_QKV);
  f32x4 S[4];
#pragma unroll
  for (int t = 0; t < 4; ++t) S[t] = f32x4{0.f, 0.f, 0.f, 0.f};
  u32x4 stg[8];
#pragma unroll
  for (int i = 0; i < 8; ++i) stg[i] = *(const u32x4*)(AMg + (size_t)(i * 256 + tid) * 8);
  f32x4 u[4];
#pragma unroll
  for (int ct = 0; ct < 4; ++ct) u[ct] = *(const f32x4*)(U + (size_t)(16 * w + col) * 64 + 16 * ct + 4 * q);
  float gl = GL[0];
  for (int n = 0; n < 64; ++n) {
    char* buf = smem + (n & 1) * 32768;
#pragma unroll
    for (int i = 0; i < 8; ++i) *(u32x4*)(buf + (i * 256 + tid) * 16) = stg[i];
    __syncthreads();
    f32x4 ucur[4];
#pragma unroll
    for (int ct = 0; ct < 4; ++ct) ucur[ct] = u[ct];
    const float glcur = gl;
    if (n + 1 < 64) {
      const u16* src = AMg + (size_t)(n + 1) * 16384;
#pragma unroll
      for (int i = 0; i < 8; ++i) stg[i] = *(const u32x4*)(src + (size_t)(i * 256 + tid) * 8);
      const float* un = U + (size_t)(n + 1) * 4096;
#pragma unroll
      for (int ct = 0; ct < 4; ++ct) u[ct] = *(const f32x4*)(un + (size_t)(16 * w + col) * 64 + 16 * ct + 4 * q);
      gl = GL[n + 1];
    }
    bf16x8 bS[2];
#pragma unroll
    for (int ks = 0; ks < 2; ++ks)
      bS[ks] = pack8(S[2 * ks][0], S[2 * ks][1], S[2 * ks][2], S[2 * ks][3], S[2 * ks + 1][0], S[2 * ks + 1][1], S[2 * ks + 1][2], S[2 * ks + 1][3]);
#define AFRAG(mat, rt, ks) (*(const bf16x8*)(buf + (mat) * 8192 + (((rt) * 2 + (ks)) * 64 + lane) * 16))
    f32x4 vn[4], o[4];
#pragma unroll
    for (int ct = 0; ct < 4; ++ct) {
      f32x4 a = f32x4{0.f, 0.f, 0.f, 0.f};
      a = mfma16(AFRAG(0, ct, 0), bS[0], a);
      a = mfma16(AFRAG(0, ct, 1), bS[1], a);
      vn[ct] = ucur[ct] - a;
      f32x4 oo = f32x4{0.f, 0.f, 0.f, 0.f};
      oo = mfma16(AFRAG(1, ct, 0), bS[0], oo);
      oo = mfma16(AFRAG(1, ct, 1), bS[1], oo);
      o[ct] = oo;
    }
    bf16x8 bV[2];
#pragma unroll
    for (int ks = 0; ks < 2; ++ks)
      bV[ks] = pack8(vn[2 * ks][0], vn[2 * ks][1], vn[2 * ks][2], vn[2 * ks][3], vn[2 * ks + 1][0], vn[2 * ks + 1][1], vn[2 * ks + 1][2], vn[2 * ks + 1][3]);
#pragma unroll
    for (int ct = 0; ct < 4; ++ct) {
      o[ct] = mfma16(AFRAG(2, ct, 0), bV[0], o[ct]);
      o[ct] = mfma16(AFRAG(2, ct, 1), bV[1], o[ct]);
      f32x4 sn = S[ct] * glcur;
      sn = mfma16(AFRAG(3, ct, 0), bV[0], sn);
      sn = mfma16(AFRAG(3, ct, 1), bV[1], sn);
      S[ct] = sn;
    }
#undef AFRAG
    float* od = O + ((size_t)b * SEQ + n * 64) * 512 + hd * 64 + 16 * w + col;
#pragma unroll
    for (int ct = 0; ct < 4; ++ct)
#pragma unroll
      for (int rg = 0; rg < 4; ++rg) od[(size_t)(16 * ct + 4 * q + rg) * 512] = o[ct][rg];
  }
  asm volatile("s_waitcnt vmcnt(0)" ::: "memory");
  __syncthreads();
  {
    u16* Z = (u16*)(ws + OFF_Z);
    const int sub = tid & 15;
    const f32x4 gw = ((const f32x4*)p.gdn_norm)[sub];
    for (int tk = tid >> 4; tk < SEQ; tk += 16) {
      const size_t gi = ((size_t)b * SEQ + tk) * 8 + hd;
      f32x4 v = *(const f32x4*)(O + gi * 64 + sub * 4);
      float ss = v[0] * v[0] + v[1] * v[1] + v[2] * v[2] + v[3] * v[3];
      ss += __shfl_xor(ss, 1); ss += __shfl_xor(ss, 2); ss += __shfl_xor(ss, 4); ss += __shfl_xor(ss, 8);
      const float rs = rsqrtf(ss * (1.f / 64.f) + 1e-6f);
      const u32x2 zz = *(const u32x2*)(Z + gi * 64 + sub * 4);
      const float z0 = bflo(zz[0]), z1 = bfhi(zz[0]), z2 = bflo(zz[1]), z3 = bfhi(zz[1]);
      u32x2 ov;
      ov[0] = pack2(v[0] * rs * gw[0] * (z0 * sigmoidf_(z0)), v[1] * rs * gw[1] * (z1 * sigmoidf_(z1)));
      ov[1] = pack2(v[2] * rs * gw[2] * (z2 * sigmoidf_(z2)), v[3] * rs * gw[3] * (z3 * sigmoidf_(z3)));
      *(u32x2*)(Z + gi * 64 + sub * 4) = ov;
    }
  }
  __syncthreads();
}

DI void phase_gdn_post(const Params& p, int bid, int nblk) {
  char* ws = p.ws;
  const float* O = (const float*)(ws + OFF_QKV);
  const u16* Z = (const u16*)(ws + OFF_Z);
  u16* OA = (u16*)(ws + OFF_NQ);
  const int sub = tidx() & 15;
  const f32x4 gw = ((const f32x4*)p.gdn_norm)[sub];
  const size_t ngrp = (size_t)NTOK * 8;
  for (size_t gi = ((size_t)bid * NTHREADS + tidx()) >> 4; gi < ngrp; gi += ((size_t)nblk * NTHREADS) >> 4) {
    f32x4 v = *(const f32x4*)(O + gi * 64 + sub * 4);
    float ss = v[0] * v[0] + v[1] * v[1] + v[2] * v[2] + v[3] * v[3];
    ss += __shfl_xor(ss, 1); ss += __shfl_xor(ss, 2); ss += __shfl_xor(ss, 4); ss += __shfl_xor(ss, 8);
    float rs = rsqrtf(ss * (1.f / 64.f) + 1e-6f);
    u32x2 zz = *(const u32x2*)(Z + gi * 64 + sub * 4);
    float z0 = bflo(zz[0]), z1 = bfhi(zz[0]), z2 = bflo(zz[1]), z3 = bfhi(zz[1]);
    u32x2 o;
    o[0] = pack2(v[0] * rs * gw[0] * (z0 * sigmoidf_(z0)), v[1] * rs * gw[1] * (z1 * sigmoidf_(z1)));
    o[1] = pack2(v[2] * rs * gw[2] * (z2 * sigmoidf_(z2)), v[3] * rs * gw[3] * (z3 * sigmoidf_(z3)));
    *(u32x2*)(OA + gi * 64 + sub * 4) = o;
  }
}

constexpr float NEGBIG = -1e30f;
constexpr float QK_SCALE = 0.125f * L2E;

DI float fexp2(float x) { return __builtin_amdgcn_exp2f(x); }
DI float xhalf_max(float x) {
  auto r = __builtin_amdgcn_permlane32_swap(__float_as_uint(x), __float_as_uint(x), false, false);
  return fmaxf(__uint_as_float(r[0]), __uint_as_float(r[1]));
}
DI float xhalf_sum(float x) {
  auto r = __builtin_amdgcn_permlane32_swap(__float_as_uint(x), __float_as_uint(x), false, false);
  return __uint_as_float(r[0]) + __uint_as_float(r[1]);
}

template <int MODE, bool SLOW>
DI void nsa_tile(const char* Kt, const char* Vt, const char* Qw, f32x16 (&O)[2], float& m, float& l,
                 const int t, const int key0, const bool lane_sel, const float* tab, const float c31,
                 const float mfin, const float linv, float* impw) {
  const int lane = tidx() & 63, r = lane & 31, h = lane >> 5;
#pragma unroll
  for (int a = 0; a < 2; ++a) {
    f32x16 S;
#pragma unroll
    for (int k = 0; k < 16; ++k) S[k] = 0.f;
#pragma unroll
    for (int s = 0; s < 4; ++s) S = mfma32(pad_frag(Kt, 32 * a + r, 2 * s + h), *(const bf16x8*)(Qw + (s * 64 + lane) * 16), S);
    if (!SLOW) {
      const float cb = (MODE == 2 && !lane_sel) ? NEGBIG : c31;
      float mxr = fmaxf(fmaxf(S[0], S[1]), fmaxf(S[2], S[3]));
#pragma unroll
      for (int k = 4; k < 16; k += 4) mxr = fmaxf(mxr, fmaxf(fmaxf(S[k], S[k + 1]), fmaxf(S[k + 2], S[k + 3])));
      const float mx = xhalf_max(fmaf(mxr, QK_SCALE, cb));
      const float mn = fmaxf(m, mx);
      const float alpha = fexp2(m - mn);
      const float cbm = cb - mn;
      float ps = 0.f;
#pragma unroll
      for (int k = 0; k < 16; ++k) { S[k] = fexp2(fmaf(S[k], QK_SCALE, cbm)); ps += S[k]; }
      l = l * alpha + ps;
      m = mn;
#pragma unroll
      for (int dt = 0; dt < 2; ++dt)
#pragma unroll
        for (int k = 0; k < 16; ++k) O[dt][k] *= alpha;
    } else {
#pragma unroll
      for (int k = 0; k < 16; ++k) {
        const int kl = 32 * a + (k & 3) + 8 * (k >> 2) + 4 * h;
        int dist;
        if (MODE < 2) dist = t - (16 * (key0 + kl) + 31); else dist = t - (key0 + kl);
        bool valid = (dist >= 0) && lane_sel;
        if (MODE == 3) valid = valid && (dist < 512);
        const int di = min(max(dist, 0), 128);
        const float bias = tab[di];
        S[k] = valid ? fmaf(S[k], QK_SCALE, bias) : NEGBIG;
      }
    if (MODE == 1) {
#pragma unroll
      for (int k = 0; k < 16; ++k) S[k] = (S[k] > -1e29f) ? fexp2(S[k] - mfin) * linv : 0.f;
    } else {
      float mx = fmaxf(fmaxf(S[0], S[1]), fmaxf(S[2], S[3]));
#pragma unroll
      for (int k = 4; k < 16; k += 4) mx = fmaxf(mx, fmaxf(fmaxf(S[k], S[k + 1]), fmaxf(S[k + 2], S[k + 3])));
      mx = xhalf_max(mx);
      const float mn = fmaxf(m, mx);
      const float alpha = fexp2(m - mn);
      float ps = 0.f;
#pragma unroll
      for (int k = 0; k < 16; ++k) { S[k] = (S[k] > -1e29f) ? fexp2(S[k] - mn) : 0.f; ps += S[k]; }
      l = l * alpha + ps;
      m = mn;
      if (MODE != 0) {
#pragma unroll
        for (int dt = 0; dt < 2; ++dt)
#pragma unroll
          for (int k = 0; k < 16; ++k) O[dt][k] *= alpha;
      }
    }
    }
    if (MODE == 1) {
#pragma unroll
      for (int g4 = 0; g4 < 4; ++g4) {
        float mainv = S[4 * g4] + S[4 * g4 + 1] + S[4 * g4 + 2] + 0.5f * S[4 * g4 + 3];
        float spill = 0.5f * S[4 * g4 + 3];
        mainv += __shfl_xor(mainv, 8); mainv += __shfl_xor(mainv, 16);
        spill += __shfl_xor(spill, 8); spill += __shfl_xor(spill, 16);
        const int blk = ((key0 + 32 * a) >> 2) + 2 * g4 + h;
        if (r < 8) { atomicAdd(&impw[r * 68 + blk], mainv); atomicAdd(&impw[r * 68 + blk + 1], spill); }
      }
    }
    if (MODE != 0) {
      bf16x8 P0 = pack8(S[0], S[1], S[2], S[3], S[4], S[5], S[6], S[7]);
      bf16x8 P1 = pack8(S[8], S[9], S[10], S[11], S[12], S[13], S[14], S[15]);
#pragma unroll
      for (int dt = 0; dt < 2; ++dt) {
        O[dt] = mfma32(pad_frag(Vt, 32 * dt + r, 4 * a + h), P0, O[dt]);
        O[dt] = mfma32(pad_frag(Vt, 32 * dt + r, 4 * a + 2 + h), P1, O[dt]);
      }
    }
  }
}

struct NsaSrc { const u16* k; long kld; const u16* v; long vld; };

constexpr int NSA_BUF = 18432;
constexpr int NSA_LDS_BIAS = 2 * NSA_BUF, NSA_LDS_IMP = NSA_LDS_BIAS + 8 * 132 * 4, NSA_LDS_Q = NSA_LDS_IMP + 4 * 8 * 68 * 4;

DI void nsa_item(const Params& p, const int bg, const int hq, char* smem) {
  char* ws = p.ws;
  const int tid = tidx(), lane = tid & 63, w = tid >> 6, r = lane & 31, h = lane >> 5;
  const int b = bg >> 1, g = bg & 1, qi = hq >> 1;
  const int t = 32 * hq + 8 * w + (r & 7);
  const int head = g * 4 + (r >> 3);
  const size_t trow = (size_t)b * SEQ + t;
  float* biasl = (float*)(smem + NSA_LDS_BIAS);
  float* impw = (float*)(smem + NSA_LDS_IMP) + w * (8 * 68);
  char* Q = smem + NSA_LDS_Q + w * 4096;
  const u16* NKV = (const u16*)(ws + OFF_NKV);
  __syncthreads();
  for (int i = tid; i < 8 * 132; i += NTHREADS) biasl[i] = ((const float*)(ws + OFF_MISC + MISC_BIAS))[i];
  for (int i = lane; i < 8 * 68; i += 64) impw[i] = 0.f;
  {
    const u16* NQ = (const u16*)(ws + OFF_NQ);
#pragma unroll
    for (int s = 0; s < 4; ++s) *(bf16x8*)(Q + (s * 64 + lane) * 16) = *(const bf16x8*)(NQ + trow * 512 + head * 64 + 16 * s + 8 * h);
  }
  const float* tab = biasl + head * 132;
  f32x16 O[2];
  float m, l, mfin = 0.f, linv = 0.f;
  u16* OB = (u16*)(ws + OFF_QKV + (size_t)NTOK * 512 * 4);
  auto reset = [&]() {
#pragma unroll
    for (int dt = 0; dt < 2; ++dt)
#pragma unroll
      for (int k = 0; k < 16; ++k) O[dt][k] = 0.f;
    m = NEGBIG; l = 0.f;
  };
  u32x4 sk[2], sv[2];
  auto stage_load = [&](const NsaSrc& s) {
#pragma unroll
    for (int i = 0; i < 2; ++i) {
      const int c = tid + 256 * i, row = c >> 3, ch = c & 7;
      sk[i] = *(const u32x4*)(s.k + (size_t)row * s.kld + ch * 8);
      sv[i] = *(const u32x4*)(s.v + (size_t)row * s.vld + ch * 8);
    }
  };
  auto stage_store = [&](char* buf) {
#pragma unroll
    for (int i = 0; i < 2; ++i) {
      const int c = tid + 256 * i, row = c >> 3, ch = c & 7;
      *(u32x4*)(buf + row * 144 + ch * 16) = sk[i];
      *(u32x4*)(buf + 9216 + row * 144 + ch * 16) = sv[i];
    }
  };
  auto src_cmp = [&](int tt) { NsaSrc s; s.k = (const u16*)(ws + OFF_KC) + ((size_t)bg * 256 + 64 * tt) * 64; s.kld = 64;
                               s.v = (const u16*)(ws + OFF_VCT) + (size_t)bg * 64 * 256 + 64 * tt; s.vld = 256; return s; };
  auto src_slc = [&](int j) { NsaSrc s; s.k = NKV + ((size_t)b * SEQ + 64 * j) * 768 + 256 + g * 64; s.kld = 768;
                              s.v = (const u16*)(ws + OFF_VST) + (size_t)bg * 64 * 4096 + 64 * j; s.vld = 4096; return s; };
  auto src_win = [&](int j) { NsaSrc s; s.k = NKV + ((size_t)b * SEQ + 64 * j) * 768 + 512 + g * 64; s.kld = 768;
                              s.v = (const u16*)(ws + OFF_VWT) + (size_t)bg * 64 * 4096 + 64 * j; s.vld = 4096; return s; };
  auto gatev = [&](int br) { return sigmoidf_(((const float*)(ws + OFF_SM))[trow * 40 + 16 + head * 3 + br]); };
  auto emit = [&](const float wgt, bool first) {
#pragma unroll
    for (int dt = 0; dt < 2; ++dt)
#pragma unroll
      for (int g4 = 0; g4 < 4; ++g4) {
        u16* dst = OB + trow * 512 + head * 64 + 32 * dt + 8 * g4 + 4 * h;
        float v0 = O[dt][4 * g4] * wgt, v1 = O[dt][4 * g4 + 1] * wgt, v2 = O[dt][4 * g4 + 2] * wgt, v3 = O[dt][4 * g4 + 3] * wgt;
        if (!first) {
          u32x2 old = *(const u32x2*)dst;
          v0 += bflo(old[0]); v1 += bfhi(old[0]); v2 += bflo(old[1]); v3 += bfhi(old[1]);
        }
        u32x2 o; o[0] = pack2(v0, v1); o[1] = pack2(v2, v3);
        *(u32x2*)dst = o;
      }
  };
  int it = 0;
  stage_load(src_cmp(0));
  stage_store(smem);
  __syncthreads();
  const float c31 = tab[128];
#define NSA_STEP(CALL, HAS_NEXT, NEXT_SRC) { \
    const bool hn_ = (HAS_NEXT); if (hn_) stage_load(NEXT_SRC); \
    { const char* Kt = smem + (it & 1) * NSA_BUF; const char* Vt = Kt + 9216; CALL; } \
    if (hn_) stage_store(smem + ((it + 1) & 1) * NSA_BUF); \
    __syncthreads(); ++it; }

  const int ntc = (2 * hq + 1 + 63) >> 6;
  reset();
  for (int tt = 0; tt < ntc; ++tt)
    NSA_STEP((nsa_tile<0, true>(Kt, Vt, Q, O, m, l, t, 64 * tt, true, tab, c31, mfin, linv, impw)), true, (tt + 1 < ntc) ? src_cmp(tt + 1) : src_cmp(0));
  { float lt = xhalf_sum(l); mfin = m; linv = lt > 0.f ? 1.f / lt : 0.f; }
  for (int tt = 0; tt < ntc; ++tt)
    NSA_STEP((nsa_tile<1, true>(Kt, Vt, Q, O, m, l, t, 64 * tt, true, tab, c31, mfin, linv, impw)), true, (tt + 1 < ntc) ? src_cmp(tt + 1) : src_slc(0));
  emit(gatev(0), true);
  unsigned sel_lo, sel_hi;
  if (qi < 16) {
    unsigned long long mk = (2ull << qi) - 1ull;
    sel_lo = (unsigned)mk; sel_hi = (unsigned)(mk >> 32);
  } else {
    unsigned long long mk = 0ull;
    const float* row = impw + (lane & 7) * 68;
    const int part = lane >> 3, hiM = qi - 2;
    for (int mm = 1 + part; mm <= hiM; mm += 8) {
      const float v = row[mm];
      int rank = 0;
      for (int m2 = 1; m2 <= hiM; ++m2) { const float u = row[m2]; rank += ((u > v) || (u == v && m2 < mm)) ? 1 : 0; }
      if (rank < 13) mk |= 1ull << mm;
    }
    mk |= 1ull | (1ull << qi) | (1ull << (qi - 1));
    sel_lo = (unsigned)mk; sel_hi = (unsigned)(mk >> 32);
    sel_lo |= __shfl_xor(sel_lo, 8); sel_hi |= __shfl_xor(sel_hi, 8);
    sel_lo |= __shfl_xor(sel_lo, 16); sel_hi |= __shfl_xor(sel_hi, 16);
    sel_lo |= __shfl_xor(sel_lo, 32); sel_hi |= __shfl_xor(sel_hi, 32);
  }
  reset();
  const int j0 = qi >= 8 ? qi - 8 : 0;
  for (int j = 0; j <= qi; ++j) {
    const bool lsel = ((j < 32 ? (sel_lo >> j) : (sel_hi >> (j - 32))) & 1u) != 0u;
    if (qi - j <= 2) {
      NSA_STEP((nsa_tile<2, true>(Kt, Vt, Q, O, m, l, t, 64 * j, lsel, tab, c31, mfin, linv, impw)), true, (j < qi) ? src_slc(j + 1) : src_win(j0));
    } else {
      NSA_STEP((nsa_tile<2, false>(Kt, Vt, Q, O, m, l, t, 64 * j, lsel, tab, c31, mfin, linv, impw)), true, src_slc(j + 1));
    }
  }
  { float lt = xhalf_sum(l); emit(lt > 0.f ? gatev(1) / lt : 0.f, false); }
  reset();
  for (int j = j0; j <= qi; ++j) {
    if ((qi - j <= 2) || (qi - j == 8)) {
      NSA_STEP((nsa_tile<3, true>(Kt, Vt, Q, O, m, l, t, 64 * j, true, tab, c31, mfin, linv, impw)), j < qi, src_win(j + 1));
    } else {
      NSA_STEP((nsa_tile<3, false>(Kt, Vt, Q, O, m, l, t, 64 * j, true, tab, c31, mfin, linv, impw)), true, src_win(j + 1));
    }
  }
#undef NSA_STEP
  { float lt = xhalf_sum(l); emit(lt > 0.f ? gatev(2) / lt : 0.f, false); }
}

DI void phase4(const Params& p, char* smem, int cidx = 0) {
  unsigned* cnt = (unsigned*)(p.ws + OFF_MISC + MISC_CNT) + cidx;
  __shared__ int s_item;
  for (;;) {
    __syncthreads();
    if (tidx() == 0) s_item = (int)atomicAdd(cnt, 1u);
    __syncthreads();
    const int it = __builtin_amdgcn_readfirstlane(s_item);
    if (it >= 64 + 2048) break;
    if (it < 64) { if (cidx != 2) gdn_scan_item(p, it, smem); }
    else if (cidx != 1) { const int k = it - 64; nsa_item(p, k & 15, 127 - (k >> 4), smem); }
  }
}

DI void phase_branch(const Params& p, int bid, int nblk, char* smem) {
  char* ws = p.ws;
  const u16* OA = (const u16*)(ws + OFF_Z);
  const u16* OB = (const u16*)(ws + OFF_QKV + (size_t)NTOK * 512 * 4);
  const u16* MG = (const u16*)(ws + OFF_MG);
  u16* MIX = (u16*)(ws + OFF_RH);
  for (int k = 0;; ++k) {
    int mt, nt;
    if (!xcd_tile(k, bid, nblk, 256, 8, mt, nt)) break;
    const int m0 = mt * 128, n0 = nt * 128;
    GemmPtrs g;
    f32x16 acc[2][2];
    gemm_setup(g, OA, 512, m0, (const u16*)(ws + OFF_WAT), 512, n0);
    zero_acc(acc);
    gemm_kloop(acc, g, 8, smem);
    gemm_epilogue_lds(acc, smem, [&](int ml, int nl, const float (&v)[8]) {
      const size_t m = m0 + ml; const int n = n0 + nl;
      const u32x4 gt = *(const u32x4*)(MG + m * 2048 + n);
      float t[8];
#pragma unroll
      for (int e = 0; e < 4; ++e) { t[2 * e] = v[2 * e] * sigmoidf_(bflo(gt[e])); t[2 * e + 1] = v[2 * e + 1] * sigmoidf_(bfhi(gt[e])); }
      *(u32x4*)(MIX + m * 1024 + n) = pack8u(t);
    });
    gemm_setup(g, OB, 512, m0, (const u16*)(ws + OFF_WBT), 512, n0);
    zero_acc(acc);
    gemm_kloop(acc, g, 8, smem);
    gemm_epilogue_lds(acc, smem, [&](int ml, int nl, const float (&v)[8]) {
      const size_t m = m0 + ml; const int n = n0 + nl;
      const u32x4 gt = *(const u32x4*)(MG + m * 2048 + 1024 + n);
      const u32x4 old = *(const u32x4*)(MIX + m * 1024 + n);
      float t[8];
#pragma unroll
      for (int e = 0; e < 4; ++e) {
        t[2 * e] = bflo(old[e]) + v[2 * e] * sigmoidf_(bflo(gt[e]));
        t[2 * e + 1] = bfhi(old[e]) + v[2 * e + 1] * sigmoidf_(bfhi(gt[e]));
      }
      *(u32x4*)(MIX + m * 1024 + n) = pack8u(t);
    });
  }
}

DI void phase_outproj(const Params& p, int bid, int nblk, char* smem) {
  char* ws = p.ws;
  const u16* MIX = (const u16*)(ws + OFF_RH);
  for (int k = 0;; ++k) {
    int mt, nt;
    if (!xcd_tile(k, bid, nblk, 256, 8, mt, nt)) break;
    const int m0 = mt * 128, n0 = nt * 128;
    GemmPtrs g;
    f32x16 acc[2][2];
    gemm_setup(g, MIX, 1024, m0, (const u16*)(ws + OFF_WOT), 1024, n0);
    zero_acc(acc);
    gemm_kloop(acc, g, 16, smem);
    gemm_epilogue_lds(acc, smem, [&](int ml, int nl, const float (&v)[8]) {
      const size_t idx = (size_t)(m0 + ml) * 1024 + n0 + nl;
      const f32x4 x0 = *(const f32x4*)(p.x + idx), x1 = *(const f32x4*)(p.x + idx + 4);
      float* X1 = (float*)(ws + OFF_QKV);
      *(f32x4*)(X1 + idx) = f32x4{x0[0] + v[0], x0[1] + v[1], x0[2] + v[2], x0[3] + v[3]};
      *(f32x4*)(X1 + idx + 4) = f32x4{x1[0] + v[4], x1[1] + v[5], x1[2] + v[6], x1[3] + v[7]};
    });
  }
}

DI void phase_query(const Params& p, int bid, int nblk, char* smem) {
  char* ws = p.ws;
  const u16* H2 = (const u16*)(ws + OFF_RH);
  u16* QRY = (u16*)(ws + OFF_MG);
  for (int k = 0;; ++k) {
    int mt, nt;
    if (!xcd_tile(k, bid, nblk, 256, 16, mt, nt)) break;
    const int m0 = mt * 128, n0 = nt * 128;
    GemmPtrs g;
    f32x16 acc[2][2];
    gemm_setup(g, H2, 1024, m0, (const u16*)(ws + OFF_WQT), 1024, n0);
    zero_acc(acc);
    gemm_kloop(acc, g, 16, smem);
    gemm_epilogue_lds(acc, smem, [&](int ml, int nl, const float (&v)[8]) { *(u32x4*)(QRY + (size_t)(m0 + ml) * 2048 + n0 + nl) = pack8u(v); });
  }
}

DI unsigned f2ord(float f) { unsigned u = __float_as_uint(f); return (u & 0x80000000u) ? ~u : (u | 0x80000000u); }
DI float ord2f(unsigned o) { unsigned u = (o & 0x80000000u) ? (o & 0x7fffffffu) : ~o; return __uint_as_float(u); }

DI void peer_route_job(const Params& p, int job, char* smem) {
  char* ws = p.ws;
  const int mt = job >> 3, hd = job & 7, m0 = mt * 128;
  const u16* QRY = (const u16*)(ws + OFF_MG);
  const u16* SK = (const u16*)(ws + OFF_SK);
  unsigned* keys = (unsigned*)smem;
  unsigned char* idxs = (unsigned char*)(smem + 66048);
  const int tid = tidx() + opaque0();
  const int row = tid >> 1, half = tid & 1;
  float v1[16], v2[16];
#pragma unroll
  for (int pp = 0; pp < 2; ++pp) {
    GemmPtrs g;
    f32x16 acc[2][2];
    gemm_setup(g, QRY + (hd * 2 + pp) * 128, 2048, m0, SK + (size_t)(hd * 2 + pp) * 128 * 128, 128, 0);
    zero_acc(acc);
    gemm_kloop(acc, g, 2, smem);
    gemm_epilogue(acc, [&](int ml, int nl, float v) { keys[ml * 129 + nl] = (f2ord(v) & ~127u) | (unsigned)(127 - nl); });
    __syncthreads();
    {
      const unsigned* rp = keys + row * 129 + half * 64;
      unsigned prev = 0xffffffffu;
#pragma unroll
      for (int rd = 0; rd < 16; ++rd) {
        unsigned best = 0u;
#pragma unroll 4
        for (int j = 0; j < 64; ++j) { unsigned k = rp[j]; k = (k < prev) ? k : 0u; best = (k > best) ? k : best; }
        const unsigned other = (unsigned)__shfl_xor((int)best, 1);
        best = best > other ? best : other;
        prev = best;
        const float val = ord2f(best & ~127u);
        if (pp == 0) v1[rd] = val; else v2[rd] = val;
        if (half == 0) idxs[row * 32 + pp * 16 + rd] = (unsigned char)(127u - (best & 127u));
      }
    }
    __syncthreads();
  }
  unsigned ck[25];
  {
    constexpr int CI[50] = {0,0,0,0,0,0,0,0,0,0,0,0,0,0,0,0, 1,1,1,1,1,1,1,1, 2,2,2,2,2, 3,3,3,3, 4,4,4, 5,5, 6,6, 7,7, 8, 9, 10, 11, 12, 13, 14, 15};
    constexpr int CJ[50] = {0,1,2,3,4,5,6,7,8,9,10,11,12,13,14,15, 0,1,2,3,4,5,6,7, 0,1,2,3,4, 0,1,2,3, 0,1,2, 0,1, 0,1, 0,1, 0, 0, 0, 0, 0, 0, 0, 0};
#pragma unroll
    for (int c = 0; c < 25; ++c) {
      const float a = half ? v1[CI[2 * c + 1]] : v1[CI[2 * c]];
      const float b = half ? v2[CJ[2 * c + 1]] : v2[CJ[2 * c]];
      const int fl = half ? (16 * CI[2 * c + 1] + CJ[2 * c + 1]) : (16 * CI[2 * c] + CJ[2 * c]);
      ck[c] = (f2ord(a + b) & ~255u) | (unsigned)(255 - fl);
    }
  }
  int* EI = (int*)(ws + OFF_NQ) + ((size_t)(m0 + row) * 128 + hd * 16);
  float* GT = (float*)(ws + OFF_NKV) + ((size_t)(m0 + row) * 128 + hd * 16);
  float selv[16];
  unsigned prev = 0xffffffffu;
#pragma unroll
  for (int rd = 0; rd < 16; ++rd) {
    unsigned best = 0u;
#pragma unroll
    for (int c = 0; c < 25; ++c) { unsigned k = (ck[c] < prev) ? ck[c] : 0u; best = (k > best) ? k : best; }
    const unsigned other = (unsigned)__shfl_xor((int)best, 1);
    best = best > other ? best : other;
    prev = best;
    const int flat = 255 - (int)(best & 255u);
    selv[rd] = ord2f(best & ~255u);
    if (half == 0) EI[rd] = (int)idxs[row * 32 + (flat >> 4)] * 128 + (int)idxs[row * 32 + 16 + (flat & 15)];
  }
  float sum = 0.f;
  const float mx = selv[0];
#pragma unroll
  for (int k = 0; k < 16; ++k) { selv[k] = __expf(selv[k] - mx); sum += selv[k]; }
  const float inv = 1.f / sum;
  if (half == 0) {
#pragma unroll
    for (int k = 0; k < 16; ++k) GT[k] = selv[k] * inv;
  }
}

DI float gelu_tanh(float x) {
  const float u = 0.7978845608028654f * (x + 0.044715f * x * x * x);
  const float e = __expf(2.f * u);
  const float th = 1.f - 2.f / (e + 1.f);
  return 0.5f * x * (1.f + th);
}
DI void peer_expert_phase(const Params& p, int bid, int nblk) {
  char* ws = p.ws;
  const int lane = tidx() & 63, wv = tidx() >> 6;
  const unsigned char* EU = (const unsigned char*)(ws + OFF_EU);
  const unsigned char* EV = (const unsigned char*)(ws + OFF_EV);
  const float* SCU = (const float*)(ws + OFF_MISC + MISC_SCU);
  const float* SCV = (const float*)(ws + OFF_MISC + MISC_SCV);
  const int* EI = (const int*)(ws + OFF_NQ);
  const float* GT = (const float*)(ws + OFF_NKV);
  for (int tok = bid * 4 + wv; tok < NTOK; tok += nblk * 4) {
    const float* xr = (const float*)(ws + OFF_QKV) + (size_t)tok * 1024 + 16 * lane;
    f32x4 xa[4];
    float ss = 0.f;
#pragma unroll
    for (int i = 0; i < 4; ++i) { xa[i] = *(const f32x4*)(xr + 4 * i); ss += xa[i][0] * xa[i][0] + xa[i][1] * xa[i][1] + xa[i][2] * xa[i][2] + xa[i][3] * xa[i][3]; }
    ss = wave_sum(ss);
    const float rs = rsqrtf(ss * (1.f / 1024.f) + 1e-6f);
    f32x2 h2[8];
#pragma unroll
    for (int i = 0; i < 4; ++i) {
      const f32x4 w4 = *(const f32x4*)(p.norm_ffn + 16 * lane + 4 * i);
      h2[2 * i] = f32x2{bf2f(f2bf(xa[i][0] * rs * w4[0])), bf2f(f2bf(xa[i][1] * rs * w4[1]))};
      h2[2 * i + 1] = f32x2{bf2f(f2bf(xa[i][2] * rs * w4[2])), bf2f(f2bf(xa[i][3] * rs * w4[3]))};
    }
    f32x2 outv[8];
#pragma unroll
    for (int i = 0; i < 8; ++i) outv[i] = f32x2{0.f, 0.f};
#pragma unroll 1
    for (int bt = 0; bt < 2; ++bt) {
      const int eidx = EI[(size_t)tok * 128 + bt * 64 + lane];
      const float gt = GT[(size_t)tok * 128 + bt * 64 + lane];
      const float su = SCU[eidx], sv = SCV[eidx];
      float acc[64];
      {
        u32x4 cur[8], nxt[8];
#pragma unroll
        for (int j = 0; j < 8; ++j) cur[j] = *(const u32x4*)(EU + (size_t)__builtin_amdgcn_readlane(eidx, j) * 1024 + 16 * lane);
#pragma unroll
        for (int g = 0; g < 8; ++g) {
          if (g < 7) {
#pragma unroll
            for (int j = 0; j < 8; ++j) nxt[j] = *(const u32x4*)(EU + (size_t)__builtin_amdgcn_readlane(eidx, 8 * (g + 1) + j) * 1024 + 16 * lane);
          }
#pragma unroll
          for (int j = 0; j < 8; ++j) {
            f32x2 d = f32x2{0.f, 0.f};
#pragma unroll
            for (int i = 0; i < 4; ++i) {
              d += __builtin_amdgcn_cvt_pk_f32_fp8(cur[j][i], false) * h2[2 * i];
              d += __builtin_amdgcn_cvt_pk_f32_fp8(cur[j][i], true) * h2[2 * i + 1];
            }
            acc[8 * g + j] = d[0] + d[1];
          }
#pragma unroll
          for (int j = 0; j < 8; ++j) cur[j] = nxt[j];
        }
      }
#pragma unroll
      for (int st = 0; st < 6; ++st) {
        const int half = 32 >> st;
        const bool up = (lane & half) != 0;
#pragma unroll
        for (int k = 0; k < half; ++k) {
          const float send = up ? acc[k] : acc[k + half];
          const float keep = up ? acc[k + half] : acc[k];
          acc[k] = keep + __shfl_xor(send, half);
        }
      }
      const float wgt = gt * gelu_tanh(acc[0] * su) * sv;
      {
        u32x4 cur[8], nxt[8];
#pragma unroll
        for (int j = 0; j < 8; ++j) cur[j] = *(const u32x4*)(EV + (size_t)__builtin_amdgcn_readlane(eidx, j) * 1024 + 16 * lane);
#pragma unroll
        for (int g = 0; g < 8; ++g) {
          if (g < 7) {
#pragma unroll
            for (int j = 0; j < 8; ++j) nxt[j] = *(const u32x4*)(EV + (size_t)__builtin_amdgcn_readlane(eidx, 8 * (g + 1) + j) * 1024 + 16 * lane);
          }
#pragma unroll
          for (int j = 0; j < 8; ++j) {
            const float we = __uint_as_float((unsigned)__builtin_amdgcn_readlane((int)__float_as_uint(wgt), 8 * g + j));
            const f32x2 w2 = f32x2{we, we};
#pragma unroll
            for (int i = 0; i < 4; ++i) {
              outv[2 * i] += __builtin_amdgcn_cvt_pk_f32_fp8(cur[j][i], false) * w2;
              outv[2 * i + 1] += __builtin_amdgcn_cvt_pk_f32_fp8(cur[j][i], true) * w2;
            }
          }
#pragma unroll
          for (int j = 0; j < 8; ++j) cur[j] = nxt[j];
        }
      }
    }
    float s2 = 0.f;
#pragma unroll
    for (int i = 0; i < 4; ++i) {
      xa[i][0] += outv[2 * i][0]; xa[i][1] += outv[2 * i][1]; xa[i][2] += outv[2 * i + 1][0]; xa[i][3] += outv[2 * i + 1][1];
      s2 += xa[i][0] * xa[i][0] + xa[i][1] * xa[i][1] + xa[i][2] * xa[i][2] + xa[i][3] * xa[i][3];
    }
    s2 = wave_sum(s2);
    const float r2 = rsqrtf(s2 * (1.f / 1024.f) + 1e-6f);
    float* orow = p.out + (size_t)tok * 1024 + 16 * lane;
#pragma unroll
    for (int i = 0; i < 4; ++i) {
      const f32x4 nw = *(const f32x4*)(p.norm_final + 16 * lane + 4 * i);
      *(f32x4*)(orow + 4 * i) = f32x4{xa[i][0] * r2 * nw[0], xa[i][1] * r2 * nw[1], xa[i][2] * r2 * nw[2], xa[i][3] * r2 * nw[3]};
    }
  }
}

#ifndef MK_SINGLE
#define MK_SINGLE 1
#endif
#define SMEM_DECL __shared__ __attribute__((aligned(16))) char smem[SMEM_BYTES]

DI void run_phase(const Params& p, int ph, int bid, int nblk, char* smem) {
  switch (ph) {
    case 0: phase0(p, bid, nblk, smem); break;
    case 1: phase_inproj(p, bid, nblk, smem); break;
    case 2: phase2(p, bid, nblk, smem); break;
    case 3: phase4(p, smem); break;
    case 4: phase_branch(p, bid, nblk, smem); break;
    case 5: phase_outproj(p, bid, nblk, smem); break;
    case 6: rmsnorm_rows_bf16((const float*)(p.ws + OFF_QKV), p.norm_ffn, (u16*)(p.ws + OFF_RH), NTOK, bid, nblk); break;
    case 7: phase_query(p, bid, nblk, smem); break;
    case 8: for (int j = bid; j < 2048; j += nblk) peer_route_job(p, j, smem); break;
    case 9: peer_expert_phase(p, bid, nblk); break;
  }
}
constexpr int NPHASES = 10;

#if MK_SINGLE
DI void grid_barrier(unsigned* ctr, unsigned target) {
  asm volatile("s_waitcnt vmcnt(0)" ::: "memory");
  __syncthreads();
  if (tidx() == 0) {
    __builtin_amdgcn_fence(__ATOMIC_RELEASE, "agent");
    asm volatile("s_waitcnt vmcnt(0)" ::: "memory");
    __hip_atomic_fetch_add(ctr, 1u, __ATOMIC_RELAXED, __HIP_MEMORY_SCOPE_AGENT);
    while (__hip_atomic_load(ctr, __ATOMIC_RELAXED, __HIP_MEMORY_SCOPE_AGENT) < target) __builtin_amdgcn_s_sleep(2);
    __builtin_amdgcn_fence(__ATOMIC_ACQUIRE, "agent");
    asm volatile("s_waitcnt vmcnt(0)" ::: "memory");
  }
  __syncthreads();
}
#ifndef MK_PROBE_SPLIT
#define MK_PROBE_SPLIT 0
#endif
#ifndef PROBE_P4
#define PROBE_P4 203
#endif
#ifndef PROBE_REPEAT
#define PROBE_REPEAT 0
#endif
#if MK_PROBE_SPLIT
__global__ void __launch_bounds__(NTHREADS, 2) fwd_megakernel(Params p, int phase_sel) {
#else
__global__ void __launch_bounds__(NTHREADS, 2) fwd_megakernel(Params p) {
#endif
  SMEM_DECL;
  cg::grid_group grid = cg::this_grid();
  const int bid = blockIdx.x, nblk = gridDim.x;
  unsigned* bar = (unsigned*)(p.ws + OFF_MISC + MISC_CNT) + 8;
#if MK_PROBE_SPLIT
  switch (phase_sel) {
    case 0: run_phase(p, 0, bid, nblk, smem); break;
    case 1: run_phase(p, 1, bid, nblk, smem); break;
    case 2: run_phase(p, 2, bid, nblk, smem); break;
    case 3: run_phase(p, 3, bid, nblk, smem); break;
    case 103: phase4(p, smem, 1); break;
    case 203: phase4(p, smem, 2); break;
    case 4: run_phase(p, 4, bid, nblk, smem); break;
    case 5: run_phase(p, 5, bid, nblk, smem); break;
    case 6: run_phase(p, 6, bid, nblk, smem); break;
    case 7: run_phase(p, 7, bid, nblk, smem); break;
    case 8: run_phase(p, 8, bid, nblk, smem); break;
    default: run_phase(p, 9, bid, nblk, smem); break;
  }
  if (phase_sel < 0) { grid.sync(); grid_barrier(bar, 1u); }
#else
  run_phase(p, 0, bid, nblk, smem); grid.sync();
  run_phase(p, 1, bid, nblk, smem); grid_barrier(bar, 1u * nblk);
  run_phase(p, 2, bid, nblk, smem); grid_barrier(bar, 2u * nblk);
  run_phase(p, 3, bid, nblk, smem); grid_barrier(bar, 3u * nblk);
  run_phase(p, 4, bid, nblk, smem); grid_barrier(bar, 4u * nblk);
  run_phase(p, 5, bid, nblk, smem); grid_barrier(bar, 5u * nblk);
  run_phase(p, 6, bid, nblk, smem); grid_barrier(bar, 6u * nblk);
  run_phase(p, 7, bid, nblk, smem); grid_barrier(bar, 7u * nblk);
  run_phase(p, 8, bid, nblk, smem); grid_barrier(bar, 8u * nblk);
  run_phase(p, 9, bid, nblk, smem);
#endif
}
#else
template <int PH>
__global__ void __launch_bounds__(NTHREADS, 2) phase_kernel(Params p) {
  SMEM_DECL;
  run_phase(p, PH, blockIdx.x, gridDim.x, smem);
}
__global__ void __launch_bounds__(NTHREADS, 2) phase4_again(Params p) { SMEM_DECL; phase4(p, smem, 1); }
#ifndef REPEAT_MASK
#define REPEAT_MASK 0
#endif
#endif

extern "C" void kernel_launch(void* const* d_in, const int* in_sizes, int n_in, void* d_out, int out_size, void* d_ws, size_t ws_size,
                              hipStream_t stream) {
  Params p{};
  const float** f = (const float**)&p;
  for (int i = 0; i < 21; ++i) f[i] = (const float*)d_in[i];
  p.out = (float*)d_out;
  p.ws = (char*)d_ws;
  if (ws_size < WS_NEEDED) return;
#if MK_SINGLE
  static int grid_blocks = 0;
  if (!grid_blocks) {
    int dev = 0, cus = 0, per_cu = 0;
    hipGetDevice(&dev);
    hipDeviceGetAttribute(&cus, hipDeviceAttributeMultiprocessorCount, dev);
    hipOccupancyMaxActiveBlocksPerMultiprocessor(&per_cu, fwd_megakernel, NTHREADS, 0);
    if (per_cu > 2) per_cu = 2;
    grid_blocks = cus * per_cu;
  }
#if MK_PROBE_SPLIT
  for (int ph = 0; ph < NPHASES; ++ph) {
    fwd_megakernel<<<grid_blocks, NTHREADS, 0, stream>>>(p, ph);
    if ((PROBE_REPEAT >> ph) & 1) fwd_megakernel<<<grid_blocks, NTHREADS, 0, stream>>>(p, ph == 3 ? PROBE_P4 : ph);
  }
#else
  void* args[] = {&p};
  hipLaunchCooperativeKernel((void*)fwd_megakernel, dim3(grid_blocks), dim3(NTHREADS), args, 0, stream);
#endif
#else
  const int G = 512;
  phase_kernel<0><<<G, NTHREADS, 0, stream>>>(p);
#if REPEAT_MASK & (1 << 0)
  phase_kernel<0><<<G, NTHREADS, 0, stream>>>(p);
#endif
  phase_kernel<1><<<G, NTHREADS, 0, stream>>>(p);
#if REPEAT_MASK & (1 << 1)
  phase_kernel<1><<<G, NTHREADS, 0, stream>>>(p);
#endif
  phase_kernel<2><<<G, NTHREADS, 0, stream>>>(p);
#if REPEAT_MASK & (1 << 2)
  phase_kernel<2><<<G, NTHREADS, 0, stream>>>(p);
#endif
  phase_kernel<3><<<G, NTHREADS, 0, stream>>>(p);
#if REPEAT_MASK & (1 << 3)
  phase4_again<<<G, NTHREADS, 0, stream>>>(p);
#endif
  phase_kernel<4><<<G, NTHREADS, 0, stream>>>(p);
#if REPEAT_MASK & (1 << 4)
  phase_kernel<4><<<G, NTHREADS, 0, stream>>>(p);
#endif
  phase_kernel<5><<<G, NTHREADS, 0, stream>>>(p);
#if REPEAT_MASK & (1 << 5)
  phase_kernel<5><<<G, NTHREADS, 0, stream>>>(p);
#endif
  phase_kernel<6><<<G, NTHREADS, 0, stream>>>(p);
#if REPEAT_MASK & (1 << 6)
  phase_kernel<6><<<G, NTHREADS, 0, stream>>>(p);
#endif
  phase_kernel<7><<<G, NTHREADS, 0, stream>>>(p);
#if REPEAT_MASK & (1 << 7)
  phase_kernel<7><<<G, NTHREADS, 0, stream>>>(p);
#endif
  phase_kernel<8><<<G, NTHREADS, 0, stream>>>(p);
#if REPEAT_MASK & (1 << 8)
  phase_kernel<8><<<G, NTHREADS, 0, stream>>>(p);
#endif
  phase_kernel<9><<<G, NTHREADS, 0, stream>>>(p);
#if REPEAT_MASK & (1 << 9)
  phase_kernel<9><<<G, NTHREADS, 0, stream>>>(p);
#endif
#endif
}
```

```cpp
#include <hip/hip_runtime.h>
#include <hip/hip_cooperative_groups.h>
#include <stdint.h>
namespace cg = cooperative_groups;

#define DI __device__ __forceinline__
typedef unsigned short u16;
typedef __attribute__((ext_vector_type(8))) short bf16x8;
typedef __attribute__((ext_vector_type(16))) float f32x16;
typedef __attribute__((ext_vector_type(4))) float f32x4;
typedef __attribute__((ext_vector_type(4))) unsigned u32x4;
typedef __attribute__((ext_vector_type(2))) unsigned u32x2;
typedef __attribute__((ext_vector_type(2))) __bf16 bf16x2v;

constexpr int BATCH = 8, SEQ = 4096, DM = 1024, NTOK = BATCH * SEQ;
constexpr int NIN = 5416, NP = 5504;
constexpr int NTHREADS = 256;
constexpr int SMEM_BYTES = 72 * 1024;
constexpr float L2E = 1.4426950408889634f;

constexpr size_t AL(size_t x) { return (x + 255) & ~(size_t)255; }
constexpr size_t OFF_WINT = 0;
constexpr size_t OFF_WAT = OFF_WINT + AL((size_t)NP * 1024 * 2);
constexpr size_t OFF_WBT = OFF_WAT + AL((size_t)1024 * 512 * 2);
constexpr size_t OFF_WOT = OFF_WBT + AL((size_t)1024 * 512 * 2);
constexpr size_t OFF_WQT = OFF_WOT + AL((size_t)1024 * 1024 * 2);
constexpr size_t OFF_SK = OFF_WQT + AL((size_t)2048 * 1024 * 2);
constexpr size_t OFF_WKT = OFF_SK + AL((size_t)16 * 128 * 128 * 2);
constexpr size_t OFF_WVT = OFF_WKT + AL((size_t)128 * 2048 * 2);
constexpr size_t OFF_EU = OFF_WVT + AL((size_t)128 * 2048 * 2);
constexpr size_t OFF_EV = OFF_EU + AL((size_t)16384 * 1024 * 2);
constexpr size_t OFF_MISC = OFF_EV + AL((size_t)16384 * 1024 * 2);
constexpr size_t MISC_CK = 0, MISC_CV = 256, MISC_BIAS = 512, MISC_CNT = 512 + 8 * 132 * 4 + 256, MISC_GL = 8192;
constexpr size_t MISC_SCU = 65536, MISC_SCV = 131072;
constexpr size_t OFF_RH = OFF_MISC + 262144;
constexpr size_t OFF_QKV = OFF_RH + (size_t)NTOK * 1024 * 2;
constexpr size_t OFF_Z = OFF_QKV + (size_t)NTOK * 1536 * 2;
constexpr size_t OFF_NQ = OFF_Z + (size_t)NTOK * 512 * 2;
constexpr size_t OFF_NKV = OFF_NQ + (size_t)NTOK * 512 * 2;
constexpr size_t OFF_MG = OFF_NKV + (size_t)NTOK * 768 * 2;
constexpr size_t OFF_SM = OFF_MG + (size_t)NTOK * 2048 * 2;
constexpr size_t OFF_VST = OFF_SM + AL((size_t)NTOK * 40 * 4);
constexpr size_t OFF_VWT = OFF_VST + (size_t)16 * 64 * 4096 * 2;
constexpr size_t OFF_KC = OFF_VWT + (size_t)16 * 64 * 4096 * 2;
constexpr size_t OFF_VCT = OFF_KC + (size_t)16 * 256 * 64 * 2;
constexpr size_t WS_NEEDED = OFF_VCT + (size_t)16 * 64 * 256 * 2;

struct Params {
  const float *x, *rel_bias, *norm_final, *norm_mix, *w_in, *conv_w, *a_log, *dt_bias, *gdn_norm, *cmp_pe_k, *cmp_pe_v,
      *cmp_w_k, *cmp_w_v, *w_a, *w_b, *w_out, *norm_ffn, *w_query, *sub_keys, *expert_u, *expert_v;
  float* out;
  char* ws;
};

DI u16 f2bf(float x) { return __builtin_bit_cast(u16, (__bf16)x); }
DI float bf2f(u16 b) { return __uint_as_float(((unsigned)b) << 16); }
typedef __attribute__((ext_vector_type(2))) float f32x2_;
typedef __attribute__((ext_vector_type(2))) __bf16 bf16x2_;
DI unsigned pack2(float lo, float hi) { f32x2_ v = {lo, hi}; return __builtin_bit_cast(unsigned, __builtin_convertvector(v, bf16x2_)); }
DI float bflo(unsigned u) { return __uint_as_float(u << 16); }
DI float bfhi(unsigned u) { return __uint_as_float(u & 0xffff0000u); }
DI float wave_sum(float v) {
#pragma unroll
  for (int o = 32; o >= 1; o >>= 1) v += __shfl_xor(v, o);
  return v;
}
DI int tidx() { int t = (int)__builtin_amdgcn_workitem_id_x(); asm volatile("" : "+v"(t)); return t; }
DI int opaque0() { int z = 0; asm volatile("" : "+v"(z)); return z; }
DI float sigmoidf_(float x) { return 1.f / (1.f + __expf(-x)); }
DI f32x16 mfma32(bf16x8 a, bf16x8 b, f32x16 c) { return __builtin_amdgcn_mfma_f32_32x32x16_bf16(a, b, c, 0, 0, 0); }
DI f32x4 mfma16(bf16x8 a, bf16x8 b, f32x4 c) { return __builtin_amdgcn_mfma_f32_16x16x32_bf16(a, b, c, 0, 0, 0); }
DI int swz(int row, int ch) { return row * 128 + ((ch ^ ((row >> 1) & 7)) << 4); }
DI bf16x8 lds_frag(const char* tile, int row, int ch) { return *(const bf16x8*)(tile + swz(row, ch)); }
DI bf16x8 pad_frag(const char* tile, int row, int ch) { return *(const bf16x8*)(tile + row * 144 + ch * 16); }
DI bf16x8 pack8(float a0, float a1, float a2, float a3, float a4, float a5, float a6, float a7) {
  u32x4 p;
  p[0] = pack2(a0, a1); p[1] = pack2(a2, a3); p[2] = pack2(a4, a5); p[3] = pack2(a6, a7);
  return __builtin_bit_cast(bf16x8, p);
}
DI int perm16(int o) { return (o & ~12) | ((o & 4) << 1) | ((o & 8) >> 1); }

DI int win_colmap(int n) {
  if (n < 2048) return n;
  if (n < 2560) return n - 2048 + 2064;
  if (n < 3328) return n - 2560 + 2576;
  if (n < 5376) return n - 3328 + 3368;
  if (n < 5392) return n - 5376 + 2048;
  if (n < 5416) return n - 5392 + 3344;
  return -1;
}
template <int MAPMODE>
DI void tconv_tile(const float* __restrict__ src, int K, int N, u16* __restrict__ dst, int kt, int nt, char* smem) {
  float* tile = (float*)smem;
  const int tid = tidx();
  const int nl = tid & 63, k0 = kt * 64, n0 = nt * 64;
  int col;
  if (MAPMODE == 1) col = win_colmap(n0 + nl); else col = (n0 + nl < N) ? (n0 + nl) : -1;
#pragma unroll 4
  for (int i = 0; i < 16; ++i) {
    int kl = (tid >> 6) + 4 * i;
    float v = (col >= 0) ? src[(size_t)(k0 + kl) * N + col] : 0.f;
    tile[kl * 65 + nl] = v;
  }
  __syncthreads();
  {
    const int n2 = tid >> 2, kp = tid & 3;
    u32x4 o0, o1;
#pragma unroll
    for (int i = 0; i < 4; ++i) {
      o0[i] = pack2(tile[(kp * 16 + 2 * i) * 65 + n2], tile[(kp * 16 + 2 * i + 1) * 65 + n2]);
      o1[i] = pack2(tile[(kp * 16 + 8 + 2 * i) * 65 + n2], tile[(kp * 16 + 8 + 2 * i + 1) * 65 + n2]);
    }
    u16* d = dst + (size_t)(n0 + n2) * K + k0 + kp * 16;
    *(u32x4*)d = o0;
    *(u32x4*)(d + 8) = o1;
  }
  __syncthreads();
}

DI void convert_flat(const float* __restrict__ src, u16* __restrict__ dst, size_t n, int bid, int nblk) {
  size_t nv = n / 8;
  for (size_t i = (size_t)bid * NTHREADS + tidx(); i < nv; i += (size_t)nblk * NTHREADS) {
    f32x4 a = ((const f32x4*)src)[2 * i], b = ((const f32x4*)src)[2 * i + 1];
    u32x4 o;
    o[0] = pack2(a[0], a[1]); o[1] = pack2(a[2], a[3]); o[2] = pack2(b[0], b[1]); o[3] = pack2(b[2], b[3]);
    ((u32x4*)dst)[i] = o;
  }
}


typedef __attribute__((ext_vector_type(2))) float f32x2;
DI unsigned f32_to_e4m3(float x) {
  unsigned u = __float_as_uint(x);
  const unsigned sign = (u >> 24) & 0x80u;
  u &= 0x7fffffffu;
  const float ax = __uint_as_float(u);
  unsigned r;
  if (ax < 0.015625f) r = (unsigned)__float2int_rn(ax * 512.f);
  else { u += 0x7ffffu + ((u >> 20) & 1u); r = (u >> 20) - (120u << 3); if (r > 0x7eu) r = 0x7eu; }
  return sign | r;
}
DI void convert_fp8_rows(const float* __restrict__ src, unsigned char* __restrict__ dst, float* __restrict__ inv_scale, int nrows, int bid, int nblk) {
  const int lane = tidx() & 63, wv = tidx() >> 6;
  for (int row = bid * 4 + wv; row < nrows; row += nblk * 4) {
    const f32x4* sp = (const f32x4*)(src + (size_t)row * 1024 + 16 * lane);
    f32x4 v[4];
    float mx = 0.f;
#pragma unroll
    for (int i = 0; i < 4; ++i) { v[i] = sp[i]; mx = fmaxf(mx, fmaxf(fmaxf(fabsf(v[i][0]), fabsf(v[i][1])), fmaxf(fabsf(v[i][2]), fabsf(v[i][3])))); }
#pragma unroll
    for (int o = 32; o >= 1; o >>= 1) mx = fmaxf(mx, __shfl_xor(mx, o));
    const float sc = (mx > 0.f) ? 240.f / mx : 1.f;
    u32x4 o4;
#pragma unroll
    for (int i = 0; i < 4; ++i)
      o4[i] = f32_to_e4m3(v[i][0] * sc) | (f32_to_e4m3(v[i][1] * sc) << 8) | (f32_to_e4m3(v[i][2] * sc) << 16) | (f32_to_e4m3(v[i][3] * sc) << 24);
    *(u32x4*)(dst + (size_t)row * 1024 + 16 * lane) = o4;
    if (lane == 0) inv_scale[row] = (mx > 0.f) ? mx / 240.f : 1.f;
  }
}

DI void rmsnorm_rows_bf16(const float* __restrict__ src, const float* __restrict__ w, u16* __restrict__ dst, int nrows, int bid, int nblk) {
  const int lane = tidx() & 63, wv = tidx() >> 6;
  f32x4 wr[4];
#pragma unroll
  for (int i = 0; i < 4; ++i) wr[i] = ((const f32x4*)w)[lane + 64 * i];
  for (int row = bid * 4 + wv; row < nrows; row += nblk * 4) {
    const f32x4* s = (const f32x4*)(src + (size_t)row * 1024);
    f32x4 v[4];
    float ss = 0.f;
#pragma unroll
    for (int i = 0; i < 4; ++i) { v[i] = s[lane + 64 * i]; ss += v[i][0] * v[i][0] + v[i][1] * v[i][1] + v[i][2] * v[i][2] + v[i][3] * v[i][3]; }
    ss = wave_sum(ss);
    float rs = rsqrtf(ss * (1.f / 1024.f) + 1e-6f);
#pragma unroll
    for (int i = 0; i < 4; ++i) {
      u32x2 o;
      o[0] = pack2(v[i][0] * rs * wr[i][0], v[i][1] * rs * wr[i][1]);
      o[1] = pack2(v[i][2] * rs * wr[i][2], v[i][3] * rs * wr[i][3]);
      *(u32x2*)(dst + (size_t)row * 1024 + (lane + 64 * i) * 4) = o;
    }
  }
}

DI int t5_bucket(int d) {
  if (d < 16) return d < 0 ? 0 : d;
  const int th[16] = {16, 19, 21, 24, 27, 31, 35, 40, 46, 52, 59, 67, 77, 87, 99, 113};
  int b = 16;
#pragma unroll
  for (int k = 1; k < 16; ++k) b += (d >= th[k]) ? 1 : 0;
  return b;
}

DI void phase0(const Params& p, int bid, int nblk, char* smem) {
  char* ws = p.ws;
  const int n_win = 16 * 86, n_wa = 8 * 16, n_wo = 16 * 16, n_wq = 16 * 32, n_wc = 32 * 2;
  const int total = n_win + 2 * n_wa + n_wo + n_wq + 2 * n_wc;
  for (int it = bid; it < total; it += nblk) {
    int i = it;
    if (i < n_win) { tconv_tile<1>(p.w_in, 1024, NIN, (u16*)(ws + OFF_WINT), i / 86, i % 86, smem); continue; }
    i -= n_win;
    if (i < n_wa) { tconv_tile<0>(p.w_a, 512, 1024, (u16*)(ws + OFF_WAT), i / 16, i % 16, smem); continue; }
    i -= n_wa;
    if (i < n_wa) { tconv_tile<0>(p.w_b, 512, 1024, (u16*)(ws + OFF_WBT), i / 16, i % 16, smem); continue; }
    i -= n_wa;
    if (i < n_wo) { tconv_tile<0>(p.w_out, 1024, 1024, (u16*)(ws + OFF_WOT), i / 16, i % 16, smem); continue; }
    i -= n_wo;
    if (i < n_wq) { tconv_tile<0>(p.w_query, 1024, 2048, (u16*)(ws + OFF_WQT), i / 32, i % 32, smem); continue; }
    i -= n_wq;
    if (i < n_wc) { tconv_tile<0>(p.cmp_w_k, 2048, 64, (u16*)(ws + OFF_WKT), i / 2, i % 2, smem); continue; }
    i -= n_wc;
    tconv_tile<0>(p.cmp_w_v, 2048, 64, (u16*)(ws + OFF_WVT), i / 2, i % 2, smem);
  }
  convert_flat(p.sub_keys, (u16*)(ws + OFF_SK), (size_t)16 * 128 * 128, bid, nblk);
  rmsnorm_rows_bf16(p.x, p.norm_mix, (u16*)(ws + OFF_RH), NTOK, bid, nblk);
  const int tid = tidx();
  if (bid == nblk - 1) {
    float* ck = (float*)(ws + OFF_MISC + MISC_CK);
    float* cv = (float*)(ws + OFF_MISC + MISC_CV);
    if (tid < 128) {
      const int e = tid & 63;
      const float* pe = (tid < 64) ? p.cmp_pe_k : p.cmp_pe_v;
      const float* W = (tid < 64) ? p.cmp_w_k : p.cmp_w_v;
      float s = 0.f;
      for (int k = 0; k < 2048; ++k) s += pe[k] * W[(size_t)k * 64 + e];
      if (tid < 64) ck[e] = s; else cv[e] = s;
    }
  }
  if (bid == nblk - 2 || nblk == 1) {
    float* bt = (float*)(ws + OFF_MISC + MISC_BIAS);
    for (int i = tid; i < 8 * 132; i += NTHREADS) {
      int hd = i / 132, d = i % 132;
      bt[i] = p.rel_bias[t5_bucket(d) * 8 + hd] * L2E;
    }
    if (tid < 16) ((unsigned*)(ws + OFF_MISC + MISC_CNT))[tid] = 0u;
  }
}

struct GemmPtrs {
  const u16* a[4];
  const u16* b[4];
  long aks, bks;
};

typedef __attribute__((address_space(3))) unsigned* lds_u32p;
DI void glds16(const u16* gsrc, const char* lds_dst) {
  __builtin_amdgcn_global_load_lds((const unsigned*)gsrc, (lds_u32p)(unsigned)(size_t)lds_dst, 16, 0, 0);
}
DI void gemm_kloop(f32x16 (&acc)[2][2], const GemmPtrs& g, int nkt, char* smem) {
  const int tid = tidx(), lane = tid & 63, w = tid >> 6, wm = w >> 1, wn = w & 1, r = lane & 31, h = lane >> 5;
  const char* dstA = smem + (w * 4) * 1024 + lane * 16;
#pragma unroll
  for (int i = 0; i < 4; ++i) { glds16(g.a[i], dstA + i * 1024); glds16(g.b[i], dstA + 16384 + i * 1024); }
  asm volatile("s_waitcnt vmcnt(0)" ::: "memory");
  __syncthreads();
  for (int kt = 0; kt < nkt; ++kt) {
    const char* A = smem + (kt & 1) * 32768;
    const char* B = A + 16384;
    if (kt + 1 < nkt) {
      const char* d2 = dstA + ((kt + 1) & 1) * 32768;
#pragma unroll
      for (int i = 0; i < 4; ++i) { glds16(g.a[i] + (long)(kt + 1) * g.aks, d2 + i * 1024); glds16(g.b[i] + (long)(kt + 1) * g.bks, d2 + 16384 + i * 1024); }
    }
#pragma unroll
    for (int s = 0; s < 4; ++s) {
      bf16x8 a0 = lds_frag(A, wm * 64 + r, 2 * s + h);
      bf16x8 a1 = lds_frag(A, wm * 64 + 32 + r, 2 * s + h);
      bf16x8 b0 = lds_frag(B, wn * 64 + r, 2 * s + h);
      bf16x8 b1 = lds_frag(B, wn * 64 + 32 + r, 2 * s + h);
      acc[0][0] = mfma32(a0, b0, acc[0][0]);
      acc[0][1] = mfma32(a0, b1, acc[0][1]);
      acc[1][0] = mfma32(a1, b0, acc[1][0]);
      acc[1][1] = mfma32(a1, b1, acc[1][1]);
    }
    asm volatile("s_waitcnt vmcnt(0)" ::: "memory");
    __syncthreads();
  }
}

DI void zero_acc(f32x16 (&acc)[2][2]) {
#pragma unroll
  for (int i = 0; i < 2; ++i)
#pragma unroll
    for (int j = 0; j < 2; ++j)
#pragma unroll
      for (int k = 0; k < 16; ++k) acc[i][j][k] = 0.f;
}
DI int glds_row(int i) { return ((tidx() >> 6) * 4 + i) * 8 + ((tidx() & 63) >> 3); }
DI int glds_chunk(int row) { return (tidx() & 7) ^ ((row >> 1) & 7); }
DI void gemm_setup(GemmPtrs& g, const u16* A, long lda, int m0, const u16* Bt, long ldb, int n0) {
#pragma unroll
  for (int i = 0; i < 4; ++i) {
    const int row = glds_row(i), ch = glds_chunk(row);
    g.a[i] = A + (size_t)(m0 + row) * lda + ch * 8;
    g.b[i] = Bt + (size_t)(n0 + row) * ldb + ch * 8;
  }
  g.aks = 64; g.bks = 64;
}
template <class F>
DI void gemm_epilogue(const f32x16 (&acc)[2][2], F f) {
  const int lane = tidx() & 63, w = tidx() >> 6, wm = w >> 1, wn = w & 1, r = lane & 31, h = lane >> 5;
#pragma unroll
  for (int i = 0; i < 2; ++i)
#pragma unroll
    for (int j = 0; j < 2; ++j) {
#pragma unroll
      for (int k = 0; k < 16; ++k) f(wm * 64 + i * 32 + (k & 3) + 8 * (k >> 2) + 4 * h, wn * 64 + j * 32 + r, acc[i][j][k]);
      asm volatile("" ::: "memory");
    }
}

template <class F>
DI void gemm_epilogue_lds(const f32x16 (&acc)[2][2], char* smem, F f) {
  float* T = (float*)smem;
  {
    const int lane = tidx() & 63, w = tidx() >> 6, wm = w >> 1, wn = w & 1, r = lane & 31, h = lane >> 5;
#pragma unroll
    for (int i = 0; i < 2; ++i)
#pragma unroll
      for (int j = 0; j < 2; ++j)
#pragma unroll
        for (int k = 0; k < 16; ++k) T[(wm * 64 + i * 32 + (k & 3) + 8 * (k >> 2) + 4 * h) * 132 + wn * 64 + j * 32 + r] = acc[i][j][k];
  }
  __syncthreads();
  const int c8 = (tidx() & 15) * 8, r0 = tidx() >> 4;
#pragma unroll 2
  for (int it = 0; it < 8; ++it) {
    const int row = r0 + 16 * it;
    const f32x4 a = *(const f32x4*)(T + row * 132 + c8), b = *(const f32x4*)(T + row * 132 + c8 + 4);
    const float v[8] = {a[0], a[1], a[2], a[3], b[0], b[1], b[2], b[3]};
    f(row, c8, v);
  }
  __syncthreads();
}
DI u32x4 pack8u(const float (&v)[8]) { u32x4 o; o[0] = pack2(v[0], v[1]); o[1] = pack2(v[2], v[3]); o[2] = pack2(v[4], v[5]); o[3] = pack2(v[6], v[7]); return o; }

DI bool xcd_tile(int k, int bid, int nblk, int NMT, int NNT, int& mt, int& nt) {
  if ((nblk & 7) != 0 || nblk < 8) {
    const int t = bid + k * nblk;
    if (t >= NMT * NNT) return false;
    mt = t / NNT; nt = t % NNT; return true;
  }
  const int x = bid & 7, j = bid >> 3, per = nblk >> 3;
  const int groups = NMT >> 6;
  const int i = j + k * per;
  if (i >= groups * 8 * NNT) return false;
  const int g = i / (8 * NNT), rem = i - g * (8 * NNT);
  nt = rem >> 3; mt = ((x + 8 * g) << 3) + (rem & 7);
  return true;
}

DI void phase_inproj(const Params& p, int bid, int nblk, char* smem) {
  char* ws = p.ws;
  const u16* H = (const u16*)(ws + OFF_RH);
  const u16* W = (const u16*)(ws + OFF_WINT);
  const int NT = NP / 128;
  for (int k = 0;; ++k) {
    int mt, nt;
    if (!xcd_tile(k, bid, nblk, 256, NT, mt, nt)) break;
    const int m0 = mt * 128, n0 = nt * 128;
    GemmPtrs g;
    gemm_setup(g, H, 1024, m0, W, 1024, n0);
    f32x16 acc[2][2];
    zero_acc(acc);
    gemm_kloop(acc, g, 16, smem);
    if (n0 >= 5376) {
      float* SM = (float*)(ws + OFF_SM);
      gemm_epilogue_lds(acc, smem, [&](int ml, int nl, const float (&v)[8]) {
        if (nl < 40) {
          float* d = SM + (size_t)(m0 + ml) * 40 + nl;
          *(f32x4*)d = f32x4{v[0], v[1], v[2], v[3]};
          *(f32x4*)(d + 4) = f32x4{v[4], v[5], v[6], v[7]};
        }
      });
    } else {
      u16* dst; int ld, c0;
      if (n0 < 1536) { dst = (u16*)(ws + OFF_QKV); ld = 1536; c0 = n0; }
      else if (n0 < 2048) { dst = (u16*)(ws + OFF_Z); ld = 512; c0 = n0 - 1536; }
      else if (n0 < 2560) { dst = (u16*)(ws + OFF_NQ); ld = 512; c0 = n0 - 2048; }
      else if (n0 < 3328) { dst = (u16*)(ws + OFF_NKV); ld = 768; c0 = n0 - 2560; }
      else { dst = (u16*)(ws + OFF_MG); ld = 2048; c0 = n0 - 3328; }
      gemm_epilogue_lds(acc, smem, [&](int ml, int nl, const float (&v)[8]) { *(u32x4*)(dst + (size_t)(m0 + ml) * ld + c0 + nl) = pack8u(v); });
    }
  }
}

DI void vtrans_item(const Params& p, int item, char* smem) {
  char* ws = p.ws;
  const int tile = item & 63, bg = (item >> 6) & 15, which = item >> 10;
  const int b = bg >> 1, g = bg & 1;
  const u16* NKV = (const u16*)(ws + OFF_NKV);
  u16* VT = (u16*)(ws + (which ? OFF_VWT : OFF_VST)) + ((size_t)bg * 64 + tile) * 4096;
  const int col0 = (which ? 640 : 384) + g * 64;
  u16* t = (u16*)smem;
  const int tid = tidx();
  {
#pragma unroll
    for (int i = 0; i < 2; ++i) {
      int c = tid + 256 * i, row = c >> 3, ch = c & 7;
      u32x4 v = *(const u32x4*)(NKV + (size_t)(b * SEQ + tile * 64 + row) * 768 + col0 + ch * 8);
      *(u32x4*)(t + row * 72 + ch * 8) = v;
    }
  }
  __syncthreads();
  {
    const int d = tid >> 2, part = tid & 3;
    u32x4 o0, o1;
    u16 vals[16];
#pragma unroll
    for (int pp = 0; pp < 16; ++pp) vals[pp] = t[(part * 16 + perm16(pp)) * 72 + d];
#pragma unroll
    for (int i = 0; i < 4; ++i) {
      o0[i] = (unsigned)vals[2 * i] | ((unsigned)vals[2 * i + 1] << 16);
      o1[i] = (unsigned)vals[8 + 2 * i] | ((unsigned)vals[8 + 2 * i + 1] << 16);
    }
    u16* dst = VT + (size_t)d * 64 + part * 16;
    *(u32x4*)dst = o0;
    *(u32x4*)(dst + 8) = o1;
  }
  __syncthreads();
}

DI void cmp_gemm_item(const Params& p, int item, char* smem) {
  char* ws = p.ws;
  const int which = item >> 5, mt = item & 31, m0 = mt * 128;
  const u16* NKV = (const u16*)(ws + OFF_NKV);
  const u16* Wt = (const u16*)(ws + (which ? OFF_WVT : OFF_WKT));
  GemmPtrs g;
#pragma unroll
  for (int i = 0; i < 4; ++i) {
    const int row = glds_row(i), ch = glds_chunk(row);
    int m = m0 + row, bg = m >> 8, n = m & 255;
    if (n > 254) n = 254;
    g.a[i] = NKV + (size_t)((bg >> 1) * SEQ + 16 * n) * 768 + which * 128 + (bg & 1) * 64 + ch * 8;
    g.b[i] = Wt + (size_t)row * 2048 + ch * 8;
  }
  g.aks = 768; g.bks = 64;
  f32x16 acc[2][2];
  zero_acc(acc);
  gemm_kloop(acc, g, 32, smem);
  const float* cc = (const float*)(ws + OFF_MISC + (which ? MISC_CV : MISC_CK));
  if (which == 0) {
    u16* KC = (u16*)(ws + OFF_KC);
    gemm_epilogue_lds(acc, smem, [&](int ml, int nl, const float (&v)[8]) {
      if (nl < 64) {
        float t[8];
#pragma unroll
        for (int e = 0; e < 8; ++e) t[e] = v[e] + cc[nl + e];
        *(u32x4*)(KC + (size_t)(m0 + ml) * 64 + nl) = pack8u(t);
      }
    });
  } else {
    u16* VCT = (u16*)(ws + OFF_VCT);
    gemm_epilogue_lds(acc, smem, [&](int ml, int nl, const float (&v)[8]) {
      if (nl < 64) {
        const int m = m0 + ml, bg = m >> 8, n = m & 255;
        u16* d = VCT + (((size_t)bg * 4 + (n >> 6)) * 64 + nl) * 64 + (n & 48) + perm16(n & 15);
#pragma unroll
        for (int e = 0; e < 8; ++e) d[e * 64] = f2bf(v[e] + cc[nl + e]);
      }
    });
  }
}

DI void gdn_store_frag(u16* dst, const char* tile, int idx  , float scale_is_row, const float* rowscale) {
  const int blk = idx >> 6, lane = idx & 63, rt = blk >> 1, ks = blk & 1, r = lane & 15, q = lane >> 4;
  const int row = 16 * rt + r;
  const int k0 = 32 * ks + 4 * q, k1 = k0 + 16;
  u32x2 lo = *(const u32x2*)(tile + swz(row, k0 >> 3) + (k0 & 7) * 2);
  u32x2 hi = *(const u32x2*)(tile + swz(row, k1 >> 3) + (k1 & 7) * 2);
  u32x4 o;
  if (rowscale) {
    float s = rowscale[row];
    o[0] = pack2(bflo(lo[0]) * s, bfhi(lo[0]) * s); o[1] = pack2(bflo(lo[1]) * s, bfhi(lo[1]) * s);
    o[2] = pack2(bflo(hi[0]) * s, bfhi(hi[0]) * s); o[3] = pack2(bflo(hi[1]) * s, bfhi(hi[1]) * s);
  } else { o[0] = lo[0]; o[1] = lo[1]; o[2] = hi[0]; o[3] = hi[1]; }
  *(u32x4*)(dst + (size_t)idx * 8) = o;
}

DI void gdn_chunk_item(const Params& p, int item, char* smem) {
  char* ws = p.ws;
  const int n = item & 63, bh = item >> 6, b = bh >> 3, hd = bh & 7;
  const int tid = tidx() + opaque0(), lane = tid & 63, w = tid >> 6;
  char* Cq = smem;
  char* Ck = smem + 8192;
  char* Cv = smem + 16384;
  float* Am = (float*)(smem + 24576);
  char* ATT = smem + 40960;
  char* Wt = smem + 49152;
  float* gc = (float*)(smem + 57344);
  float* bet = gc + 64;
  float* eg = gc + 128;
  float* ekd = gc + 192;
  const u16* QKV = (const u16*)(ws + OFF_QKV);
  const size_t tok0 = (size_t)b * SEQ + n * 64;
  {
    const int cg = tid & 7, tp = tid >> 3;
#pragma unroll
    for (int part = 0; part < 3; ++part) {
      const int col = part * 512 + hd * 64 + cg * 8;
      const int s0 = n * 64 + 2 * tp;
      const u16* src = QKV + ((size_t)b * SEQ) * 1536 + col;
      u32x4 xr[5];
#pragma unroll
      for (int j = 0; j < 5; ++j) {
        const int ss = s0 - 3 + j;
        xr[j] = (ss >= 0) ? *(const u32x4*)(src + (size_t)ss * 1536) : u32x4{0u, 0u, 0u, 0u};
      }
      float wv[4][8];
#pragma unroll
      for (int j = 0; j < 4; ++j) {
        const f32x4 wa = *(const f32x4*)(p.conv_w + j * 1536 + col), wb = *(const f32x4*)(p.conv_w + j * 1536 + col + 4);
        wv[j][0] = wa[0]; wv[j][1] = wa[1]; wv[j][2] = wa[2]; wv[j][3] = wa[3]; wv[j][4] = wb[0]; wv[j][5] = wb[1]; wv[j][6] = wb[2]; wv[j][7] = wb[3];
      }
      char* C = smem + part * 8192;
#pragma unroll
      for (int tt = 0; tt < 2; ++tt) {
        float y[8];
#pragma unroll
        for (int e = 0; e < 8; ++e) {
          float acc = 0.f;
#pragma unroll
          for (int j = 0; j < 4; ++j) {
            const unsigned wd = xr[tt + j][e >> 1];
            acc += wv[j][e] * ((e & 1) ? bfhi(wd) : bflo(wd));
          }
          y[e] = acc / (1.f + __expf(-acc));
        }
        u32x4 o; o[0] = pack2(y[0], y[1]); o[1] = pack2(y[2], y[3]); o[2] = pack2(y[4], y[5]); o[3] = pack2(y[6], y[7]);
        *(u32x4*)(C + swz(2 * tp + tt, cg)) = o;
      }
    }
  }
  if (w == 0) {
    const float* SM = (const float*)(ws + OFF_SM);
    float bi = SM[(tok0 + lane) * 40 + hd], ai = SM[(tok0 + lane) * 40 + 8 + hd];
    float xs = ai + p.dt_bias[hd];
    float sp = (xs > 20.f) ? xs : log1pf(__expf(xs));
    float gv = -__expf(p.a_log[hd]) * sp;
#pragma unroll
    for (int o = 1; o < 64; o <<= 1) { float t = __shfl_up(gv, o); if (lane >= o) gv += t; }
    float glast = __shfl(gv, 63);
    gc[lane] = gv; bet[lane] = sigmoidf_(bi); eg[lane] = __expf(gv); ekd[lane] = __expf(glast - gv);
    if (lane == 63) ((float*)(ws + OFF_MISC + MISC_GL))[item] = __expf(gv);
  }
  __syncthreads();
  if (tid < 128) {
    char* C = (tid < 64) ? Cq : Ck;
    const int row = tid & 63;
    u32x4 v[8];
    float ss = 0.f;
#pragma unroll
    for (int c = 0; c < 8; ++c) {
      v[c] = *(const u32x4*)(C + swz(row, c));
#pragma unroll
      for (int e = 0; e < 4; ++e) { float a = bflo(v[c][e]), bb = bfhi(v[c][e]); ss += a * a + bb * bb; }
    }
    float rs = rsqrtf(ss + 1e-6f) * ((tid < 64) ? 0.125f : 1.f);
#pragma unroll
    for (int c = 0; c < 8; ++c) {
      u32x4 o;
#pragma unroll
      for (int e = 0; e < 4; ++e) o[e] = pack2(bflo(v[c][e]) * rs, bfhi(v[c][e]) * rs);
      *(u32x4*)(C + swz(row, c)) = o;
    }
  }
  __syncthreads();
  {
    const int qa = w >> 1, qb = w & 1, r = lane & 31, h = lane >> 5;
    f32x16 akk, aqk;
#pragma unroll
    for (int k = 0; k < 16; ++k) { akk[k] = 0.f; aqk[k] = 0.f; }
    if (!(qa == 0 && qb == 1)) {
#pragma unroll
      for (int s = 0; s < 4; ++s) {
        bf16x8 ak = lds_frag(Ck, 32 * qa + r, 2 * s + h);
        bf16x8 aq = lds_frag(Cq, 32 * qa + r, 2 * s + h);
        bf16x8 bk = lds_frag(Ck, 32 * qb + r, 2 * s + h);
        akk = mfma32(ak, bk, akk);
        aqk = mfma32(aq, bk, aqk);
      }
    }
    const int j = 32 * qb + r;
    const float gj = gc[j];
#pragma unroll
    for (int k = 0; k < 16; ++k) {
      const int i = 32 * qa + (k & 3) + 8 * (k >> 2) + 4 * h;
      float dec = __expf(fminf(gc[i] - gj, 0.f));
      Am[i * 64 + j] = (j < i) ? akk[k] * bet[i] * dec : 0.f;
      *(u16*)(ATT + swz(i, j >> 3) + (j & 7) * 2) = f2bf((j <= i) ? aqk[k] * dec : 0.f);
    }
  }
  __syncthreads();
  u16* AMg = (u16*)p.out + (size_t)item * 16384;
  {
    const int c = tid >> 1, half = tid & 1, dcol = c & 63;
    const char* Rt = (c < 64) ? Cv : Ck;
    float xh[32];
#pragma unroll
    for (int k = 0; k < 32; ++k) xh[k] = 0.f;
#pragma unroll
    for (int i = 0; i < 64; ++i) {
      const float rhs = bf2f(*(const u16*)(Rt + swz(i, dcol >> 3) + (dcol & 7) * 2)) * bet[i] * ((c < 64) ? 1.f : eg[i]);
      float s0 = 0.f, s1 = 0.f;
#pragma unroll
      for (int j4 = 0; j4 < (i + 3) / 4; ++j4) {
        const f32x4 a = *(const f32x4*)(Am + i * 64 + j4 * 4);
        s0 += (half ? a[1] : a[0]) * xh[2 * j4];
        s1 += (half ? a[3] : a[2]) * xh[2 * j4 + 1];
      }
      float tot = s0 + s1;
      tot += __shfl_xor(tot, 1);
      float xi = rhs - tot;
      asm volatile("" : "+v"(xi) : : "memory");
      if ((i & 1) == 0) { if (half == 0) xh[i >> 1] = xi; } else { if (half == 1) xh[i >> 1] = xi; }
    }
    if (c < 64) {
      float* U = (float*)(ws + OFF_RH) + ((size_t)item * 64 + c) * 64;
#pragma unroll
      for (int k = 0; k < 32; ++k) U[2 * k + half] = xh[k];
    } else {
#pragma unroll
      for (int k = 0; k < 32; ++k) { const int i = 2 * k + half; *(u16*)(Wt + swz(i, dcol >> 3) + (dcol & 7) * 2) = f2bf(xh[k]); }
    }
  }
  {
#pragma unroll
    for (int i = 0; i < 2; ++i) {
      gdn_store_frag(AMg + 4096, Cq, tid + 256 * i, 1.f, eg);
      gdn_store_frag(AMg + 8192, ATT, tid + 256 * i, 0.f, nullptr);
    }
#pragma unroll
    for (int i = 0; i < 2; ++i) {
      const int idx = tid + 256 * i, blk = idx >> 6, ln = idx & 63, rt = blk >> 1, ks = blk & 1, r = ln & 15, q = ln >> 4;
      const int d = 16 * rt + r;
      float vv[8];
#pragma unroll
      for (int j = 0; j < 8; ++j) {
        const int tk = 32 * ks + ((j < 4) ? (4 * q + j) : (16 + 4 * q + (j - 4)));
        vv[j] = bf2f(*(const u16*)(Ck + swz(tk, d >> 3) + (d & 7) * 2)) * ekd[tk];
      }
      *(bf16x8*)(AMg + 12288 + (size_t)idx * 8) = pack8(vv[0], vv[1], vv[2], vv[3], vv[4], vv[5], vv[6], vv[7]);
    }
  }
  __syncthreads();
#pragma unroll
  for (int i = 0; i < 2; ++i) gdn_store_frag(AMg, Wt, tid + 256 * i, 0.f, nullptr);
  __syncthreads();
}

DI void phase2(const Params& p, int bid, int nblk, char* smem) {
  const int total = 64 + 2048 + 4096;
  for (int it = bid; it < total; it += nblk) {
    if (it < 64) cmp_gemm_item(p, it, smem);
    else if (it < 2112) vtrans_item(p, it - 64, smem);
    else gdn_chunk_item(p, it - 2112, smem);
  }
}

DI void gdn_scan_item(const Params& p, int bh, char* smem) {
  char* ws = p.ws;
  const int tid = tidx(), lane = tid & 63, w = tid >> 6, col = lane & 15, q = lane >> 4;
  const int b = bh >> 3, hd = bh & 7;
  const u16* AMg = (const u16*)p.out + (size_t)bh * 64 * 16384;
  const float* U = (const float*)(ws + OFF_RH) + (size_t)bh * 64 * 4096;
  const float* GL = (const float*)(ws + OFF_MISC + MISC_GL) + bh * 64;
  float* O = (float*)(ws + OFF_QKV);
  f32x4 S[4];
#pragma unroll
  for (int t = 0; t < 4; ++t) S[t] = f32x4{0.f, 0.f, 0.f, 0.f};
  u32x4 stg[8];
#pragma unroll
  for (int i = 0; i < 8; ++i) stg[i] = *(const u32x4*)(AMg + (size_t)(i * 256 + tid) * 8);
  f32x4 u[4];
#pragma unroll
  for (int ct = 0; ct < 4; ++ct) u[ct] = *(const f32x4*)(U + (size_t)(16 * w + col) * 64 + 16 * ct + 4 * q);
  float gl = GL[0];
  for (int n = 0; n < 64; ++n) {
    char* buf = smem + (n & 1) * 32768;
#pragma unroll
    for (int i = 0; i < 8; ++i) *(u32x4*)(buf + (i * 256 + tid) * 16) = stg[i];
    __syncthreads();
    f32x4 ucur[4];
#pragma unroll
    for (int ct = 0; ct < 4; ++ct) ucur[ct] = u[ct];
    const float glcur = gl;
    if (n + 1 < 64) {
      const u16* src = AMg + (size_t)(n + 1) * 16384;
#pragma unroll
      for (int i = 0; i < 8; ++i) stg[i] = *(const u32x4*)(src + (size_t)(i * 256 + tid) * 8);
      const float* un = U + (size_t)(n + 1) * 4096;
#pragma unroll
      for (int ct = 0; ct < 4; ++ct) u[ct] = *(const f32x4*)(un + (size_t)(16 * w + col) * 64 + 16 * ct + 4 * q);
      gl = GL[n + 1];
    }
    bf16x8 bS[2];
#pragma unroll
    for (int ks = 0; ks < 2; ++ks)
      bS[ks] = pack8(S[2 * ks][0], S[2 * ks][1], S[2 * ks][2], S[2 * ks][3], S[2 * ks + 1][0], S[2 * ks + 1][1], S[2 * ks + 1][2], S[2 * ks + 1][3]);
#define AFRAG(mat, rt, ks) (*(const bf16x8*)(buf + (mat) * 8192 + (((rt) * 2 + (ks)) * 64 + lane) * 16))
    f32x4 vn[4], o[4];
#pragma unroll
    for (int ct = 0; ct < 4; ++ct) {
      f32x4 a = f32x4{0.f, 0.f, 0.f, 0.f};
      a = mfma16(AFRAG(0, ct, 0), bS[0], a);
      a = mfma16(AFRAG(0, ct, 1), bS[1], a);
      vn[ct] = ucur[ct] - a;
      f32x4 oo = f32x4{0.f, 0.f, 0.f, 0.f};
      oo = mfma16(AFRAG(1, ct, 0), bS[0], oo);
      oo = mfma16(AFRAG(1, ct, 1), bS[1], oo);
      o[ct] = oo;
    }
    bf16x8 bV[2];
#pragma unroll
    for (int ks = 0; ks < 2; ++ks)
      bV[ks] = pack8(vn[2 * ks][0], vn[2 * ks][1], vn[2 * ks][2], vn[2 * ks][3], vn[2 * ks + 1][0], vn[2 * ks + 1][1], vn[2 * ks + 1][2], vn[2 * ks + 1][3]);
#pragma unroll
    for (int ct = 0; ct < 4; ++ct) {
      o[ct] = mfma16(AFRAG(2, ct, 0), bV[0], o[ct]);
      o[ct] = mfma16(AFRAG(2, ct, 1), bV[1], o[ct]);
      f32x4 sn = S[ct] * glcur;
      sn = mfma16(AFRAG(3, ct, 0), bV[0], sn);
      sn = mfma16(AFRAG(3, ct, 1), bV[1], sn);
      S[ct] = sn;
    }
#undef AFRAG
    float* od = O + ((size_t)b * SEQ + n * 64) * 512 + hd * 64 + 16 * w + col;
#pragma unroll
    for (int ct = 0; ct < 4; ++ct)
#pragma unroll
      for (int rg = 0; rg < 4; ++rg) od[(size_t)(16 * ct + 4 * q + rg) * 512] = o[ct][rg];
  }
  asm volatile("s_waitcnt vmcnt(0)" ::: "memory");
  __syncthreads();
  {
    u16* Z = (u16*)(ws + OFF_Z);
    const int sub = tid & 15;
    const f32x4 gw = ((const f32x4*)p.gdn_norm)[sub];
    for (int tk = tid >> 4; tk < SEQ; tk += 16) {
      const size_t gi = ((size_t)b * SEQ + tk) * 8 + hd;
      f32x4 v = *(const f32x4*)(O + gi * 64 + sub * 4);
      float ss = v[0] * v[0] + v[1] * v[1] + v[2] * v[2] + v[3] * v[3];
      ss += __shfl_xor(ss, 1); ss += __shfl_xor(ss, 2); ss += __shfl_xor(ss, 4); ss += __shfl_xor(ss, 8);
      const float rs = rsqrtf(ss * (1.f / 64.f) + 1e-6f);
      const u32x2 zz = *(const u32x2*)(Z + gi * 64 + sub * 4);
      const float z0 = bflo(zz[0]), z1 = bfhi(zz[0]), z2 = bflo(zz[1]), z3 = bfhi(zz[1]);
      u32x2 ov;
      ov[0] = pack2(v[0] * rs * gw[0] * (z0 * sigmoidf_(z0)), v[1] * rs * gw[1] * (z1 * sigmoidf_(z1)));
      ov[1] = pack2(v[2] * rs * gw[2] * (z2 * sigmoidf_(z2)), v[3] * rs * gw[3] * (z3 * sigmoidf_(z3)));
      *(u32x2*)(Z + gi * 64 + sub * 4) = ov;
    }
  }
  __syncthreads();
}

DI void phase_gdn_post(const Params& p, int bid, int nblk) {
  char* ws = p.ws;
  const float* O = (const float*)(ws + OFF_QKV);
  const u16* Z = (const u16*)(ws + OFF_Z);
  u16* OA = (u16*)(ws + OFF_NQ);
  const int sub = tidx() & 15;
  const f32x4 gw = ((const f32x4*)p.gdn_norm)[sub];
  const size_t ngrp = (size_t)NTOK * 8;
  for (size_t gi = ((size_t)bid * NTHREADS + tidx()) >> 4; gi < ngrp; gi += ((size_t)nblk * NTHREADS) >> 4) {
    f32x4 v = *(const f32x4*)(O + gi * 64 + sub * 4);
    float ss = v[0] * v[0] + v[1] * v[1] + v[2] * v[2] + v[3] * v[3];
    ss += __shfl_xor(ss, 1); ss += __shfl_xor(ss, 2); ss += __shfl_xor(ss, 4); ss += __shfl_xor(ss, 8);
    float rs = rsqrtf(ss * (1.f / 64.f) + 1e-6f);
    u32x2 zz = *(const u32x2*)(Z + gi * 64 + sub * 4);
    float z0 = bflo(zz[0]), z1 = bfhi(zz[0]), z2 = bflo(zz[1]), z3 = bfhi(zz[1]);
    u32x2 o;
    o[0] = pack2(v[0] * rs * gw[0] * (z0 * sigmoidf_(z0)), v[1] * rs * gw[1] * (z1 * sigmoidf_(z1)));
    o[1] = pack2(v[2] * rs * gw[2] * (z2 * sigmoidf_(z2)), v[3] * rs * gw[3] * (z3 * sigmoidf_(z3)));
    *(u32x2*)(OA + gi * 64 + sub * 4) = o;
  }
}

constexpr float NEGBIG = -1e30f;
constexpr float QK_SCALE = 0.125f * L2E;

DI float fexp2(float x) { return __builtin_amdgcn_exp2f(x); }
DI float xhalf_max(float x) {
  auto r = __builtin_amdgcn_permlane32_swap(__float_as_uint(x), __float_as_uint(x), false, false);
  return fmaxf(__uint_as_float(r[0]), __uint_as_float(r[1]));
}
DI float xhalf_sum(float x) {
  auto r = __builtin_amdgcn_permlane32_swap(__float_as_uint(x), __float_as_uint(x), false, false);
  return __uint_as_float(r[0]) + __uint_as_float(r[1]);
}

template <int MODE, bool SLOW>
DI void nsa_tile(const char* Kt, const char* Vt, const char* Qw, f32x16 (&O)[2], float& m, float& l,
                 const int t, const int key0, const bool lane_sel, const float* tab, const float c31,
                 const float mfin, const float linv, float* impw) {
  const int lane = tidx() & 63, r = lane & 31, h = lane >> 5;
#pragma unroll
  for (int a = 0; a < 2; ++a) {
    f32x16 S;
#pragma unroll
    for (int k = 0; k < 16; ++k) S[k] = 0.f;
#pragma unroll
    for (int s = 0; s < 4; ++s) S = mfma32(pad_frag(Kt, 32 * a + r, 2 * s + h), *(const bf16x8*)(Qw + (s * 64 + lane) * 16), S);
    if (!SLOW) {
      const float cb = (MODE == 2 && !lane_sel) ? NEGBIG : c31;
      float mxr = fmaxf(fmaxf(S[0], S[1]), fmaxf(S[2], S[3]));
#pragma unroll
      for (int k = 4; k < 16; k += 4) mxr = fmaxf(mxr, fmaxf(fmaxf(S[k], S[k + 1]), fmaxf(S[k + 2], S[k + 3])));
      const float mx = xhalf_max(fmaf(mxr, QK_SCALE, cb));
      const float mn = fmaxf(m, mx);
      const float alpha = fexp2(m - mn);
      const float cbm = cb - mn;
      float ps = 0.f;
#pragma unroll
      for (int k = 0; k < 16; ++k) { S[k] = fexp2(fmaf(S[k], QK_SCALE, cbm)); ps += S[k]; }
      l = l * alpha + ps;
      m = mn;
#pragma unroll
      for (int dt = 0; dt < 2; ++dt)
#pragma unroll
        for (int k = 0; k < 16; ++k) O[dt][k] *= alpha;
    } else {
      float bias[16];
#pragma unroll
      for (int k = 0; k < 16; ++k) {
        const int kl = 32 * a + (k & 3) + 8 * (k >> 2) + 4 * h;
        const int dist = (MODE < 2) ? (t - (16 * (key0 + kl) + 31)) : (t - (key0 + kl));
        bias[k] = tab[min(max(dist, 0), 128)];
      }
#pragma unroll
      for (int k = 0; k < 16; ++k) asm volatile("" : "+v"(bias[k]));
#pragma unroll
      for (int k = 0; k < 16; ++k) {
        const int kl = 32 * a + (k & 3) + 8 * (k >> 2) + 4 * h;
        const int dist = (MODE < 2) ? (t - (16 * (key0 + kl) + 31)) : (t - (key0 + kl));
        bool valid = (dist >= 0) && lane_sel;
        if (MODE == 3) valid = valid && (dist < 512);
        S[k] = valid ? fmaf(S[k], QK_SCALE, bias[k]) : NEGBIG;
      }
    if (MODE == 1) {
#pragma unroll
      for (int k = 0; k < 16; ++k) S[k] = (S[k] > -1e29f) ? fexp2(S[k] - mfin) * linv : 0.f;
    } else {
      float mx = fmaxf(fmaxf(S[0], S[1]), fmaxf(S[2], S[3]));
#pragma unroll
      for (int k = 4; k < 16; k += 4) mx = fmaxf(mx, fmaxf(fmaxf(S[k], S[k + 1]), fmaxf(S[k + 2], S[k + 3])));
      mx = xhalf_max(mx);
      const float mn = fmaxf(m, mx);
      const float alpha = fexp2(m - mn);
      float ps = 0.f;
#pragma unroll
      for (int k = 0; k < 16; ++k) { S[k] = (S[k] > -1e29f) ? fexp2(S[k] - mn) : 0.f; ps += S[k]; }
      l = l * alpha + ps;
      m = mn;
      if (MODE != 0) {
#pragma unroll
        for (int dt = 0; dt < 2; ++dt)
#pragma unroll
          for (int k = 0; k < 16; ++k) O[dt][k] *= alpha;
      }
    }
    }
    if (MODE == 1) {
#pragma unroll
      for (int g4 = 0; g4 < 4; ++g4) {
        float mainv = S[4 * g4] + S[4 * g4 + 1] + S[4 * g4 + 2] + 0.5f * S[4 * g4 + 3];
        float spill = 0.5f * S[4 * g4 + 3];
        mainv += __shfl_xor(mainv, 8); mainv += __shfl_xor(mainv, 16);
        spill += __shfl_xor(spill, 8); spill += __shfl_xor(spill, 16);
        const int blk = ((key0 + 32 * a) >> 2) + 2 * g4 + h;
        if (r < 8) { atomicAdd(&impw[r * 68 + blk], mainv); atomicAdd(&impw[r * 68 + blk + 1], spill); }
      }
    }
    if (MODE != 0) {
      bf16x8 P0 = pack8(S[0], S[1], S[2], S[3], S[4], S[5], S[6], S[7]);
      bf16x8 P1 = pack8(S[8], S[9], S[10], S[11], S[12], S[13], S[14], S[15]);
#pragma unroll
      for (int dt = 0; dt < 2; ++dt) {
        O[dt] = mfma32(pad_frag(Vt, 32 * dt + r, 4 * a + h), P0, O[dt]);
        O[dt] = mfma32(pad_frag(Vt, 32 * dt + r, 4 * a + 2 + h), P1, O[dt]);
      }
    }
  }
}

struct NsaSrc { const u16* k; long kld; const u16* v; long vld; };

constexpr int NSA_BUF = 18432;
constexpr int NSA_LDS_BIAS = 2 * NSA_BUF, NSA_LDS_IMP = NSA_LDS_BIAS + 8 * 132 * 4, NSA_LDS_Q = NSA_LDS_IMP + 4 * 8 * 68 * 4;

DI void nsa_item(const Params& p, const int bg, const int hq, char* smem) {
  char* ws = p.ws;
  const int tid = tidx(), lane = tid & 63, w = tid >> 6, r = lane & 31, h = lane >> 5;
  const int b = bg >> 1, g = bg & 1, qi = hq >> 1;
  const int t = 32 * hq + 8 * w + (r & 7);
  const int head = g * 4 + (r >> 3);
  const size_t trow = (size_t)b * SEQ + t;
  float* biasl = (float*)(smem + NSA_LDS_BIAS);
  float* impw = (float*)(smem + NSA_LDS_IMP) + w * (8 * 68);
  char* Q = smem + NSA_LDS_Q + w * 4096;
  const u16* NKV = (const u16*)(ws + OFF_NKV);
  __syncthreads();
  for (int i = tid; i < 8 * 132; i += NTHREADS) biasl[i] = ((const float*)(ws + OFF_MISC + MISC_BIAS))[i];
  for (int i = lane; i < 8 * 68; i += 64) impw[i] = 0.f;
  {
    const u16* NQ = (const u16*)(ws + OFF_NQ);
#pragma unroll
    for (int s = 0; s < 4; ++s) *(bf16x8*)(Q + (s * 64 + lane) * 16) = *(const bf16x8*)(NQ + trow * 512 + head * 64 + 16 * s + 8 * h);
  }
  const float* tab = biasl + head * 132;
  f32x16 O[2];
  float m, l, mfin = 0.f, linv = 0.f;
  u16* OB = (u16*)(ws + OFF_QKV + (size_t)NTOK * 512 * 4);
  auto reset = [&]() {
#pragma unroll
    for (int dt = 0; dt < 2; ++dt)
#pragma unroll
      for (int k = 0; k < 16; ++k) O[dt][k] = 0.f;
    m = NEGBIG; l = 0.f;
  };
  u32x4 sk[2], sv[2];
  auto stage_load = [&](const NsaSrc& s) {
#pragma unroll
    for (int i = 0; i < 2; ++i) {
      const int c = tid + 256 * i, row = c >> 3, ch = c & 7;
      sk[i] = *(const u32x4*)(s.k + (size_t)row * s.kld + ch * 8);
      sv[i] = *(const u32x4*)(s.v + (size_t)row * s.vld + ch * 8);
    }
  };
  auto stage_store = [&](char* buf) {
#pragma unroll
    for (int i = 0; i < 2; ++i) {
      const int c = tid + 256 * i, row = c >> 3, ch = c & 7;
      *(u32x4*)(buf + row * 144 + ch * 16) = sk[i];
      *(u32x4*)(buf + 9216 + row * 144 + ch * 16) = sv[i];
    }
  };
  auto src_cmp = [&](int tt) { NsaSrc s; s.k = (const u16*)(ws + OFF_KC) + ((size_t)bg * 256 + 64 * tt) * 64; s.kld = 64;
                               s.v = (const u16*)(ws + OFF_VCT) + ((size_t)bg * 4 + tt) * 4096; s.vld = 64; return s; };
  auto src_slc = [&](int j) { NsaSrc s; s.k = NKV + ((size_t)b * SEQ + 64 * j) * 768 + 256 + g * 64; s.kld = 768;
                              s.v = (const u16*)(ws + OFF_VST) + ((size_t)bg * 64 + j) * 4096; s.vld = 64; return s; };
  auto src_win = [&](int j) { NsaSrc s; s.k = NKV + ((size_t)b * SEQ + 64 * j) * 768 + 512 + g * 64; s.kld = 768;
                              s.v = (const u16*)(ws + OFF_VWT) + ((size_t)bg * 64 + j) * 4096; s.vld = 64; return s; };
  auto gatev = [&](int br) { return sigmoidf_(((const float*)(ws + OFF_SM))[trow * 40 + 16 + head * 3 + br]); };
  auto emit = [&](const float wgt, bool first) {
#pragma unroll
    for (int dt = 0; dt < 2; ++dt)
#pragma unroll
      for (int g4 = 0; g4 < 4; ++g4) {
        u16* dst = OB + trow * 512 + head * 64 + 32 * dt + 8 * g4 + 4 * h;
        float v0 = O[dt][4 * g4] * wgt, v1 = O[dt][4 * g4 + 1] * wgt, v2 = O[dt][4 * g4 + 2] * wgt, v3 = O[dt][4 * g4 + 3] * wgt;
        if (!first) {
          u32x2 old = *(const u32x2*)dst;
          v0 += bflo(old[0]); v1 += bfhi(old[0]); v2 += bflo(old[1]); v3 += bfhi(old[1]);
        }
        u32x2 o; o[0] = pack2(v0, v1); o[1] = pack2(v2, v3);
        *(u32x2*)dst = o;
      }
  };
  int it = 0;
  stage_load(src_cmp(0));
  stage_store(smem);
  __syncthreads();
  const float c31 = tab[128];
#define NSA_STEP(CALL, HAS_NEXT, NEXT_SRC) { \
    const bool hn_ = (HAS_NEXT); if (hn_) stage_load(NEXT_SRC); \
    { const char* Kt = smem + (it & 1) * NSA_BUF; const char* Vt = Kt + 9216; CALL; } \
    if (hn_) stage_store(smem + ((it + 1) & 1) * NSA_BUF); \
    __syncthreads(); ++it; }

  const int ntc = (2 * hq + 1 + 63) >> 6;
  reset();
  for (int tt = 0; tt < ntc; ++tt)
    NSA_STEP((nsa_tile<0, true>(Kt, Vt, Q, O, m, l, t, 64 * tt, true, tab, c31, mfin, linv, impw)), true, (tt + 1 < ntc) ? src_cmp(tt + 1) : src_cmp(0));
  { float lt = xhalf_sum(l); mfin = m; linv = lt > 0.f ? 1.f / lt : 0.f; }
  for (int tt = 0; tt < ntc; ++tt)
    NSA_STEP((nsa_tile<1, true>(Kt, Vt, Q, O, m, l, t, 64 * tt, true, tab, c31, mfin, linv, impw)), true, (tt + 1 < ntc) ? src_cmp(tt + 1) : src_slc(0));
  emit(gatev(0), true);
  unsigned sel_lo, sel_hi;
  if (qi < 16) {
    unsigned long long mk = (2ull << qi) - 1ull;
    sel_lo = (unsigned)mk; sel_hi = (unsigned)(mk >> 32);
  } else {
    unsigned long long mk = 0ull;
    const float* row = impw + (lane & 7) * 68;
    const int part = lane >> 3, hiM = qi - 2;
    for (int mm = 1 + part; mm <= hiM; mm += 8) {
      const float v = row[mm];
      int rank = 0;
      for (int m2 = 1; m2 <= hiM; ++m2) { const float u = row[m2]; rank += ((u > v) || (u == v && m2 < mm)) ? 1 : 0; }
      if (rank < 13) mk |= 1ull << mm;
    }
    mk |= 1ull | (1ull << qi) | (1ull << (qi - 1));
    sel_lo = (unsigned)mk; sel_hi = (unsigned)(mk >> 32);
    sel_lo |= __shfl_xor(sel_lo, 8); sel_hi |= __shfl_xor(sel_hi, 8);
    sel_lo |= __shfl_xor(sel_lo, 16); sel_hi |= __shfl_xor(sel_hi, 16);
    sel_lo |= __shfl_xor(sel_lo, 32); sel_hi |= __shfl_xor(sel_hi, 32);
  }
  reset();
  const int j0 = qi >= 8 ? qi - 8 : 0;
  for (int j = 0; j <= qi; ++j) {
    const bool lsel = ((j < 32 ? (sel_lo >> j) : (sel_hi >> (j - 32))) & 1u) != 0u;
    if (qi - j <= 2) {
      NSA_STEP((nsa_tile<2, true>(Kt, Vt, Q, O, m, l, t, 64 * j, lsel, tab, c31, mfin, linv, impw)), true, (j < qi) ? src_slc(j + 1) : src_win(j0));
    } else {
      NSA_STEP((nsa_tile<2, false>(Kt, Vt, Q, O, m, l, t, 64 * j, lsel, tab, c31, mfin, linv, impw)), true, src_slc(j + 1));
    }
  }
  { float lt = xhalf_sum(l); emit(lt > 0.f ? gatev(1) / lt : 0.f, false); }
  reset();
  for (int j = j0; j <= qi; ++j) {
    if ((qi - j <= 2) || (qi - j == 8)) {
      NSA_STEP((nsa_tile<3, true>(Kt, Vt, Q, O, m, l, t, 64 * j, true, tab, c31, mfin, linv, impw)), j < qi, src_win(j + 1));
    } else {
      NSA_STEP((nsa_tile<3, false>(Kt, Vt, Q, O, m, l, t, 64 * j, true, tab, c31, mfin, linv, impw)), true, src_win(j + 1));
    }
  }
#undef NSA_STEP
  { float lt = xhalf_sum(l); emit(lt > 0.f ? gatev(2) / lt : 0.f, false); }
}

DI void phase4(const Params& p, char* smem, int   = 0) {
  const int bid = blockIdx.x, nblk = gridDim.x;
  if (nblk < 128) {
    for (int it = bid; it < 64 + 2048; it += nblk) {
      if (it < 64) gdn_scan_item(p, it, smem);
      else { const int k = it - 64; nsa_item(p, k & 15, 127 - (k >> 4), smem); }
    }
    convert_fp8_rows(p.expert_u, (unsigned char*)(p.ws + OFF_EU), (float*)(p.ws + OFF_MISC + MISC_SCU), 16384, bid, nblk);
    convert_fp8_rows(p.expert_v, (unsigned char*)(p.ws + OFF_EV), (float*)(p.ws + OFF_MISC + MISC_SCV), 16384, bid, nblk);
    return;
  }
  if (bid < 64) {
    gdn_scan_item(p, bid, smem);
    convert_fp8_rows(p.expert_u, (unsigned char*)(p.ws + OFF_EU), (float*)(p.ws + OFF_MISC + MISC_SCU), 16384, bid, 64);
    convert_fp8_rows(p.expert_v, (unsigned char*)(p.ws + OFF_EV), (float*)(p.ws + OFF_MISC + MISC_SCV), 16384, bid, 64);
    return;
  }
  const int nb = nblk - 64, c = bid - 64;
  for (int r = 0;; ++r) {
    const int k = r * nb + ((r & 1) ? (nb - 1 - c) : c);
    if (k >= 2048) break;
    nsa_item(p, k & 15, 127 - (k >> 4), smem);
  }
}

DI void phase_branch(const Params& p, int bid, int nblk, char* smem) {
  char* ws = p.ws;
  const u16* OA = (const u16*)(ws + OFF_Z);
  const u16* OB = (const u16*)(ws + OFF_QKV + (size_t)NTOK * 512 * 4);
  const u16* MG = (const u16*)(ws + OFF_MG);
  u16* MIX = (u16*)(ws + OFF_RH);
  for (int k = 0;; ++k) {
    int mt, nt;
    if (!xcd_tile(k, bid, nblk, 256, 8, mt, nt)) break;
    const int m0 = mt * 128, n0 = nt * 128;
    GemmPtrs g;
    f32x16 acc[2][2];
    gemm_setup(g, OA, 512, m0, (const u16*)(ws + OFF_WAT), 512, n0);
    zero_acc(acc);
    gemm_kloop(acc, g, 8, smem);
    gemm_epilogue_lds(acc, smem, [&](int ml, int nl, const float (&v)[8]) {
      const size_t m = m0 + ml; const int n = n0 + nl;
      const u32x4 gt = *(const u32x4*)(MG + m * 2048 + n);
      float t[8];
#pragma unroll
      for (int e = 0; e < 4; ++e) { t[2 * e] = v[2 * e] * sigmoidf_(bflo(gt[e])); t[2 * e + 1] = v[2 * e + 1] * sigmoidf_(bfhi(gt[e])); }
      *(u32x4*)(MIX + m * 1024 + n) = pack8u(t);
    });
    gemm_setup(g, OB, 512, m0, (const u16*)(ws + OFF_WBT), 512, n0);
    zero_acc(acc);
    gemm_kloop(acc, g, 8, smem);
    gemm_epilogue_lds(acc, smem, [&](int ml, int nl, const float (&v)[8]) {
      const size_t m = m0 + ml; const int n = n0 + nl;
      const u32x4 gt = *(const u32x4*)(MG + m * 2048 + 1024 + n);
      const u32x4 old = *(const u32x4*)(MIX + m * 1024 + n);
      float t[8];
#pragma unroll
      for (int e = 0; e < 4; ++e) {
        t[2 * e] = bflo(old[e]) + v[2 * e] * sigmoidf_(bflo(gt[e]));
        t[2 * e + 1] = bfhi(old[e]) + v[2 * e + 1] * sigmoidf_(bfhi(gt[e]));
      }
      *(u32x4*)(MIX + m * 1024 + n) = pack8u(t);
    });
  }
}

DI void phase_outproj(const Params& p, int bid, int nblk, char* smem) {
  char* ws = p.ws;
  const u16* MIX = (const u16*)(ws + OFF_RH);
  for (int k = 0;; ++k) {
    int mt, nt;
    if (!xcd_tile(k, bid, nblk, 256, 8, mt, nt)) break;
    const int m0 = mt * 128, n0 = nt * 128;
    GemmPtrs g;
    f32x16 acc[2][2];
    gemm_setup(g, MIX, 1024, m0, (const u16*)(ws + OFF_WOT), 1024, n0);
    zero_acc(acc);
    gemm_kloop(acc, g, 16, smem);
    gemm_epilogue_lds(acc, smem, [&](int ml, int nl, const float (&v)[8]) {
      const size_t idx = (size_t)(m0 + ml) * 1024 + n0 + nl;
      const f32x4 x0 = *(const f32x4*)(p.x + idx), x1 = *(const f32x4*)(p.x + idx + 4);
      float* X1 = (float*)(ws + OFF_QKV);
      *(f32x4*)(X1 + idx) = f32x4{x0[0] + v[0], x0[1] + v[1], x0[2] + v[2], x0[3] + v[3]};
      *(f32x4*)(X1 + idx + 4) = f32x4{x1[0] + v[4], x1[1] + v[5], x1[2] + v[6], x1[3] + v[7]};
    });
  }
}

DI void phase_query(const Params& p, int bid, int nblk, char* smem) {
  char* ws = p.ws;
  const u16* H2 = (const u16*)(ws + OFF_RH);
  u16* QRY = (u16*)(ws + OFF_MG);
  for (int k = 0;; ++k) {
    int mt, nt;
    if (!xcd_tile(k, bid, nblk, 256, 16, mt, nt)) break;
    const int m0 = mt * 128, n0 = nt * 128;
    GemmPtrs g;
    f32x16 acc[2][2];
    gemm_setup(g, H2, 1024, m0, (const u16*)(ws + OFF_WQT), 1024, n0);
    zero_acc(acc);
    gemm_kloop(acc, g, 16, smem);
    gemm_epilogue_lds(acc, smem, [&](int ml, int nl, const float (&v)[8]) { *(u32x4*)(QRY + (size_t)(m0 + ml) * 2048 + n0 + nl) = pack8u(v); });
  }
}

DI unsigned f2ord(float f) { unsigned u = __float_as_uint(f); return (u & 0x80000000u) ? ~u : (u | 0x80000000u); }
DI float ord2f(unsigned o) { unsigned u = (o & 0x80000000u) ? (o & 0x7fffffffu) : ~o; return __uint_as_float(u); }

DI void peer_route_job(const Params& p, int job, char* smem) {
  char* ws = p.ws;
  const int mt = job >> 3, hd = job & 7, m0 = mt * 128;
  const u16* H2 = (const u16*)(ws + OFF_RH);
  const u16* WQ = (const u16*)(ws + OFF_WQT);
  const u16* SK = (const u16*)(ws + OFF_SK);
  unsigned* keys = (unsigned*)smem;
  unsigned char* idxs = (unsigned char*)(smem + 67584);
  const int tid = tidx() + opaque0();
  float v1[16], v2[16];
#pragma unroll
  for (int pp = 0; pp < 2; ++pp) {
    GemmPtrs g;
    f32x16 acc[2][2];
    gemm_setup(g, H2, 1024, m0, WQ, 1024, (hd * 2 + pp) * 128);
    zero_acc(acc);
    gemm_kloop(acc, g, 16, smem);
    {
      const int lane = tid & 63, w = tid >> 6, wm = w >> 1, wn = w & 1, r = lane & 31, h = lane >> 5;
#pragma unroll
      for (int i = 0; i < 2; ++i)
#pragma unroll
        for (int j = 0; j < 2; ++j)
          {
            const int nl = wn * 64 + j * 32 + r;
            char* colbase = smem + (nl >> 6) * 32768 + (nl & 7) * 2;
            const int chn = (nl & 63) >> 3;
#pragma unroll
            for (int k = 0; k < 16; ++k) {
              const int ml = wm * 64 + i * 32 + (k & 3) + 8 * (k >> 2) + 4 * h;
              *(u16*)(colbase + swz(ml, chn)) = f2bf(acc[i][j][k]);
              if ((k & 3) == 3) asm volatile("" ::: "memory");
            }
          }
      const u16* skt = SK + (size_t)(hd * 2 + pp) * 128 * 128;
      char* dstB = smem + 16384 + (w * 4) * 1024 + lane * 16;
#pragma unroll
      for (int i = 0; i < 4; ++i) {
        const int rw = glds_row(i), ch = glds_chunk(rw);
        glds16(skt + (size_t)rw * 128 + ch * 8, dstB + i * 1024);
        glds16(skt + (size_t)rw * 128 + 64 + ch * 8, dstB + 32768 + i * 1024);
      }
      asm volatile("s_waitcnt vmcnt(0)" ::: "memory");
      __syncthreads();
      zero_acc(acc);
#pragma unroll
      for (int kt = 0; kt < 2; ++kt) {
        const char* A = smem + kt * 32768;
        const char* B = A + 16384;
#pragma unroll
        for (int s4 = 0; s4 < 4; ++s4) {
          bf16x8 a0 = lds_frag(A, wm * 64 + r, 2 * s4 + h);
          bf16x8 a1 = lds_frag(A, wm * 64 + 32 + r, 2 * s4 + h);
          bf16x8 b0 = lds_frag(B, wn * 64 + r, 2 * s4 + h);
          bf16x8 b1 = lds_frag(B, wn * 64 + 32 + r, 2 * s4 + h);
          acc[0][0] = mfma32(a0, b0, acc[0][0]);
          acc[0][1] = mfma32(a0, b1, acc[0][1]);
          acc[1][0] = mfma32(a1, b0, acc[1][0]);
          acc[1][1] = mfma32(a1, b1, acc[1][1]);
        }
      }
      __syncthreads();
    }
    gemm_epilogue(acc, [&](int ml, int nl, float v) { keys[ml * 132 + nl] = (f2ord(v) & ~127u) | (unsigned)(127 - nl); });
    __syncthreads();
    {
      const int t2 = tidx(), row = t2 >> 1, half = t2 & 1;
      unsigned kr[64];
#pragma unroll
      for (int j = 0; j < 16; ++j) {
        const u32x4 q4 = *(const u32x4*)(keys + row * 132 + half * 64 + 4 * j);
        kr[4 * j] = q4[0]; kr[4 * j + 1] = q4[1]; kr[4 * j + 2] = q4[2]; kr[4 * j + 3] = q4[3];
      }
      unsigned prev = 0xffffffffu;
#pragma unroll
      for (int rd = 0; rd < 16; ++rd) {
        unsigned best = 0u;
#pragma unroll
        for (int j = 0; j < 64; ++j) { const unsigned k = (kr[j] < prev) ? kr[j] : 0u; best = (k > best) ? k : best; }
        const unsigned other = (unsigned)__shfl_xor((int)best, 1);
        best = best > other ? best : other;
        prev = best;
        const float val = ord2f(best & ~127u);
        if (pp == 0) v1[rd] = val; else v2[rd] = val;
        if (half == 0) idxs[row * 32 + pp * 16 + rd] = (unsigned char)(127u - (best & 127u));
      }
    }
    __syncthreads();
  }
  const int t3 = tidx(), row = t3 >> 1, half = t3 & 1;
  unsigned ck[25];
  {
    constexpr int CI[50] = {0,0,0,0,0,0,0,0,0,0,0,0,0,0,0,0, 1,1,1,1,1,1,1,1, 2,2,2,2,2, 3,3,3,3, 4,4,4, 5,5, 6,6, 7,7, 8, 9, 10, 11, 12, 13, 14, 15};
    constexpr int CJ[50] = {0,1,2,3,4,5,6,7,8,9,10,11,12,13,14,15, 0,1,2,3,4,5,6,7, 0,1,2,3,4, 0,1,2,3, 0,1,2, 0,1, 0,1, 0,1, 0, 0, 0, 0, 0, 0, 0, 0};
#pragma unroll
    for (int c = 0; c < 25; ++c) {
      const float a = half ? v1[CI[2 * c + 1]] : v1[CI[2 * c]];
      const float b = half ? v2[CJ[2 * c + 1]] : v2[CJ[2 * c]];
      const int fl = half ? (16 * CI[2 * c + 1] + CJ[2 * c + 1]) : (16 * CI[2 * c] + CJ[2 * c]);
      ck[c] = (f2ord(a + b) & ~255u) | (unsigned)(255 - fl);
    }
  }
  int* EI = (int*)(ws + OFF_NQ) + ((size_t)(m0 + row) * 128 + hd * 16);
  float* GT = (float*)(ws + OFF_NKV) + ((size_t)(m0 + row) * 128 + hd * 16);
  float selv[16];
  unsigned prev = 0xffffffffu;
#pragma unroll
  for (int rd = 0; rd < 16; ++rd) {
    unsigned best = 0u;
#pragma unroll
    for (int c = 0; c < 25; ++c) { unsigned k = (ck[c] < prev) ? ck[c] : 0u; best = (k > best) ? k : best; }
    const unsigned other = (unsigned)__shfl_xor((int)best, 1);
    best = best > other ? best : other;
    prev = best;
    const int flat = 255 - (int)(best & 255u);
    selv[rd] = ord2f(best & ~255u);
    if (half == 0) EI[rd] = (int)idxs[row * 32 + (flat >> 4)] * 128 + (int)idxs[row * 32 + 16 + (flat & 15)];
  }
  float sum = 0.f;
  const float mx = selv[0];
#pragma unroll
  for (int k = 0; k < 16; ++k) { selv[k] = __expf(selv[k] - mx); sum += selv[k]; }
  const float inv = 1.f / sum;
  if (half == 0) {
#pragma unroll
    for (int k = 0; k < 16; ++k) GT[k] = selv[k] * inv;
  }
}

DI float gelu_tanh(float x) {
  const float u = 0.7978845608028654f * (x + 0.044715f * x * x * x);
  const float e = __expf(2.f * u);
  const float th = 1.f - 2.f / (e + 1.f);
  return 0.5f * x * (1.f + th);
}
DI void peer_expert_phase(const Params& p, int bid, int nblk) {
  char* ws = p.ws;
  const int lane = tidx() & 63, wv = tidx() >> 6;
  const unsigned char* EU = (const unsigned char*)(ws + OFF_EU);
  const unsigned char* EV = (const unsigned char*)(ws + OFF_EV);
  const float* SCU = (const float*)(ws + OFF_MISC + MISC_SCU);
  const float* SCV = (const float*)(ws + OFF_MISC + MISC_SCV);
  const int* EI = (const int*)(ws + OFF_NQ);
  const float* GT = (const float*)(ws + OFF_NKV);
  for (int tok = bid * 4 + wv; tok < NTOK; tok += nblk * 4) {
    const float* xr = (const float*)(ws + OFF_QKV) + (size_t)tok * 1024 + 16 * lane;
    f32x4 xa[4];
    float ss = 0.f;
#pragma unroll
    for (int i = 0; i < 4; ++i) { xa[i] = *(const f32x4*)(xr + 4 * i); ss += xa[i][0] * xa[i][0] + xa[i][1] * xa[i][1] + xa[i][2] * xa[i][2] + xa[i][3] * xa[i][3]; }
    ss = wave_sum(ss);
    const float rs = rsqrtf(ss * (1.f / 1024.f) + 1e-6f);
    f32x2 h2[8];
#pragma unroll
    for (int i = 0; i < 4; ++i) {
      const f32x4 w4 = *(const f32x4*)(p.norm_ffn + 16 * lane + 4 * i);
      h2[2 * i] = f32x2{bf2f(f2bf(xa[i][0] * rs * w4[0])), bf2f(f2bf(xa[i][1] * rs * w4[1]))};
      h2[2 * i + 1] = f32x2{bf2f(f2bf(xa[i][2] * rs * w4[2])), bf2f(f2bf(xa[i][3] * rs * w4[3]))};
    }
    f32x2 outv[8];
#pragma unroll
    for (int i = 0; i < 8; ++i) outv[i] = f32x2{0.f, 0.f};
#pragma unroll 1
    for (int bt = 0; bt < 2; ++bt) {
      const int eidx = EI[(size_t)tok * 128 + bt * 64 + lane];
      const float gt = GT[(size_t)tok * 128 + bt * 64 + lane];
      const float su = SCU[eidx], sv = SCV[eidx];
      float acc[64];
      {
        u32x4 cur[8], nxt[8];
#pragma unroll
        for (int j = 0; j < 8; ++j) cur[j] = *(const u32x4*)(EU + (size_t)__builtin_amdgcn_readlane(eidx, j) * 1024 + 16 * lane);
#pragma unroll
        for (int g = 0; g < 8; ++g) {
          if (g < 7) {
#pragma unroll
            for (int j = 0; j < 8; ++j) nxt[j] = *(const u32x4*)(EU + (size_t)__builtin_amdgcn_readlane(eidx, 8 * (g + 1) + j) * 1024 + 16 * lane);
          }
#pragma unroll
          for (int j = 0; j < 8; ++j) {
            f32x2 d = f32x2{0.f, 0.f};
#pragma unroll
            for (int i = 0; i < 4; ++i) {
              d += __builtin_amdgcn_cvt_pk_f32_fp8(cur[j][i], false) * h2[2 * i];
              d += __builtin_amdgcn_cvt_pk_f32_fp8(cur[j][i], true) * h2[2 * i + 1];
            }
            acc[8 * g + j] = d[0] + d[1];
          }
#pragma unroll
          for (int j = 0; j < 8; ++j) cur[j] = nxt[j];
        }
      }
#pragma unroll
      for (int st = 0; st < 6; ++st) {
        const int half = 32 >> st;
        const bool up = (lane & half) != 0;
#pragma unroll
        for (int k = 0; k < half; ++k) {
          const float send = up ? acc[k] : acc[k + half];
          const float keep = up ? acc[k + half] : acc[k];
          acc[k] = keep + __shfl_xor(send, half);
        }
      }
      const float wgt = gt * gelu_tanh(acc[0] * su) * sv;
      {
        u32x4 cur[8], nxt[8];
#pragma unroll
        for (int j = 0; j < 8; ++j) cur[j] = *(const u32x4*)(EV + (size_t)__builtin_amdgcn_readlane(eidx, j) * 1024 + 16 * lane);
#pragma unroll
        for (int g = 0; g < 8; ++g) {
          if (g < 7) {
#pragma unroll
            for (int j = 0; j < 8; ++j) nxt[j] = *(const u32x4*)(EV + (size_t)__builtin_amdgcn_readlane(eidx, 8 * (g + 1) + j) * 1024 + 16 * lane);
          }
#pragma unroll
          for (int j = 0; j < 8; ++j) {
            const float we = __uint_as_float((unsigned)__builtin_amdgcn_readlane((int)__float_as_uint(wgt), 8 * g + j));
            const f32x2 w2 = f32x2{we, we};
#pragma unroll
            for (int i = 0; i < 4; ++i) {
              outv[2 * i] += __builtin_amdgcn_cvt_pk_f32_fp8(cur[j][i], false) * w2;
              outv[2 * i + 1] += __builtin_amdgcn_cvt_pk_f32_fp8(cur[j][i], true) * w2;
            }
          }
#pragma unroll
          for (int j = 0; j < 8; ++j) cur[j] = nxt[j];
        }
      }
    }
    float s2 = 0.f;
#pragma unroll
    for (int i = 0; i < 4; ++i) {
      xa[i][0] += outv[2 * i][0]; xa[i][1] += outv[2 * i][1]; xa[i][2] += outv[2 * i + 1][0]; xa[i][3] += outv[2 * i + 1][1];
      s2 += xa[i][0] * xa[i][0] + xa[i][1] * xa[i][1] + xa[i][2] * xa[i][2] + xa[i][3] * xa[i][3];
    }
    s2 = wave_sum(s2);
    const float r2 = rsqrtf(s2 * (1.f / 1024.f) + 1e-6f);
    float* orow = p.out + (size_t)tok * 1024 + 16 * lane;
#pragma unroll
    for (int i = 0; i < 4; ++i) {
      const f32x4 nw = *(const f32x4*)(p.norm_final + 16 * lane + 4 * i);
      *(f32x4*)(orow + 4 * i) = f32x4{xa[i][0] * r2 * nw[0], xa[i][1] * r2 * nw[1], xa[i][2] * r2 * nw[2], xa[i][3] * r2 * nw[3]};
    }
  }
}

#ifndef MK_SINGLE
#define MK_SINGLE 1
#endif
#define SMEM_DECL __shared__ __attribute__((aligned(16))) char smem[SMEM_BYTES]

DI void run_phase(const Params& p, int ph, int bid, int nblk, char* smem) {
  switch (ph) {
    case 0: phase0(p, bid, nblk, smem); break;
    case 1: phase_inproj(p, bid, nblk, smem); break;
    case 2: phase2(p, bid, nblk, smem); break;
    case 3: phase4(p, smem); break;
    case 4: phase_branch(p, bid, nblk, smem); break;
    case 5: phase_outproj(p, bid, nblk, smem); break;
    case 6: rmsnorm_rows_bf16((const float*)(p.ws + OFF_QKV), p.norm_ffn, (u16*)(p.ws + OFF_RH), NTOK, bid, nblk); break;
    case 7: for (int j = bid; j < 2048; j += nblk) peer_route_job(p, j, smem); break;
    case 8: peer_expert_phase(p, bid, nblk); break;
  }
}
constexpr int NPHASES = 9;

#if MK_SINGLE
DI void grid_barrier(unsigned* ctr, unsigned target) {
  asm volatile("s_waitcnt vmcnt(0)" ::: "memory");
  __syncthreads();
  if (tidx() == 0) {
    __builtin_amdgcn_fence(__ATOMIC_RELEASE, "agent");
    asm volatile("s_waitcnt vmcnt(0)" ::: "memory");
    __hip_atomic_fetch_add(ctr, 1u, __ATOMIC_RELAXED, __HIP_MEMORY_SCOPE_AGENT);
    while (__hip_atomic_load(ctr, __ATOMIC_RELAXED, __HIP_MEMORY_SCOPE_AGENT) < target) __builtin_amdgcn_s_sleep(2);
    __builtin_amdgcn_fence(__ATOMIC_ACQUIRE, "agent");
    asm volatile("s_waitcnt vmcnt(0)" ::: "memory");
  }
  __syncthreads();
}
#ifndef MK_PROBE_SPLIT
#define MK_PROBE_SPLIT 0
#endif
#ifndef PROBE_P4
#define PROBE_P4 103
#endif
#ifndef PROBE_REPEAT
#define PROBE_REPEAT 0
#endif
#if MK_PROBE_SPLIT
__global__ void __launch_bounds__(NTHREADS, 2) fwd_megakernel(Params p, int phase_sel) {
#else
__global__ void __launch_bounds__(NTHREADS, 2) fwd_megakernel(Params p) {
#endif
  SMEM_DECL;
  cg::grid_group grid = cg::this_grid();
  const int bid = blockIdx.x, nblk = gridDim.x;
  unsigned* bar = (unsigned*)(p.ws + OFF_MISC + MISC_CNT) + 8;
#if MK_PROBE_SPLIT
  switch (phase_sel) {
    case 0: run_phase(p, 0, bid, nblk, smem); break;
    case 1: run_phase(p, 1, bid, nblk, smem); break;
    case 2: run_phase(p, 2, bid, nblk, smem); break;
    case 3: run_phase(p, 3, bid, nblk, smem); break;
    case 103: phase4(p, smem, 1); break;
    case 203: phase4(p, smem, 2); break;
    case 4: run_phase(p, 4, bid, nblk, smem); break;
    case 5: run_phase(p, 5, bid, nblk, smem); break;
    case 6: run_phase(p, 6, bid, nblk, smem); break;
    case 7: run_phase(p, 7, bid, nblk, smem); break;
    default: run_phase(p, 8, bid, nblk, smem); break;
  }
  if (phase_sel < 0) { grid.sync(); grid_barrier(bar, 1u); }
#else
  run_phase(p, 0, bid, nblk, smem); grid.sync();
  run_phase(p, 1, bid, nblk, smem); grid_barrier(bar, 1u * nblk);
  run_phase(p, 2, bid, nblk, smem); grid_barrier(bar, 2u * nblk);
  run_phase(p, 3, bid, nblk, smem); grid_barrier(bar, 3u * nblk);
  run_phase(p, 4, bid, nblk, smem); grid_barrier(bar, 4u * nblk);
  run_phase(p, 5, bid, nblk, smem); grid_barrier(bar, 5u * nblk);
  run_phase(p, 6, bid, nblk, smem); grid_barrier(bar, 6u * nblk);
  run_phase(p, 7, bid, nblk, smem); grid_barrier(bar, 7u * nblk);
  run_phase(p, 8, bid, nblk, smem);
#endif
}
#else
template <int PH>
__global__ void __launch_bounds__(NTHREADS, 2) phase_kernel(Params p) {
  SMEM_DECL;
  run_phase(p, PH, blockIdx.x, gridDim.x, smem);
}
__global__ void __launch_bounds__(NTHREADS, 2) phase4_again(Params p) { SMEM_DECL; phase4(p, smem, 1); }
#ifndef REPEAT_MASK
#define REPEAT_MASK 0
#endif
#endif

extern "C" void kernel_launch(void* const* d_in, const int* in_sizes, int n_in, void* d_out, int out_size, void* d_ws, size_t ws_size,
                              hipStream_t stream) {
  Params p{};
  const float** f = (const float**)&p;
  for (int i = 0; i < 21; ++i) f[i] = (const float*)d_in[i];
  p.out = (float*)d_out;
  p.ws = (char*)d_ws;
  if (ws_size < WS_NEEDED) return;
#if MK_SINGLE
  static int grid_blocks = 0;
  if (!grid_blocks) {
    int dev = 0, cus = 0, per_cu = 0;
    hipGetDevice(&dev);
    hipDeviceGetAttribute(&cus, hipDeviceAttributeMultiprocessorCount, dev);
    hipOccupancyMaxActiveBlocksPerMultiprocessor(&per_cu, fwd_megakernel, NTHREADS, 0);
    if (per_cu > 2) per_cu = 2;
    grid_blocks = cus * per_cu;
  }
#if MK_PROBE_SPLIT
  for (int ph = 0; ph < NPHASES; ++ph) {
    fwd_megakernel<<<grid_blocks, NTHREADS, 0, stream>>>(p, ph);
    if ((PROBE_REPEAT >> ph) & 1) fwd_megakernel<<<grid_blocks, NTHREADS, 0, stream>>>(p, ph == 3 ? PROBE_P4 : ph);
  }
#else
  void* args[] = {&p};
  hipLaunchCooperativeKernel((void*)fwd_megakernel, dim3(grid_blocks), dim3(NTHREADS), args, 0, stream);
#endif
#else
  const int G = 512;
  phase_kernel<0><<<G, NTHREADS, 0, stream>>>(p);
#if REPEAT_MASK & (1 << 0)
  phase_kernel<0><<<G, NTHREADS, 0, stream>>>(p);
#endif
  phase_kernel<1><<<G, NTHREADS, 0, stream>>>(p);
#if REPEAT_MASK & (1 << 1)
  phase_kernel<1><<<G, NTHREADS, 0, stream>>>(p);
#endif
  phase_kernel<2><<<G, NTHREADS, 0, stream>>>(p);
#if REPEAT_MASK & (1 << 2)
  phase_kernel<2><<<G, NTHREADS, 0, stream>>>(p);
#endif
  phase_kernel<3><<<G, NTHREADS, 0, stream>>>(p);
#if REPEAT_MASK & (1 << 3)
  phase4_again<<<G, NTHREADS, 0, stream>>>(p);
#endif
  phase_kernel<4><<<G, NTHREADS, 0, stream>>>(p);
#if REPEAT_MASK & (1 << 4)
  phase_kernel<4><<<G, NTHREADS, 0, stream>>>(p);
#endif
  phase_kernel<5><<<G, NTHREADS, 0, stream>>>(p);
#if REPEAT_MASK & (1 << 5)
  phase_kernel<5><<<G, NTHREADS, 0, stream>>>(p);
#endif
  phase_kernel<6><<<G, NTHREADS, 0, stream>>>(p);
#if REPEAT_MASK & (1 << 6)
  phase_kernel<6><<<G, NTHREADS, 0, stream>>>(p);
#endif
  phase_kernel<7><<<G, NTHREADS, 0, stream>>>(p);
#if REPEAT_MASK & (1 << 7)
  phase_kernel<7><<<G, NTHREADS, 0, stream>>>(p);
#endif
  phase_kernel<8><<<G, NTHREADS, 0, stream>>>(p);
#if REPEAT_MASK & (1 << 8)
  phase_kernel<8><<<G, NTHREADS, 0, stream>>>(p);
#endif
#endif
}
```

```cpp
#include <hip/hip_runtime.h>
#include <hip/hip_cooperative_groups.h>
#include <stdint.h>
namespace cg = cooperative_groups;

#define DI __device__ __forceinline__
typedef unsigned short u16;
typedef __attribute__((ext_vector_type(8))) short bf16x8;
typedef __attribute__((ext_vector_type(16))) float f32x16;
typedef __attribute__((ext_vector_type(4))) float f32x4;
typedef __attribute__((ext_vector_type(4))) unsigned u32x4;
typedef __attribute__((ext_vector_type(2))) unsigned u32x2;
typedef __attribute__((ext_vector_type(2))) __bf16 bf16x2v;

constexpr int BATCH = 8, SEQ = 4096, DM = 1024, NTOK = BATCH * SEQ;
constexpr int NIN = 5416, NP = 5504;
constexpr int NTHREADS = 256;
constexpr int SMEM_BYTES = 72 * 1024;
constexpr float L2E = 1.4426950408889634f;

constexpr size_t AL(size_t x) { return (x + 255) & ~(size_t)255; }
constexpr size_t OFF_WINT = 0;
constexpr size_t OFF_WAT = OFF_WINT + AL((size_t)NP * 1024 * 2);
constexpr size_t OFF_WBT = OFF_WAT + AL((size_t)1024 * 512 * 2);
constexpr size_t OFF_WOT = OFF_WBT + AL((size_t)1024 * 512 * 2);
constexpr size_t OFF_WQT = OFF_WOT + AL((size_t)1024 * 1024 * 2);
constexpr size_t OFF_SK = OFF_WQT + AL((size_t)2048 * 1024 * 2);
constexpr size_t OFF_WKT = OFF_SK + AL((size_t)16 * 128 * 128 * 2);
constexpr size_t OFF_WVT = OFF_WKT + AL((size_t)128 * 2048 * 2);
constexpr size_t OFF_EU = OFF_WVT + AL((size_t)128 * 2048 * 2);
constexpr size_t OFF_EV = OFF_EU + AL((size_t)16384 * 1024 * 2);
constexpr size_t OFF_MISC = OFF_EV + AL((size_t)16384 * 1024 * 2);
constexpr size_t MISC_CK = 0, MISC_CV = 256, MISC_BIAS = 512, MISC_CNT = 512 + 8 * 132 * 4 + 256, MISC_GL = 8192;
constexpr size_t MISC_SCU = 65536, MISC_SCV = 131072;
constexpr size_t OFF_RH = OFF_MISC + 262144;
constexpr size_t OFF_QKV = OFF_RH + (size_t)NTOK * 1024 * 2;
constexpr size_t OFF_Z = OFF_QKV + (size_t)NTOK * 1536 * 2;
constexpr size_t OFF_NQ = OFF_Z + (size_t)NTOK * 512 * 2;
constexpr size_t OFF_NKV = OFF_NQ + (size_t)NTOK * 512 * 2;
constexpr size_t OFF_MG = OFF_NKV + (size_t)NTOK * 768 * 2;
constexpr size_t OFF_SM = OFF_MG + (size_t)NTOK * 2048 * 2;
constexpr size_t OFF_VST = OFF_SM + AL((size_t)NTOK * 40 * 4);
constexpr size_t OFF_VWT = OFF_VST + (size_t)16 * 64 * 4096 * 2;
constexpr size_t OFF_KC = OFF_VWT + (size_t)16 * 64 * 4096 * 2;
constexpr size_t OFF_VCT = OFF_KC + (size_t)16 * 256 * 64 * 2;
constexpr size_t WS_NEEDED = OFF_VCT + (size_t)16 * 64 * 256 * 2;

struct Params {
  const float *x, *rel_bias, *norm_final, *norm_mix, *w_in, *conv_w, *a_log, *dt_bias, *gdn_norm, *cmp_pe_k, *cmp_pe_v,
      *cmp_w_k, *cmp_w_v, *w_a, *w_b, *w_out, *norm_ffn, *w_query, *sub_keys, *expert_u, *expert_v;
  float* out;
  char* ws;
};

DI u16 f2bf(float x) { return __builtin_bit_cast(u16, (__bf16)x); }
DI float bf2f(u16 b) { return __uint_as_float(((unsigned)b) << 16); }
typedef __attribute__((ext_vector_type(2))) float f32x2_;
typedef __attribute__((ext_vector_type(2))) __bf16 bf16x2_;
DI unsigned pack2(float lo, float hi) { f32x2_ v = {lo, hi}; return __builtin_bit_cast(unsigned, __builtin_convertvector(v, bf16x2_)); }
DI float bflo(unsigned u) { return __uint_as_float(u << 16); }
DI float bfhi(unsigned u) { return __uint_as_float(u & 0xffff0000u); }
DI float wave_sum(float v) {
#pragma unroll
  for (int o = 32; o >= 1; o >>= 1) v += __shfl_xor(v, o);
  return v;
}
DI int tidx() { int t = (int)__builtin_amdgcn_workitem_id_x(); asm volatile("" : "+v"(t)); return t; }
DI int opaque0() { int z = 0; asm volatile("" : "+v"(z)); return z; }
template <int CTRL> DI float dppf(float x) { return __uint_as_float((unsigned)__builtin_amdgcn_mov_dpp((int)__float_as_uint(x), CTRL, 0xF, 0xF, true)); }
DI float dpp_xor1(float x) { return __uint_as_float((unsigned)__builtin_amdgcn_mov_dpp((int)__float_as_uint(x), 0xB1, 0xF, 0xF, true)); }
DI unsigned dpp_xor1u(unsigned x) { return (unsigned)__builtin_amdgcn_mov_dpp((int)x, 0xB1, 0xF, 0xF, true); }
DI float sigmoidf_(float x) { return 1.f / (1.f + __expf(-x)); }
DI f32x16 mfma32(bf16x8 a, bf16x8 b, f32x16 c) { return __builtin_amdgcn_mfma_f32_32x32x16_bf16(a, b, c, 0, 0, 0); }
DI f32x4 mfma16(bf16x8 a, bf16x8 b, f32x4 c) { return __builtin_amdgcn_mfma_f32_16x16x32_bf16(a, b, c, 0, 0, 0); }
DI int swz(int row, int ch) { return row * 128 + ((ch ^ ((row >> 1) & 7)) << 4); }
DI bf16x8 lds_frag(const char* tile, int row, int ch) { return *(const bf16x8*)(tile + swz(row, ch)); }
DI bf16x8 pad_frag(const char* tile, int row, int ch) { return *(const bf16x8*)(tile + row * 144 + ch * 16); }
DI bf16x8 pack8(float a0, float a1, float a2, float a3, float a4, float a5, float a6, float a7) {
  u32x4 p;
  p[0] = pack2(a0, a1); p[1] = pack2(a2, a3); p[2] = pack2(a4, a5); p[3] = pack2(a6, a7);
  return __builtin_bit_cast(bf16x8, p);
}
DI int perm16(int o) { return (o & ~12) | ((o & 4) << 1) | ((o & 8) >> 1); }

DI int win_colmap(int n) {
  if (n < 2048) return n;
  if (n < 2560) return n - 2048 + 2064;
  if (n < 3328) return n - 2560 + 2576;
  if (n < 5376) return n - 3328 + 3368;
  if (n < 5392) return n - 5376 + 2048;
  if (n < 5416) return n - 5392 + 3344;
  return -1;
}
template <int MAPMODE>
DI void tconv_tile(const float* __restrict__ src, int K, int N, u16* __restrict__ dst, int kt, int nt, char* smem, const float* kscale = nullptr) {
  float* tile = (float*)smem;
  const int tid = tidx();
  const int nl = tid & 63, k0 = kt * 64, n0 = nt * 64;
  int col;
  if (MAPMODE == 1) col = win_colmap(n0 + nl); else col = (n0 + nl < N) ? (n0 + nl) : -1;
#pragma unroll 4
  for (int i = 0; i < 16; ++i) {
    int kl = (tid >> 6) + 4 * i;
    float v = (col >= 0) ? src[(size_t)(k0 + kl) * N + col] : 0.f;
    if (kscale) v *= kscale[k0 + kl];
    tile[kl * 65 + nl] = v;
  }
  __syncthreads();
  {
    const int n2 = tid >> 2, kp = tid & 3;
    u32x4 o0, o1;
#pragma unroll
    for (int i = 0; i < 4; ++i) {
      o0[i] = pack2(tile[(kp * 16 + 2 * i) * 65 + n2], tile[(kp * 16 + 2 * i + 1) * 65 + n2]);
      o1[i] = pack2(tile[(kp * 16 + 8 + 2 * i) * 65 + n2], tile[(kp * 16 + 8 + 2 * i + 1) * 65 + n2]);
    }
    u16* d = dst + (size_t)(n0 + n2) * K + k0 + kp * 16;
    *(u32x4*)d = o0;
    *(u32x4*)(d + 8) = o1;
  }
  __syncthreads();
}

DI void convert_flat(const float* __restrict__ src, u16* __restrict__ dst, size_t n, int bid, int nblk) {
  size_t nv = n / 8;
  for (size_t i = (size_t)bid * NTHREADS + tidx(); i < nv; i += (size_t)nblk * NTHREADS) {
    f32x4 a = ((const f32x4*)src)[2 * i], b = ((const f32x4*)src)[2 * i + 1];
    u32x4 o;
    o[0] = pack2(a[0], a[1]); o[1] = pack2(a[2], a[3]); o[2] = pack2(b[0], b[1]); o[3] = pack2(b[2], b[3]);
    ((u32x4*)dst)[i] = o;
  }
}


typedef __attribute__((ext_vector_type(2))) float f32x2;
DI unsigned f32_to_e4m3(float x) {
  unsigned u = __float_as_uint(x);
  const unsigned sign = (u >> 24) & 0x80u;
  u &= 0x7fffffffu;
  const float ax = __uint_as_float(u);
  unsigned r;
  if (ax < 0.015625f) r = (unsigned)__float2int_rn(ax * 512.f);
  else { u += 0x7ffffu + ((u >> 20) & 1u); r = (u >> 20) - (120u << 3); if (r > 0x7eu) r = 0x7eu; }
  return sign | r;
}
DI void convert_fp8_rows(const float* __restrict__ src, unsigned char* __restrict__ dst, float* __restrict__ inv_scale, int nrows, int bid, int nblk) {
  const int lane = tidx() & 63, wv = tidx() >> 6;
  for (int row = bid * 4 + wv; row < nrows; row += nblk * 4) {
    const f32x4* sp = (const f32x4*)(src + (size_t)row * 1024 + 16 * lane);
    f32x4 v[4];
    float mx = 0.f;
#pragma unroll
    for (int i = 0; i < 4; ++i) { v[i] = sp[i]; mx = fmaxf(mx, fmaxf(fmaxf(fabsf(v[i][0]), fabsf(v[i][1])), fmaxf(fabsf(v[i][2]), fabsf(v[i][3])))); }
#pragma unroll
    for (int o = 32; o >= 1; o >>= 1) mx = fmaxf(mx, __shfl_xor(mx, o));
    const float sc = (mx > 0.f) ? 240.f / mx : 1.f;
    u32x4 o4;
#pragma unroll
    for (int i = 0; i < 4; ++i)
      o4[i] = f32_to_e4m3(v[i][0] * sc) | (f32_to_e4m3(v[i][1] * sc) << 8) | (f32_to_e4m3(v[i][2] * sc) << 16) | (f32_to_e4m3(v[i][3] * sc) << 24);
    *(u32x4*)(dst + (size_t)row * 1024 + 16 * lane) = o4;
    if (lane == 0) inv_scale[row] = (mx > 0.f) ? mx / 240.f : 1.f;
  }
}

DI void rmsnorm_rows_bf16(const float* __restrict__ src, const float* __restrict__ w, u16* __restrict__ dst, int nrows, int bid, int nblk) {
  const int lane = tidx() & 63, wv = tidx() >> 6;
  f32x4 wr[4];
#pragma unroll
  for (int i = 0; i < 4; ++i) wr[i] = ((const f32x4*)w)[lane + 64 * i];
  for (int row = bid * 4 + wv; row < nrows; row += nblk * 4) {
    const f32x4* s = (const f32x4*)(src + (size_t)row * 1024);
    f32x4 v[4];
    float ss = 0.f;
#pragma unroll
    for (int i = 0; i < 4; ++i) { v[i] = s[lane + 64 * i]; ss += v[i][0] * v[i][0] + v[i][1] * v[i][1] + v[i][2] * v[i][2] + v[i][3] * v[i][3]; }
    ss = wave_sum(ss);
    float rs = rsqrtf(ss * (1.f / 1024.f) + 1e-6f);
#pragma unroll
    for (int i = 0; i < 4; ++i) {
      u32x2 o;
      o[0] = pack2(v[i][0] * rs * wr[i][0], v[i][1] * rs * wr[i][1]);
      o[1] = pack2(v[i][2] * rs * wr[i][2], v[i][3] * rs * wr[i][3]);
      *(u32x2*)(dst + (size_t)row * 1024 + (lane + 64 * i) * 4) = o;
    }
  }
}

DI int t5_bucket(int d) {
  if (d < 16) return d < 0 ? 0 : d;
  const int th[16] = {16, 19, 21, 24, 27, 31, 35, 40, 46, 52, 59, 67, 77, 87, 99, 113};
  int b = 16;
#pragma unroll
  for (int k = 1; k < 16; ++k) b += (d >= th[k]) ? 1 : 0;
  return b;
}

DI void phase0(const Params& p, int bid, int nblk, char* smem) {
  char* ws = p.ws;
  const int n_win = 16 * 86, n_wa = 8 * 16, n_wo = 16 * 16, n_wq = 16 * 32, n_wc = 32 * 2;
  const int total = n_win + 2 * n_wa + n_wo + n_wq + 2 * n_wc;
  for (int it = bid; it < total; it += nblk) {
    int i = it;
    if (i < n_win) { tconv_tile<1>(p.w_in, 1024, NIN, (u16*)(ws + OFF_WINT), i / 86, i % 86, smem); continue; }
    i -= n_win;
    if (i < n_wa) { tconv_tile<0>(p.w_a, 512, 1024, (u16*)(ws + OFF_WAT), i / 16, i % 16, smem); continue; }
    i -= n_wa;
    if (i < n_wa) { tconv_tile<0>(p.w_b, 512, 1024, (u16*)(ws + OFF_WBT), i / 16, i % 16, smem); continue; }
    i -= n_wa;
    if (i < n_wo) { tconv_tile<0>(p.w_out, 1024, 1024, (u16*)(ws + OFF_WOT), i / 16, i % 16, smem); continue; }
    i -= n_wo;
    if (i < n_wq) { tconv_tile<0>(p.w_query, 1024, 2048, (u16*)(ws + OFF_WQT), i / 32, i % 32, smem, p.norm_ffn); continue; }
    i -= n_wq;
    if (i < n_wc) { tconv_tile<0>(p.cmp_w_k, 2048, 64, (u16*)(ws + OFF_WKT), i / 2, i % 2, smem); continue; }
    i -= n_wc;
    tconv_tile<0>(p.cmp_w_v, 2048, 64, (u16*)(ws + OFF_WVT), i / 2, i % 2, smem);
  }
  convert_flat(p.sub_keys, (u16*)(ws + OFF_SK), (size_t)16 * 128 * 128, bid, nblk);
  rmsnorm_rows_bf16(p.x, p.norm_mix, (u16*)(ws + OFF_RH), NTOK, bid, nblk);
  const int tid = tidx();
  if (bid == nblk - 1) {
    float* ck = (float*)(ws + OFF_MISC + MISC_CK);
    float* cv = (float*)(ws + OFF_MISC + MISC_CV);
    if (tid < 128) {
      const int e = tid & 63;
      const float* pe = (tid < 64) ? p.cmp_pe_k : p.cmp_pe_v;
      const float* W = (tid < 64) ? p.cmp_w_k : p.cmp_w_v;
      float s = 0.f;
      for (int k = 0; k < 2048; ++k) s += pe[k] * W[(size_t)k * 64 + e];
      if (tid < 64) ck[e] = s; else cv[e] = s;
    }
  }
  if (bid == nblk - 2 || nblk == 1) {
    float* bt = (float*)(ws + OFF_MISC + MISC_BIAS);
    for (int i = tid; i < 8 * 132; i += NTHREADS) {
      int hd = i / 132, d = i % 132;
      bt[i] = p.rel_bias[t5_bucket(d) * 8 + hd] * L2E;
    }
    if (tid < 16) ((unsigned*)(ws + OFF_MISC + MISC_CNT))[tid] = 0u;
  }
}

struct GemmPtrs {
  const u16* a[4];
  const u16* b[4];
  long aks, bks;
};

typedef __attribute__((address_space(3))) unsigned* lds_u32p;
DI void glds16(const u16* gsrc, const char* lds_dst) {
  __builtin_amdgcn_global_load_lds((const unsigned*)gsrc, (lds_u32p)(unsigned)(size_t)lds_dst, 16, 0, 0);
}
DI void gemm_kloop(f32x16 (&acc)[2][2], const GemmPtrs& g, int nkt, char* smem) {
  const int tid = tidx(), lane = tid & 63, w = tid >> 6, wm = w >> 1, wn = w & 1, r = lane & 31, h = lane >> 5;
  const char* dstA = smem + (w * 4) * 1024 + lane * 16;
#pragma unroll
  for (int i = 0; i < 4; ++i) { glds16(g.a[i], dstA + i * 1024); glds16(g.b[i], dstA + 16384 + i * 1024); }
  asm volatile("s_waitcnt vmcnt(0)" ::: "memory");
  __syncthreads();
  for (int kt = 0; kt < nkt; ++kt) {
    const char* A = smem + (kt & 1) * 32768;
    const char* B = A + 16384;
    if (kt + 1 < nkt) {
      const char* d2 = dstA + ((kt + 1) & 1) * 32768;
#pragma unroll
      for (int i = 0; i < 4; ++i) { glds16(g.a[i] + (long)(kt + 1) * g.aks, d2 + i * 1024); glds16(g.b[i] + (long)(kt + 1) * g.bks, d2 + 16384 + i * 1024); }
    }
#pragma unroll
    for (int s = 0; s < 4; ++s) {
      bf16x8 a0 = lds_frag(A, wm * 64 + r, 2 * s + h);
      bf16x8 a1 = lds_frag(A, wm * 64 + 32 + r, 2 * s + h);
      bf16x8 b0 = lds_frag(B, wn * 64 + r, 2 * s + h);
      bf16x8 b1 = lds_frag(B, wn * 64 + 32 + r, 2 * s + h);
      acc[0][0] = mfma32(a0, b0, acc[0][0]);
      acc[0][1] = mfma32(a0, b1, acc[0][1]);
      acc[1][0] = mfma32(a1, b0, acc[1][0]);
      acc[1][1] = mfma32(a1, b1, acc[1][1]);
    }
    asm volatile("s_waitcnt vmcnt(0)" ::: "memory");
    __syncthreads();
  }
}

DI void zero_acc(f32x16 (&acc)[2][2]) {
#pragma unroll
  for (int i = 0; i < 2; ++i)
#pragma unroll
    for (int j = 0; j < 2; ++j)
#pragma unroll
      for (int k = 0; k < 16; ++k) acc[i][j][k] = 0.f;
}
DI int glds_row(int i) { return ((tidx() >> 6) * 4 + i) * 8 + ((tidx() & 63) >> 3); }
DI int glds_chunk(int row) { return (tidx() & 7) ^ ((row >> 1) & 7); }
DI void gemm_setup(GemmPtrs& g, const u16* A, long lda, int m0, const u16* Bt, long ldb, int n0) {
#pragma unroll
  for (int i = 0; i < 4; ++i) {
    const int row = glds_row(i), ch = glds_chunk(row);
    g.a[i] = A + (size_t)(m0 + row) * lda + ch * 8;
    g.b[i] = Bt + (size_t)(n0 + row) * ldb + ch * 8;
  }
  g.aks = 64; g.bks = 64;
}
template <class F>
DI void gemm_epilogue(const f32x16 (&acc)[2][2], F f) {
  const int lane = tidx() & 63, w = tidx() >> 6, wm = w >> 1, wn = w & 1, r = lane & 31, h = lane >> 5;
#pragma unroll
  for (int i = 0; i < 2; ++i)
#pragma unroll
    for (int j = 0; j < 2; ++j) {
#pragma unroll
      for (int k = 0; k < 16; ++k) f(wm * 64 + i * 32 + (k & 3) + 8 * (k >> 2) + 4 * h, wn * 64 + j * 32 + r, acc[i][j][k]);
      asm volatile("" ::: "memory");
    }
}

template <class F>
DI void gemm_epilogue_lds(const f32x16 (&acc)[2][2], char* smem, F f) {
  float* T = (float*)smem;
  {
    const int lane = tidx() & 63, w = tidx() >> 6, wm = w >> 1, wn = w & 1, r = lane & 31, h = lane >> 5;
#pragma unroll
    for (int i = 0; i < 2; ++i)
#pragma unroll
      for (int j = 0; j < 2; ++j)
#pragma unroll
        for (int k = 0; k < 16; ++k) T[(wm * 64 + i * 32 + (k & 3) + 8 * (k >> 2) + 4 * h) * 132 + wn * 64 + j * 32 + r] = acc[i][j][k];
  }
  __syncthreads();
  const int c8 = (tidx() & 15) * 8, r0 = tidx() >> 4;
#pragma unroll 2
  for (int it = 0; it < 8; ++it) {
    const int row = r0 + 16 * it;
    const f32x4 a = *(const f32x4*)(T + row * 132 + c8), b = *(const f32x4*)(T + row * 132 + c8 + 4);
    const float v[8] = {a[0], a[1], a[2], a[3], b[0], b[1], b[2], b[3]};
    f(row, c8, v);
  }
  __syncthreads();
}
DI u32x4 pack8u(const float (&v)[8]) { u32x4 o; o[0] = pack2(v[0], v[1]); o[1] = pack2(v[2], v[3]); o[2] = pack2(v[4], v[5]); o[3] = pack2(v[6], v[7]); return o; }

DI bool xcd_tile(int k, int bid, int nblk, int NMT, int NNT, int& mt, int& nt) {
  if ((nblk & 7) != 0 || nblk < 8) {
    const int t = bid + k * nblk;
    if (t >= NMT * NNT) return false;
    mt = t / NNT; nt = t % NNT; return true;
  }
  const int x = bid & 7, j = bid >> 3, per = nblk >> 3;
  const int groups = NMT >> 6;
  const int i = j + k * per;
  if (i >= groups * 8 * NNT) return false;
  const int g = i / (8 * NNT), rem = i - g * (8 * NNT);
  nt = rem >> 3; mt = ((x + 8 * g) << 3) + (rem & 7);
  return true;
}

DI void phase_inproj(const Params& p, int bid, int nblk, char* smem) {
  char* ws = p.ws;
  const u16* H = (const u16*)(ws + OFF_RH);
  const u16* W = (const u16*)(ws + OFF_WINT);
  const int NT = NP / 128;
  for (int k = 0;; ++k) {
    int mt, nt;
    if (!xcd_tile(k, bid, nblk, 256, NT, mt, nt)) break;
    const int m0 = mt * 128, n0 = nt * 128;
    GemmPtrs g;
    gemm_setup(g, H, 1024, m0, W, 1024, n0);
    f32x16 acc[2][2];
    zero_acc(acc);
    gemm_kloop(acc, g, 16, smem);
    if (n0 >= 5376) {
      float* SM = (float*)(ws + OFF_SM);
      gemm_epilogue_lds(acc, smem, [&](int ml, int nl, const float (&v)[8]) {
        if (nl < 40) {
          float* d = SM + (size_t)(m0 + ml) * 40 + nl;
          *(f32x4*)d = f32x4{v[0], v[1], v[2], v[3]};
          *(f32x4*)(d + 4) = f32x4{v[4], v[5], v[6], v[7]};
        }
      });
    } else {
      u16* dst; int ld, c0;
      if (n0 < 1536) { dst = (u16*)(ws + OFF_QKV); ld = 1536; c0 = n0; }
      else if (n0 < 2048) { dst = (u16*)(ws + OFF_Z); ld = 512; c0 = n0 - 1536; }
      else if (n0 < 2560) { dst = (u16*)(ws + OFF_NQ); ld = 512; c0 = n0 - 2048; }
      else if (n0 < 3328) { dst = (u16*)(ws + OFF_NKV); ld = 768; c0 = n0 - 2560; }
      else { dst = (u16*)(ws + OFF_MG); ld = 2048; c0 = n0 - 3328; }
      gemm_epilogue_lds(acc, smem, [&](int ml, int nl, const float (&v)[8]) { *(u32x4*)(dst + (size_t)(m0 + ml) * ld + c0 + nl) = pack8u(v); });
    }
  }
}

DI void vtrans_item(const Params& p, int item, char* smem) {
  char* ws = p.ws;
  const int tile = item & 63, bg = (item >> 6) & 15, which = item >> 10;
  const int b = bg >> 1, g = bg & 1;
  const u16* NKV = (const u16*)(ws + OFF_NKV);
  u16* VT = (u16*)(ws + (which ? OFF_VWT : OFF_VST)) + ((size_t)bg * 64 + tile) * 4096;
  const int col0 = (which ? 640 : 384) + g * 64;
  u16* t = (u16*)smem;
  const int tid = tidx();
  {
#pragma unroll
    for (int i = 0; i < 2; ++i) {
      int c = tid + 256 * i, row = c >> 3, ch = c & 7;
      u32x4 v = *(const u32x4*)(NKV + (size_t)(b * SEQ + tile * 64 + row) * 768 + col0 + ch * 8);
      *(u32x4*)(t + row * 72 + ch * 8) = v;
    }
  }
  __syncthreads();
  {
    const int d = tid >> 2, part = tid & 3;
    u32x4 o0, o1;
    u16 vals[16];
#pragma unroll
    for (int pp = 0; pp < 16; ++pp) vals[pp] = t[(part * 16 + perm16(pp)) * 72 + d];
#pragma unroll
    for (int i = 0; i < 4; ++i) {
      o0[i] = (unsigned)vals[2 * i] | ((unsigned)vals[2 * i + 1] << 16);
      o1[i] = (unsigned)vals[8 + 2 * i] | ((unsigned)vals[8 + 2 * i + 1] << 16);
    }
    u16* dst = VT + (size_t)d * 64 + part * 16;
    *(u32x4*)dst = o0;
    *(u32x4*)(dst + 8) = o1;
  }
  __syncthreads();
}

DI void cmp_gemm_item(const Params& p, int item, char* smem) {
  char* ws = p.ws;
  const int which = item >> 5, mt = item & 31, m0 = mt * 128;
  const u16* NKV = (const u16*)(ws + OFF_NKV);
  const u16* Wt = (const u16*)(ws + (which ? OFF_WVT : OFF_WKT));
  GemmPtrs g;
#pragma unroll
  for (int i = 0; i < 4; ++i) {
    const int row = glds_row(i), ch = glds_chunk(row);
    int m = m0 + row, bg = m >> 8, n = m & 255;
    if (n > 254) n = 254;
    g.a[i] = NKV + (size_t)((bg >> 1) * SEQ + 16 * n) * 768 + which * 128 + (bg & 1) * 64 + ch * 8;
    g.b[i] = Wt + (size_t)row * 2048 + ch * 8;
  }
  g.aks = 768; g.bks = 64;
  f32x16 acc[2][2];
  zero_acc(acc);
  gemm_kloop(acc, g, 32, smem);
  const float* cc = (const float*)(ws + OFF_MISC + (which ? MISC_CV : MISC_CK));
  if (which == 0) {
    u16* KC = (u16*)(ws + OFF_KC);
    gemm_epilogue_lds(acc, smem, [&](int ml, int nl, const float (&v)[8]) {
      if (nl < 64) {
        float t[8];
#pragma unroll
        for (int e = 0; e < 8; ++e) t[e] = v[e] + cc[nl + e];
        *(u32x4*)(KC + (size_t)(m0 + ml) * 64 + nl) = pack8u(t);
      }
    });
  } else {
    u16* VCT = (u16*)(ws + OFF_VCT);
    gemm_epilogue_lds(acc, smem, [&](int ml, int nl, const float (&v)[8]) {
      if (nl < 64) {
        const int m = m0 + ml, bg = m >> 8, n = m & 255;
        u16* d = VCT + (((size_t)bg * 4 + (n >> 6)) * 64 + nl) * 64 + (n & 48) + perm16(n & 15);
#pragma unroll
        for (int e = 0; e < 8; ++e) d[e * 64] = f2bf(v[e] + cc[nl + e]);
      }
    });
  }
}

DI void gdn_store_frag(u16* dst, const char* tile, int idx  , float scale_is_row, const float* rowscale) {
  const int blk = idx >> 6, lane = idx & 63, rt = blk >> 1, ks = blk & 1, r = lane & 15, q = lane >> 4;
  const int row = 16 * rt + r;
  const int k0 = 32 * ks + 4 * q, k1 = k0 + 16;
  u32x2 lo = *(const u32x2*)(tile + swz(row, k0 >> 3) + (k0 & 7) * 2);
  u32x2 hi = *(const u32x2*)(tile + swz(row, k1 >> 3) + (k1 & 7) * 2);
  u32x4 o;
  if (rowscale) {
    float s = rowscale[row];
    o[0] = pack2(bflo(lo[0]) * s, bfhi(lo[0]) * s); o[1] = pack2(bflo(lo[1]) * s, bfhi(lo[1]) * s);
    o[2] = pack2(bflo(hi[0]) * s, bfhi(hi[0]) * s); o[3] = pack2(bflo(hi[1]) * s, bfhi(hi[1]) * s);
  } else { o[0] = lo[0]; o[1] = lo[1]; o[2] = hi[0]; o[3] = hi[1]; }
  *(u32x4*)(dst + (size_t)idx * 8) = o;
}

DI void gdn_chunk_item(const Params& p, int item, char* smem) {
  char* ws = p.ws;
  const int n = item & 63, bh = item >> 6, b = bh >> 3, hd = bh & 7;
  const int tid = tidx() + opaque0(), lane = tid & 63, w = tid >> 6;
  char* Cq = smem;
  char* Ck = smem + 8192;
  char* Cv = smem + 16384;
  float* Am = (float*)(smem + 24576);
  char* ATT = smem + 40960;
  char* Wt = smem + 49152;
  float* gc = (float*)(smem + 57344);
  float* bet = gc + 64;
  float* eg = gc + 128;
  float* ekd = gc + 192;
  const u16* QKV = (const u16*)(ws + OFF_QKV);
  const size_t tok0 = (size_t)b * SEQ + n * 64;
  {
    const int cg = tid & 7, tp = tid >> 3;
#pragma unroll
    for (int part = 0; part < 3; ++part) {
      const int col = part * 512 + hd * 64 + cg * 8;
      const int s0 = n * 64 + 2 * tp;
      const u16* src = QKV + ((size_t)b * SEQ) * 1536 + col;
      u32x4 xr[5];
#pragma unroll
      for (int j = 0; j < 5; ++j) {
        const int ss = s0 - 3 + j;
        xr[j] = (ss >= 0) ? *(const u32x4*)(src + (size_t)ss * 1536) : u32x4{0u, 0u, 0u, 0u};
      }
      float wv[4][8];
#pragma unroll
      for (int j = 0; j < 4; ++j) {
        const f32x4 wa = *(const f32x4*)(p.conv_w + j * 1536 + col), wb = *(const f32x4*)(p.conv_w + j * 1536 + col + 4);
        wv[j][0] = wa[0]; wv[j][1] = wa[1]; wv[j][2] = wa[2]; wv[j][3] = wa[3]; wv[j][4] = wb[0]; wv[j][5] = wb[1]; wv[j][6] = wb[2]; wv[j][7] = wb[3];
      }
      char* C = smem + part * 8192;
#pragma unroll
      for (int tt = 0; tt < 2; ++tt) {
        float y[8];
#pragma unroll
        for (int e = 0; e < 8; ++e) {
          float acc = 0.f;
#pragma unroll
          for (int j = 0; j < 4; ++j) {
            const unsigned wd = xr[tt + j][e >> 1];
            acc += wv[j][e] * ((e & 1) ? bfhi(wd) : bflo(wd));
          }
          y[e] = acc / (1.f + __expf(-acc));
        }
        u32x4 o; o[0] = pack2(y[0], y[1]); o[1] = pack2(y[2], y[3]); o[2] = pack2(y[4], y[5]); o[3] = pack2(y[6], y[7]);
        *(u32x4*)(C + swz(2 * tp + tt, cg)) = o;
      }
    }
  }
  if (w == 0) {
    const float* SM = (const float*)(ws + OFF_SM);
    float bi = SM[(tok0 + lane) * 40 + hd], ai = SM[(tok0 + lane) * 40 + 8 + hd];
    float xs = ai + p.dt_bias[hd];
    float sp = (xs > 20.f) ? xs : log1pf(__expf(xs));
    float gv = -__expf(p.a_log[hd]) * sp;
#pragma unroll
    for (int o = 1; o < 64; o <<= 1) { float t = __shfl_up(gv, o); if (lane >= o) gv += t; }
    float glast = __shfl(gv, 63);
    gc[lane] = gv; bet[lane] = sigmoidf_(bi); eg[lane] = __expf(gv); ekd[lane] = __expf(glast - gv);
    if (lane == 63) ((float*)(ws + OFF_MISC + MISC_GL))[item] = __expf(gv);
  }
  __syncthreads();
  if (tid < 128) {
    char* C = (tid < 64) ? Cq : Ck;
    const int row = tid & 63;
    u32x4 v[8];
    float ss = 0.f;
#pragma unroll
    for (int c = 0; c < 8; ++c) {
      v[c] = *(const u32x4*)(C + swz(row, c));
#pragma unroll
      for (int e = 0; e < 4; ++e) { float a = bflo(v[c][e]), bb = bfhi(v[c][e]); ss += a * a + bb * bb; }
    }
    float rs = rsqrtf(ss + 1e-6f) * ((tid < 64) ? 0.125f : 1.f);
#pragma unroll
    for (int c = 0; c < 8; ++c) {
      u32x4 o;
#pragma unroll
      for (int e = 0; e < 4; ++e) o[e] = pack2(bflo(v[c][e]) * rs, bfhi(v[c][e]) * rs);
      *(u32x4*)(C + swz(row, c)) = o;
    }
  }
  __syncthreads();
  {
    const int qa = w >> 1, qb = w & 1, r = lane & 31, h = lane >> 5;
    f32x16 akk, aqk;
#pragma unroll
    for (int k = 0; k < 16; ++k) { akk[k] = 0.f; aqk[k] = 0.f; }
    if (!(qa == 0 && qb == 1)) {
#pragma unroll
      for (int s = 0; s < 4; ++s) {
        bf16x8 ak = lds_frag(Ck, 32 * qa + r, 2 * s + h);
        bf16x8 aq = lds_frag(Cq, 32 * qa + r, 2 * s + h);
        bf16x8 bk = lds_frag(Ck, 32 * qb + r, 2 * s + h);
        akk = mfma32(ak, bk, akk);
        aqk = mfma32(aq, bk, aqk);
      }
    }
    const int j = 32 * qb + r;
    const float gj = gc[j];
#pragma unroll
    for (int k = 0; k < 16; ++k) {
      const int i = 32 * qa + (k & 3) + 8 * (k >> 2) + 4 * h;
      float dec = __expf(fminf(gc[i] - gj, 0.f));
      Am[i * 64 + j] = (j < i) ? akk[k] * bet[i] * dec : 0.f;
      *(u16*)(ATT + swz(i, j >> 3) + (j & 7) * 2) = f2bf((j <= i) ? aqk[k] * dec : 0.f);
    }
  }
  __syncthreads();
  u16* AMg = (u16*)p.out + (size_t)item * 16384;
  {
    const int c = tid >> 1, half = tid & 1, dcol = c & 63;
    const char* Rt = (c < 64) ? Cv : Ck;
    float xh[32];
#pragma unroll
    for (int k = 0; k < 32; ++k) xh[k] = 0.f;
#pragma unroll
    for (int i = 0; i < 64; ++i) {
      const float rhs = bf2f(*(const u16*)(Rt + swz(i, dcol >> 3) + (dcol & 7) * 2)) * bet[i] * ((c < 64) ? 1.f : eg[i]);
      float s0 = 0.f, s1 = 0.f;
#pragma unroll
      for (int j4 = 0; j4 < (i + 3) / 4; ++j4) {
        const f32x4 a = *(const f32x4*)(Am + i * 64 + j4 * 4);
        s0 += (half ? a[1] : a[0]) * xh[2 * j4];
        s1 += (half ? a[3] : a[2]) * xh[2 * j4 + 1];
      }
      float tot = s0 + s1;
      tot += dpp_xor1(tot);
      float xi = rhs - tot;
      asm volatile("" : "+v"(xi) : : "memory");
      if ((i & 1) == 0) { if (half == 0) xh[i >> 1] = xi; } else { if (half == 1) xh[i >> 1] = xi; }
    }
    if (c < 64) {
      float* U = (float*)(ws + OFF_RH) + ((size_t)item * 64 + c) * 64;
#pragma unroll
      for (int k = 0; k < 32; ++k) U[2 * k + half] = xh[k];
    } else {
#pragma unroll
      for (int k = 0; k < 32; ++k) { const int i = 2 * k + half; *(u16*)(Wt + swz(i, dcol >> 3) + (dcol & 7) * 2) = f2bf(xh[k]); }
    }
  }
  {
#pragma unroll
    for (int i = 0; i < 2; ++i) {
      gdn_store_frag(AMg + 4096, Cq, tid + 256 * i, 1.f, eg);
      gdn_store_frag(AMg + 8192, ATT, tid + 256 * i, 0.f, nullptr);
    }
#pragma unroll
    for (int i = 0; i < 2; ++i) {
      const int idx = tid + 256 * i, blk = idx >> 6, ln = idx & 63, rt = blk >> 1, ks = blk & 1, r = ln & 15, q = ln >> 4;
      const int d = 16 * rt + r;
      float vv[8];
#pragma unroll
      for (int j = 0; j < 8; ++j) {
        const int tk = 32 * ks + ((j < 4) ? (4 * q + j) : (16 + 4 * q + (j - 4)));
        vv[j] = bf2f(*(const u16*)(Ck + swz(tk, d >> 3) + (d & 7) * 2)) * ekd[tk];
      }
      *(bf16x8*)(AMg + 12288 + (size_t)idx * 8) = pack8(vv[0], vv[1], vv[2], vv[3], vv[4], vv[5], vv[6], vv[7]);
    }
  }
  __syncthreads();
#pragma unroll
  for (int i = 0; i < 2; ++i) gdn_store_frag(AMg, Wt, tid + 256 * i, 0.f, nullptr);
  __syncthreads();
}

DI void phase2(const Params& p, int bid, int nblk, char* smem) {
  const int total = 64 + 2048 + 4096;
  for (int it = bid; it < total; it += nblk) {
    if (it < 64) cmp_gemm_item(p, it, smem);
    else if (it < 2112) vtrans_item(p, it - 64, smem);
    else gdn_chunk_item(p, it - 2112, smem);
  }
}

DI void gdn_scan_item(const Params& p, int bh, char* smem) {
  char* ws = p.ws;
  const int tid = tidx(), lane = tid & 63, w = tid >> 6, col = lane & 15, q = lane >> 4;
  const int b = bh >> 3, hd = bh & 7;
  const u16* AMg = (const u16*)p.out + (size_t)bh * 64 * 16384;
  const float* U = (const float*)(ws + OFF_RH) + (size_t)bh * 64 * 4096;
  const float* GL = (const float*)(ws + OFF_MISC + MISC_GL) + bh * 64;
  float* O = (float*)(ws + OFF_QKV);
  f32x4 S[4];
#pragma unroll
  for (int t = 0; t < 4; ++t) S[t] = f32x4{0.f, 0.f, 0.f, 0.f};
  u32x4 stg[8];
#pragma unroll
  for (int i = 0; i < 8; ++i) stg[i] = *(const u32x4*)(AMg + (size_t)(i * 256 + tid) * 8);
  f32x4 u[4];
#pragma unroll
  for (int ct = 0; ct < 4; ++ct) u[ct] = *(const f32x4*)(U + (size_t)(16 * w + col) * 64 + 16 * ct + 4 * q);
  float gl = GL[0];
  for (int n = 0; n < 64; ++n) {
    char* buf = smem + (n & 1) * 32768;
#pragma unroll
    for (int i = 0; i < 8; ++i) *(u32x4*)(buf + (i * 256 + tid) * 16) = stg[i];
    __syncthreads();
    f32x4 ucur[4];
#pragma unroll
    for (int ct = 0; ct < 4; ++ct) ucur[ct] = u[ct];
    const float glcur = gl;
    if (n + 1 < 64) {
      const u16* src = AMg + (size_t)(n + 1) * 16384;
#pragma unroll
      for (int i = 0; i < 8; ++i) stg[i] = *(const u32x4*)(src + (size_t)(i * 256 + tid) * 8);
      const float* un = U + (size_t)(n + 1) * 4096;
#pragma unroll
      for (int ct = 0; ct < 4; ++ct) u[ct] = *(const f32x4*)(un + (size_t)(16 * w + col) * 64 + 16 * ct + 4 * q);
      gl = GL[n + 1];
    }
    bf16x8 bS[2];
#pragma unroll
    for (int ks = 0; ks < 2; ++ks)
      bS[ks] = pack8(S[2 * ks][0], S[2 * ks][1], S[2 * ks][2], S[2 * ks][3], S[2 * ks + 1][0], S[2 * ks + 1][1], S[2 * ks + 1][2], S[2 * ks + 1][3]);
#define AFRAG(mat, rt, ks) (*(const bf16x8*)(buf + (mat) * 8192 + (((rt) * 2 + (ks)) * 64 + lane) * 16))
    f32x4 vn[4], o[4];
#pragma unroll
    for (int ct = 0; ct < 4; ++ct) {
      f32x4 a = f32x4{0.f, 0.f, 0.f, 0.f};
      a = mfma16(AFRAG(0, ct, 0), bS[0], a);
      a = mfma16(AFRAG(0, ct, 1), bS[1], a);
      vn[ct] = ucur[ct] - a;
      f32x4 oo = f32x4{0.f, 0.f, 0.f, 0.f};
      oo = mfma16(AFRAG(1, ct, 0), bS[0], oo);
      oo = mfma16(AFRAG(1, ct, 1), bS[1], oo);
      o[ct] = oo;
    }
    bf16x8 bV[2];
#pragma unroll
    for (int ks = 0; ks < 2; ++ks)
      bV[ks] = pack8(vn[2 * ks][0], vn[2 * ks][1], vn[2 * ks][2], vn[2 * ks][3], vn[2 * ks + 1][0], vn[2 * ks + 1][1], vn[2 * ks + 1][2], vn[2 * ks + 1][3]);
#pragma unroll
    for (int ct = 0; ct < 4; ++ct) {
      o[ct] = mfma16(AFRAG(2, ct, 0), bV[0], o[ct]);
      o[ct] = mfma16(AFRAG(2, ct, 1), bV[1], o[ct]);
      f32x4 sn = S[ct] * glcur;
      sn = mfma16(AFRAG(3, ct, 0), bV[0], sn);
      sn = mfma16(AFRAG(3, ct, 1), bV[1], sn);
      S[ct] = sn;
    }
#undef AFRAG
    float* od = O + ((size_t)b * SEQ + n * 64) * 512 + hd * 64 + 16 * w + col;
#pragma unroll
    for (int ct = 0; ct < 4; ++ct)
#pragma unroll
      for (int rg = 0; rg < 4; ++rg) od[(size_t)(16 * ct + 4 * q + rg) * 512] = o[ct][rg];
  }
  asm volatile("s_waitcnt vmcnt(0)" ::: "memory");
  __syncthreads();
  {
    u16* Z = (u16*)(ws + OFF_Z);
    const int sub = tid & 15;
    const f32x4 gw = ((const f32x4*)p.gdn_norm)[sub];
    for (int tk = tid >> 4; tk < SEQ; tk += 16) {
      const size_t gi = ((size_t)b * SEQ + tk) * 8 + hd;
      f32x4 v = *(const f32x4*)(O + gi * 64 + sub * 4);
      float ss = v[0] * v[0] + v[1] * v[1] + v[2] * v[2] + v[3] * v[3];
      ss += __shfl_xor(ss, 1); ss += __shfl_xor(ss, 2); ss += __shfl_xor(ss, 4); ss += __shfl_xor(ss, 8);
      const float rs = rsqrtf(ss * (1.f / 64.f) + 1e-6f);
      const u32x2 zz = *(const u32x2*)(Z + gi * 64 + sub * 4);
      const float z0 = bflo(zz[0]), z1 = bfhi(zz[0]), z2 = bflo(zz[1]), z3 = bfhi(zz[1]);
      u32x2 ov;
      ov[0] = pack2(v[0] * rs * gw[0] * (z0 * sigmoidf_(z0)), v[1] * rs * gw[1] * (z1 * sigmoidf_(z1)));
      ov[1] = pack2(v[2] * rs * gw[2] * (z2 * sigmoidf_(z2)), v[3] * rs * gw[3] * (z3 * sigmoidf_(z3)));
      *(u32x2*)(Z + gi * 64 + sub * 4) = ov;
    }
  }
  __syncthreads();
}

DI void phase_gdn_post(const Params& p, int bid, int nblk) {
  char* ws = p.ws;
  const float* O = (const float*)(ws + OFF_QKV);
  const u16* Z = (const u16*)(ws + OFF_Z);
  u16* OA = (u16*)(ws + OFF_NQ);
  const int sub = tidx() & 15;
  const f32x4 gw = ((const f32x4*)p.gdn_norm)[sub];
  const size_t ngrp = (size_t)NTOK * 8;
  for (size_t gi = ((size_t)bid * NTHREADS + tidx()) >> 4; gi < ngrp; gi += ((size_t)nblk * NTHREADS) >> 4) {
    f32x4 v = *(const f32x4*)(O + gi * 64 + sub * 4);
    float ss = v[0] * v[0] + v[1] * v[1] + v[2] * v[2] + v[3] * v[3];
    ss += __shfl_xor(ss, 1); ss += __shfl_xor(ss, 2); ss += __shfl_xor(ss, 4); ss += __shfl_xor(ss, 8);
    float rs = rsqrtf(ss * (1.f / 64.f) + 1e-6f);
    u32x2 zz = *(const u32x2*)(Z + gi * 64 + sub * 4);
    float z0 = bflo(zz[0]), z1 = bfhi(zz[0]), z2 = bflo(zz[1]), z3 = bfhi(zz[1]);
    u32x2 o;
    o[0] = pack2(v[0] * rs * gw[0] * (z0 * sigmoidf_(z0)), v[1] * rs * gw[1] * (z1 * sigmoidf_(z1)));
    o[1] = pack2(v[2] * rs * gw[2] * (z2 * sigmoidf_(z2)), v[3] * rs * gw[3] * (z3 * sigmoidf_(z3)));
    *(u32x2*)(OA + gi * 64 + sub * 4) = o;
  }
}

constexpr float NEGBIG = -1e30f;
constexpr float QK_SCALE = 0.125f * L2E;

DI float fexp2(float x) { return __builtin_amdgcn_exp2f(x); }
DI float xhalf_max(float x) {
  auto r = __builtin_amdgcn_permlane32_swap(__float_as_uint(x), __float_as_uint(x), false, false);
  return fmaxf(__uint_as_float(r[0]), __uint_as_float(r[1]));
}
DI float xhalf_sum(float x) {
  auto r = __builtin_amdgcn_permlane32_swap(__float_as_uint(x), __float_as_uint(x), false, false);
  return __uint_as_float(r[0]) + __uint_as_float(r[1]);
}

template <int MODE, bool SLOW>
DI void nsa_tile(const char* Kt, const char* Vt, const bf16x8 (&Qf)[4], f32x16 (&O)[2], float& m, float& l,
                 const int t, const int key0, const bool lane_sel, const float* tab, const float c31,
                 const float mfin, const float linv, float* impw) {
  const int lane = tidx() & 63, r = lane & 31, h = lane >> 5;
#pragma unroll
  for (int a = 0; a < 2; ++a) {
    f32x16 S;
#pragma unroll
    for (int k = 0; k < 16; ++k) S[k] = 0.f;
#pragma unroll
    for (int s = 0; s < 4; ++s) S = mfma32(pad_frag(Kt, 32 * a + r, 2 * s + h), Qf[s], S);
    if (!SLOW) {
      const float cb = (MODE == 2 && !lane_sel) ? NEGBIG : c31;
      float mxr = fmaxf(fmaxf(S[0], S[1]), fmaxf(S[2], S[3]));
#pragma unroll
      for (int k = 4; k < 16; k += 4) mxr = fmaxf(mxr, fmaxf(fmaxf(S[k], S[k + 1]), fmaxf(S[k + 2], S[k + 3])));
      const float mx = xhalf_max(fmaf(mxr, QK_SCALE, cb));
      const float mn = fmaxf(m, mx);
      const float alpha = fexp2(m - mn);
      const float cbm = cb - mn;
      float ps = 0.f;
#pragma unroll
      for (int k = 0; k < 16; ++k) { S[k] = fexp2(fmaf(S[k], QK_SCALE, cbm)); ps += S[k]; }
      l = l * alpha + ps;
      m = mn;
#pragma unroll
      for (int dt = 0; dt < 2; ++dt)
#pragma unroll
        for (int k = 0; k < 16; ++k) O[dt][k] *= alpha;
    } else {
      float bias[16];
#pragma unroll
      for (int k = 0; k < 16; ++k) {
        const int kl = 32 * a + (k & 3) + 8 * (k >> 2) + 4 * h;
        const int dist = (MODE < 2) ? (t - (16 * (key0 + kl) + 31)) : (t - (key0 + kl));
        bias[k] = tab[min(max(dist, 0), 128)];
      }
#pragma unroll
      for (int k = 0; k < 16; ++k) asm volatile("" : "+v"(bias[k]));
#pragma unroll
      for (int k = 0; k < 16; ++k) {
        const int kl = 32 * a + (k & 3) + 8 * (k >> 2) + 4 * h;
        const int dist = (MODE < 2) ? (t - (16 * (key0 + kl) + 31)) : (t - (key0 + kl));
        bool valid = (dist >= 0) && lane_sel;
        if (MODE == 3) valid = valid && (dist < 512);
        S[k] = valid ? fmaf(S[k], QK_SCALE, bias[k]) : NEGBIG;
      }
    if (MODE == 1) {
#pragma unroll
      for (int k = 0; k < 16; ++k) S[k] = (S[k] > -1e29f) ? fexp2(S[k] - mfin) * linv : 0.f;
    } else {
      float mx = fmaxf(fmaxf(S[0], S[1]), fmaxf(S[2], S[3]));
#pragma unroll
      for (int k = 4; k < 16; k += 4) mx = fmaxf(mx, fmaxf(fmaxf(S[k], S[k + 1]), fmaxf(S[k + 2], S[k + 3])));
      mx = xhalf_max(mx);
      const float mn = fmaxf(m, mx);
      const float alpha = fexp2(m - mn);
      float ps = 0.f;
#pragma unroll
      for (int k = 0; k < 16; ++k) { S[k] = (S[k] > -1e29f) ? fexp2(S[k] - mn) : 0.f; ps += S[k]; }
      l = l * alpha + ps;
      m = mn;
      if (MODE != 0) {
#pragma unroll
        for (int dt = 0; dt < 2; ++dt)
#pragma unroll
          for (int k = 0; k < 16; ++k) O[dt][k] *= alpha;
      }
    }
    }
    if (MODE == 1) {
#pragma unroll
      for (int g4 = 0; g4 < 4; ++g4) {
        float mainv = S[4 * g4] + S[4 * g4 + 1] + S[4 * g4 + 2] + 0.5f * S[4 * g4 + 3];
        float spill = 0.5f * S[4 * g4 + 3];
        mainv += __shfl_xor(mainv, 8); mainv += __shfl_xor(mainv, 16);
        spill += __shfl_xor(spill, 8); spill += __shfl_xor(spill, 16);
        const int blk = ((key0 + 32 * a) >> 2) + 2 * g4 + h;
        if (r < 8) { atomicAdd(&impw[r * 68 + blk], mainv); atomicAdd(&impw[r * 68 + blk + 1], spill); }
      }
    }
    if (MODE != 0) {
      bf16x8 P0 = pack8(S[0], S[1], S[2], S[3], S[4], S[5], S[6], S[7]);
      bf16x8 P1 = pack8(S[8], S[9], S[10], S[11], S[12], S[13], S[14], S[15]);
#pragma unroll
      for (int dt = 0; dt < 2; ++dt) {
        O[dt] = mfma32(pad_frag(Vt, 32 * dt + r, 4 * a + h), P0, O[dt]);
        O[dt] = mfma32(pad_frag(Vt, 32 * dt + r, 4 * a + 2 + h), P1, O[dt]);
      }
    }
  }
}

struct NsaSrc { const u16* k; long kld; const u16* v; long vld; };

constexpr int NSA_BUF = 18432;
constexpr int NSA_LDS_BIAS = 2 * NSA_BUF, NSA_LDS_IMP = NSA_LDS_BIAS + 8 * 132 * 4, NSA_LDS_Q = NSA_LDS_IMP + 4 * 8 * 68 * 4;

DI void nsa_item(const Params& p, const int bg, const int hq, char* smem) {
  char* ws = p.ws;
  const int tid = tidx(), lane = tid & 63, w = tid >> 6, r = lane & 31, h = lane >> 5;
  const int b = bg >> 1, g = bg & 1, qi = hq >> 1;
  const int t = 32 * hq + 8 * w + (r & 7);
  const int head = g * 4 + (r >> 3);
  const size_t trow = (size_t)b * SEQ + t;
  float* biasl = (float*)(smem + NSA_LDS_BIAS);
  float* impw = (float*)(smem + NSA_LDS_IMP) + w * (8 * 68);
  const u16* NKV = (const u16*)(ws + OFF_NKV);
  __syncthreads();
  for (int i = tid; i < 8 * 132; i += NTHREADS) biasl[i] = ((const float*)(ws + OFF_MISC + MISC_BIAS))[i];
  for (int i = lane; i < 8 * 68; i += 64) impw[i] = 0.f;
  bf16x8 Q[4];
  {
    const u16* NQ = (const u16*)(ws + OFF_NQ);
#pragma unroll
    for (int s = 0; s < 4; ++s) Q[s] = *(const bf16x8*)(NQ + trow * 512 + head * 64 + 16 * s + 8 * h);
  }
  const float* tab = biasl + head * 132;
  f32x16 O[2];
  float m, l, mfin = 0.f, linv = 0.f;
  u16* OB = (u16*)(ws + OFF_QKV + (size_t)NTOK * 512 * 4);
  auto reset = [&]() {
#pragma unroll
    for (int dt = 0; dt < 2; ++dt)
#pragma unroll
      for (int k = 0; k < 16; ++k) O[dt][k] = 0.f;
    m = NEGBIG; l = 0.f;
  };
  u32x4 sk[2], sv[2];
  auto stage_load = [&](const NsaSrc& s) {
#pragma unroll
    for (int i = 0; i < 2; ++i) {
      const int c = tid + 256 * i, row = c >> 3, ch = c & 7;
      sk[i] = *(const u32x4*)(s.k + (size_t)row * s.kld + ch * 8);
      sv[i] = *(const u32x4*)(s.v + (size_t)row * s.vld + ch * 8);
    }
  };
  auto stage_store = [&](char* buf) {
#pragma unroll
    for (int i = 0; i < 2; ++i) {
      const int c = tid + 256 * i, row = c >> 3, ch = c & 7;
      *(u32x4*)(buf + row * 144 + ch * 16) = sk[i];
      *(u32x4*)(buf + 9216 + row * 144 + ch * 16) = sv[i];
    }
  };
  auto src_cmp = [&](int tt) { NsaSrc s; s.k = (const u16*)(ws + OFF_KC) + ((size_t)bg * 256 + 64 * tt) * 64; s.kld = 64;
                               s.v = (const u16*)(ws + OFF_VCT) + ((size_t)bg * 4 + tt) * 4096; s.vld = 64; return s; };
  auto src_slc = [&](int j) { NsaSrc s; s.k = NKV + ((size_t)b * SEQ + 64 * j) * 768 + 256 + g * 64; s.kld = 768;
                              s.v = (const u16*)(ws + OFF_VST) + ((size_t)bg * 64 + j) * 4096; s.vld = 64; return s; };
  auto src_win = [&](int j) { NsaSrc s; s.k = NKV + ((size_t)b * SEQ + 64 * j) * 768 + 512 + g * 64; s.kld = 768;
                              s.v = (const u16*)(ws + OFF_VWT) + ((size_t)bg * 64 + j) * 4096; s.vld = 64; return s; };
  auto gatev = [&](int br) { return sigmoidf_(((const float*)(ws + OFF_SM))[trow * 40 + 16 + head * 3 + br]); };
  auto emit = [&](const float wgt, bool first) {
#pragma unroll
    for (int dt = 0; dt < 2; ++dt)
#pragma unroll
      for (int g4 = 0; g4 < 4; ++g4) {
        u16* dst = OB + trow * 512 + head * 64 + 32 * dt + 8 * g4 + 4 * h;
        float v0 = O[dt][4 * g4] * wgt, v1 = O[dt][4 * g4 + 1] * wgt, v2 = O[dt][4 * g4 + 2] * wgt, v3 = O[dt][4 * g4 + 3] * wgt;
        if (!first) {
          u32x2 old = *(const u32x2*)dst;
          v0 += bflo(old[0]); v1 += bfhi(old[0]); v2 += bflo(old[1]); v3 += bfhi(old[1]);
        }
        u32x2 o; o[0] = pack2(v0, v1); o[1] = pack2(v2, v3);
        *(u32x2*)dst = o;
      }
  };
  int it = 0;
  stage_load(src_cmp(0));
  stage_store(smem);
  __syncthreads();
  const float c31 = tab[128];
#define NSA_STEP(CALL, HAS_NEXT, NEXT_SRC) { \
    const bool hn_ = (HAS_NEXT); if (hn_) stage_load(NEXT_SRC); \
    { const char* Kt = smem + (it & 1) * NSA_BUF; const char* Vt = Kt + 9216; CALL; } \
    if (hn_) stage_store(smem + ((it + 1) & 1) * NSA_BUF); \
    __syncthreads(); ++it; }

  const int ntc = (2 * hq + 1 + 63) >> 6;
  reset();
  for (int tt = 0; tt < ntc; ++tt)
    NSA_STEP((nsa_tile<0, true>(Kt, Vt, Q, O, m, l, t, 64 * tt, true, tab, c31, mfin, linv, impw)), true, (tt + 1 < ntc) ? src_cmp(tt + 1) : src_cmp(0));
  { float lt = xhalf_sum(l); mfin = m; linv = lt > 0.f ? 1.f / lt : 0.f; }
  for (int tt = 0; tt < ntc; ++tt)
    NSA_STEP((nsa_tile<1, true>(Kt, Vt, Q, O, m, l, t, 64 * tt, true, tab, c31, mfin, linv, impw)), true, (tt + 1 < ntc) ? src_cmp(tt + 1) : src_slc(0));
  emit(gatev(0), true);
  unsigned sel_lo, sel_hi;
  if (qi < 16) {
    unsigned long long mk = (2ull << qi) - 1ull;
    sel_lo = (unsigned)mk; sel_hi = (unsigned)(mk >> 32);
  } else {
    unsigned long long mk = 0ull;
    const float* row = impw + (lane & 7) * 68;
    const int part = lane >> 3, hiM = qi - 2;
    for (int mm = 1 + part; mm <= hiM; mm += 8) {
      const float v = row[mm];
      int rank = 0;
      for (int m2 = 1; m2 <= hiM; ++m2) { const float u = row[m2]; rank += ((u > v) || (u == v && m2 < mm)) ? 1 : 0; }
      if (rank < 13) mk |= 1ull << mm;
    }
    mk |= 1ull | (1ull << qi) | (1ull << (qi - 1));
    sel_lo = (unsigned)mk; sel_hi = (unsigned)(mk >> 32);
    sel_lo |= __shfl_xor(sel_lo, 8); sel_hi |= __shfl_xor(sel_hi, 8);
    sel_lo |= __shfl_xor(sel_lo, 16); sel_hi |= __shfl_xor(sel_hi, 16);
    sel_lo |= __shfl_xor(sel_lo, 32); sel_hi |= __shfl_xor(sel_hi, 32);
  }
  reset();
  const int j0 = qi >= 8 ? qi - 8 : 0;
  for (int j = 0; j <= qi; ++j) {
    const bool lsel = ((j < 32 ? (sel_lo >> j) : (sel_hi >> (j - 32))) & 1u) != 0u;
    if (qi - j <= 2) {
      NSA_STEP((nsa_tile<2, true>(Kt, Vt, Q, O, m, l, t, 64 * j, lsel, tab, c31, mfin, linv, impw)), true, (j < qi) ? src_slc(j + 1) : src_win(j0));
    } else {
      NSA_STEP((nsa_tile<2, false>(Kt, Vt, Q, O, m, l, t, 64 * j, lsel, tab, c31, mfin, linv, impw)), true, src_slc(j + 1));
    }
  }
  { float lt = xhalf_sum(l); emit(lt > 0.f ? gatev(1) / lt : 0.f, false); }
  reset();
  for (int j = j0; j <= qi; ++j) {
    if ((qi - j <= 2) || (qi - j == 8)) {
      NSA_STEP((nsa_tile<3, true>(Kt, Vt, Q, O, m, l, t, 64 * j, true, tab, c31, mfin, linv, impw)), j < qi, src_win(j + 1));
    } else {
      NSA_STEP((nsa_tile<3, false>(Kt, Vt, Q, O, m, l, t, 64 * j, true, tab, c31, mfin, linv, impw)), true, src_win(j + 1));
    }
  }
#undef NSA_STEP
  { float lt = xhalf_sum(l); emit(lt > 0.f ? gatev(2) / lt : 0.f, false); }
}

DI void phase4(const Params& p, char* smem, int   = 0) {
  const int bid = blockIdx.x, nblk = gridDim.x;
  if (nblk < 128) {
    for (int it = bid; it < 64 + 2048; it += nblk) {
      if (it < 64) gdn_scan_item(p, it, smem);
      else { const int k = it - 64; nsa_item(p, k & 15, 127 - (k >> 4), smem); }
    }
    convert_fp8_rows(p.expert_u, (unsigned char*)(p.ws + OFF_EU), (float*)(p.ws + OFF_MISC + MISC_SCU), 16384, bid, nblk);
    convert_fp8_rows(p.expert_v, (unsigned char*)(p.ws + OFF_EV), (float*)(p.ws + OFF_MISC + MISC_SCV), 16384, bid, nblk);
    return;
  }
  if (bid < 64) {
    gdn_scan_item(p, bid, smem);
    convert_fp8_rows(p.expert_u, (unsigned char*)(p.ws + OFF_EU), (float*)(p.ws + OFF_MISC + MISC_SCU), 16384, bid, 64);
    convert_fp8_rows(p.expert_v, (unsigned char*)(p.ws + OFF_EV), (float*)(p.ws + OFF_MISC + MISC_SCV), 16384, bid, 64);
    return;
  }
  const int nb = nblk - 64, c = bid - 64;
  for (int r = 0;; ++r) {
    const int k = r * nb + ((r & 1) ? (nb - 1 - c) : c);
    if (k >= 2048) break;
    nsa_item(p, k & 15, 127 - (k >> 4), smem);
  }
}

DI void phase_branch(const Params& p, int bid, int nblk, char* smem) {
  char* ws = p.ws;
  const u16* OA = (const u16*)(ws + OFF_Z);
  const u16* OB = (const u16*)(ws + OFF_QKV + (size_t)NTOK * 512 * 4);
  const u16* MG = (const u16*)(ws + OFF_MG);
  u16* MIX = (u16*)(ws + OFF_RH);
  for (int k = 0;; ++k) {
    int mt, nt;
    if (!xcd_tile(k, bid, nblk, 256, 8, mt, nt)) break;
    const int m0 = mt * 128, n0 = nt * 128;
    GemmPtrs g;
    f32x16 acc[2][2];
    gemm_setup(g, OA, 512, m0, (const u16*)(ws + OFF_WAT), 512, n0);
    zero_acc(acc);
    gemm_kloop(acc, g, 8, smem);
    gemm_epilogue_lds(acc, smem, [&](int ml, int nl, const float (&v)[8]) {
      const size_t m = m0 + ml; const int n = n0 + nl;
      const u32x4 gt = *(const u32x4*)(MG + m * 2048 + n);
      float t[8];
#pragma unroll
      for (int e = 0; e < 4; ++e) { t[2 * e] = v[2 * e] * sigmoidf_(bflo(gt[e])); t[2 * e + 1] = v[2 * e + 1] * sigmoidf_(bfhi(gt[e])); }
      *(u32x4*)(MIX + m * 1024 + n) = pack8u(t);
    });
    gemm_setup(g, OB, 512, m0, (const u16*)(ws + OFF_WBT), 512, n0);
    zero_acc(acc);
    gemm_kloop(acc, g, 8, smem);
    gemm_epilogue_lds(acc, smem, [&](int ml, int nl, const float (&v)[8]) {
      const size_t m = m0 + ml; const int n = n0 + nl;
      const u32x4 gt = *(const u32x4*)(MG + m * 2048 + 1024 + n);
      const u32x4 old = *(const u32x4*)(MIX + m * 1024 + n);
      float t[8];
#pragma unroll
      for (int e = 0; e < 4; ++e) {
        t[2 * e] = bflo(old[e]) + v[2 * e] * sigmoidf_(bflo(gt[e]));
        t[2 * e + 1] = bfhi(old[e]) + v[2 * e + 1] * sigmoidf_(bfhi(gt[e]));
      }
      *(u32x4*)(MIX + m * 1024 + n) = pack8u(t);
    });
  }
}

DI void phase_outproj(const Params& p, int bid, int nblk, char* smem) {
  char* ws = p.ws;
  const u16* MIX = (const u16*)(ws + OFF_RH);
  for (int k = 0;; ++k) {
    int mt, nt;
    if (!xcd_tile(k, bid, nblk, 256, 8, mt, nt)) break;
    const int m0 = mt * 128, n0 = nt * 128;
    GemmPtrs g;
    f32x16 acc[2][2];
    gemm_setup(g, MIX, 1024, m0, (const u16*)(ws + OFF_WOT), 1024, n0);
    zero_acc(acc);
    gemm_kloop(acc, g, 16, smem);
    gemm_epilogue_lds(acc, smem, [&](int ml, int nl, const float (&v)[8]) {
      const size_t idx = (size_t)(m0 + ml) * 1024 + n0 + nl;
      const f32x4 x0 = *(const f32x4*)(p.x + idx), x1 = *(const f32x4*)(p.x + idx + 4);
      float* X1 = (float*)(ws + OFF_QKV);
      const float y[8] = {x0[0] + v[0], x0[1] + v[1], x0[2] + v[2], x0[3] + v[3], x1[0] + v[4], x1[1] + v[5], x1[2] + v[6], x1[3] + v[7]};
      *(f32x4*)(X1 + idx) = f32x4{y[0], y[1], y[2], y[3]};
      *(f32x4*)(X1 + idx + 4) = f32x4{y[4], y[5], y[6], y[7]};
      *(u32x4*)((u16*)(ws + OFF_MG) + idx) = pack8u(y);
      float ss = y[0] * y[0] + y[1] * y[1] + y[2] * y[2] + y[3] * y[3] + y[4] * y[4] + y[5] * y[5] + y[6] * y[6] + y[7] * y[7];
      ss += dppf<0xB1>(ss); ss += dppf<0x4E>(ss); ss += dppf<0x141>(ss); ss += dppf<0x140>(ss);
      if ((tidx() & 15) == 0) ((float*)(ws + OFF_MG + (size_t)NTOK * 1024 * 2))[(size_t)(m0 + ml) * 8 + nt] = ss;
    });
  }
}

DI void phase_query(const Params& p, int bid, int nblk, char* smem) {
  char* ws = p.ws;
  const u16* H2 = (const u16*)(ws + OFF_RH);
  u16* QRY = (u16*)(ws + OFF_MG);
  for (int k = 0;; ++k) {
    int mt, nt;
    if (!xcd_tile(k, bid, nblk, 256, 16, mt, nt)) break;
    const int m0 = mt * 128, n0 = nt * 128;
    GemmPtrs g;
    f32x16 acc[2][2];
    gemm_setup(g, H2, 1024, m0, (const u16*)(ws + OFF_WQT), 1024, n0);
    zero_acc(acc);
    gemm_kloop(acc, g, 16, smem);
    gemm_epilogue_lds(acc, smem, [&](int ml, int nl, const float (&v)[8]) { *(u32x4*)(QRY + (size_t)(m0 + ml) * 2048 + n0 + nl) = pack8u(v); });
  }
}

DI unsigned f2ord(float f) { unsigned u = __float_as_uint(f); return (u & 0x80000000u) ? ~u : (u | 0x80000000u); }
DI float ord2f(unsigned o) { unsigned u = (o & 0x80000000u) ? (o & 0x7fffffffu) : ~o; return __uint_as_float(u); }

DI void peer_route_job(const Params& p, int job, char* smem) {
  char* ws = p.ws;
  const int mt = job >> 3, hd = job & 7, m0 = mt * 128;
  const u16* H2 = (const u16*)(ws + OFF_MG);
  const u16* WQ = (const u16*)(ws + OFF_WQT);
  float* rs_l = (float*)(smem + 71680);
  const u16* SK = (const u16*)(ws + OFF_SK);
  unsigned* keys = (unsigned*)smem;
  unsigned char* idxs = (unsigned char*)(smem + 67584);
  const int tid = tidx() + opaque0();
  float v1[16], v2[16];
  __syncthreads();
  if (tid < 128) {
    const float* sp = (const float*)(ws + OFF_MG + (size_t)NTOK * 1024 * 2) + (size_t)(m0 + tid) * 8;
    const f32x4 a = *(const f32x4*)sp, b4 = *(const f32x4*)(sp + 4);
    rs_l[tid] = rsqrtf((a[0] + a[1] + a[2] + a[3] + b4[0] + b4[1] + b4[2] + b4[3]) * (1.f / 1024.f) + 1e-6f);
  }
#pragma unroll
  for (int pp = 0; pp < 2; ++pp) {
    GemmPtrs g;
    f32x16 acc[2][2];
    gemm_setup(g, H2, 1024, m0, WQ, 1024, (hd * 2 + pp) * 128);
    zero_acc(acc);
    gemm_kloop(acc, g, 16, smem);
    {
      const int lane = tid & 63, w = tid >> 6, wm = w >> 1, wn = w & 1, r = lane & 31, h = lane >> 5;
#pragma unroll
      for (int i = 0; i < 2; ++i)
#pragma unroll
        for (int j = 0; j < 2; ++j)
          {
            const int nl = wn * 64 + j * 32 + r;
            char* colbase = smem + (nl >> 6) * 32768 + (nl & 7) * 2;
            const int chn = (nl & 63) >> 3;
#pragma unroll
            for (int k = 0; k < 16; ++k) {
              const int ml = wm * 64 + i * 32 + (k & 3) + 8 * (k >> 2) + 4 * h;
              *(u16*)(colbase + swz(ml, chn)) = f2bf(acc[i][j][k] * rs_l[ml]);
              if ((k & 3) == 3) asm volatile("" ::: "memory");
            }
          }
      const u16* skt = SK + (size_t)(hd * 2 + pp) * 128 * 128;
      char* dstB = smem + 16384 + (w * 4) * 1024 + lane * 16;
#pragma unroll
      for (int i = 0; i < 4; ++i) {
        const int rw = glds_row(i), ch = glds_chunk(rw);
        glds16(skt + (size_t)rw * 128 + ch * 8, dstB + i * 1024);
        glds16(skt + (size_t)rw * 128 + 64 + ch * 8, dstB + 32768 + i * 1024);
      }
      asm volatile("s_waitcnt vmcnt(0)" ::: "memory");
      __syncthreads();
      zero_acc(acc);
#pragma unroll
      for (int kt = 0; kt < 2; ++kt) {
        const char* A = smem + kt * 32768;
        const char* B = A + 16384;
#pragma unroll
        for (int s4 = 0; s4 < 4; ++s4) {
          bf16x8 a0 = lds_frag(A, wm * 64 + r, 2 * s4 + h);
          bf16x8 a1 = lds_frag(A, wm * 64 + 32 + r, 2 * s4 + h);
          bf16x8 b0 = lds_frag(B, wn * 64 + r, 2 * s4 + h);
          bf16x8 b1 = lds_frag(B, wn * 64 + 32 + r, 2 * s4 + h);
          acc[0][0] = mfma32(a0, b0, acc[0][0]);
          acc[0][1] = mfma32(a0, b1, acc[0][1]);
          acc[1][0] = mfma32(a1, b0, acc[1][0]);
          acc[1][1] = mfma32(a1, b1, acc[1][1]);
        }
      }
      __syncthreads();
    }
    gemm_epilogue(acc, [&](int ml, int nl, float v) { keys[ml * 132 + nl] = (f2ord(v) & ~127u) | (unsigned)(127 - nl); });
    __syncthreads();
    {
      const int t2 = tidx(), row = t2 >> 1, half = t2 & 1;
      unsigned kr[64];
#pragma unroll
      for (int j = 0; j < 16; ++j) {
        const u32x4 q4 = *(const u32x4*)(keys + row * 132 + half * 64 + 4 * j);
        kr[4 * j] = q4[0]; kr[4 * j + 1] = q4[1]; kr[4 * j + 2] = q4[2]; kr[4 * j + 3] = q4[3];
      }
      unsigned prev = 0xffffffffu;
#pragma unroll
      for (int rd = 0; rd < 16; ++rd) {
        unsigned best = 0u;
#pragma unroll
        for (int j = 0; j < 64; ++j) { const unsigned k = (kr[j] < prev) ? kr[j] : 0u; best = (k > best) ? k : best; }
        const unsigned other = dpp_xor1u(best);
        best = best > other ? best : other;
        prev = best;
        const float val = ord2f(best & ~127u);
        if (pp == 0) v1[rd] = val; else v2[rd] = val;
        if (half == 0) idxs[row * 32 + pp * 16 + rd] = (unsigned char)(127u - (best & 127u));
      }
    }
    __syncthreads();
  }
  const int t3 = tidx(), row = t3 >> 1, half = t3 & 1;
  unsigned ck[25];
  {
    constexpr int CI[50] = {0,0,0,0,0,0,0,0,0,0,0,0,0,0,0,0, 1,1,1,1,1,1,1,1, 2,2,2,2,2, 3,3,3,3, 4,4,4, 5,5, 6,6, 7,7, 8, 9, 10, 11, 12, 13, 14, 15};
    constexpr int CJ[50] = {0,1,2,3,4,5,6,7,8,9,10,11,12,13,14,15, 0,1,2,3,4,5,6,7, 0,1,2,3,4, 0,1,2,3, 0,1,2, 0,1, 0,1, 0,1, 0, 0, 0, 0, 0, 0, 0, 0};
#pragma unroll
    for (int c = 0; c < 25; ++c) {
      const float a = half ? v1[CI[2 * c + 1]] : v1[CI[2 * c]];
      const float b = half ? v2[CJ[2 * c + 1]] : v2[CJ[2 * c]];
      const int fl = half ? (16 * CI[2 * c + 1] + CJ[2 * c + 1]) : (16 * CI[2 * c] + CJ[2 * c]);
      ck[c] = (f2ord(a + b) & ~255u) | (unsigned)(255 - fl);
    }
  }
  int* EI = (int*)(ws + OFF_NQ) + ((size_t)(m0 + row) * 128 + hd * 16);
  float* GT = (float*)(ws + OFF_NKV) + ((size_t)(m0 + row) * 128 + hd * 16);
  float selv[16];
  unsigned prev = 0xffffffffu;
#pragma unroll
  for (int rd = 0; rd < 16; ++rd) {
    unsigned best = 0u;
#pragma unroll
    for (int c = 0; c < 25; ++c) { unsigned k = (ck[c] < prev) ? ck[c] : 0u; best = (k > best) ? k : best; }
    const unsigned other = dpp_xor1u(best);
    best = best > other ? best : other;
    prev = best;
    const int flat = 255 - (int)(best & 255u);
    selv[rd] = ord2f(best & ~255u);
    if (half == 0) EI[rd] = (int)idxs[row * 32 + (flat >> 4)] * 128 + (int)idxs[row * 32 + 16 + (flat & 15)];
  }
  float sum = 0.f;
  const float mx = selv[0];
#pragma unroll
  for (int k = 0; k < 16; ++k) { selv[k] = __expf(selv[k] - mx); sum += selv[k]; }
  const float inv = 1.f / sum;
  if (half == 0) {
#pragma unroll
    for (int k = 0; k < 16; ++k) GT[k] = selv[k] * inv;
  }
}

DI float gelu_tanh(float x) {
  const float u = 0.7978845608028654f * (x + 0.044715f * x * x * x);
  const float e = __expf(2.f * u);
  const float th = 1.f - 2.f / (e + 1.f);
  return 0.5f * x * (1.f + th);
}
DI void peer_expert_phase(const Params& p, int bid, int nblk) {
  char* ws = p.ws;
  const int lane = tidx() & 63, wv = tidx() >> 6;
  const unsigned char* EU = (const unsigned char*)(ws + OFF_EU);
  const unsigned char* EV = (const unsigned char*)(ws + OFF_EV);
  const float* SCU = (const float*)(ws + OFF_MISC + MISC_SCU);
  const float* SCV = (const float*)(ws + OFF_MISC + MISC_SCV);
  const int* EI = (const int*)(ws + OFF_NQ);
  const float* GT = (const float*)(ws + OFF_NKV);
  for (int tok = bid * 4 + wv; tok < NTOK; tok += nblk * 4) {
    const float* xr = (const float*)(ws + OFF_QKV) + (size_t)tok * 1024 + 16 * lane;
    f32x4 xa[4];
    float ss = 0.f;
#pragma unroll
    for (int i = 0; i < 4; ++i) { xa[i] = *(const f32x4*)(xr + 4 * i); ss += xa[i][0] * xa[i][0] + xa[i][1] * xa[i][1] + xa[i][2] * xa[i][2] + xa[i][3] * xa[i][3]; }
    ss = wave_sum(ss);
    const float rs = rsqrtf(ss * (1.f / 1024.f) + 1e-6f);
    f32x2 h2[8];
#pragma unroll
    for (int i = 0; i < 4; ++i) {
      const f32x4 w4 = *(const f32x4*)(p.norm_ffn + 16 * lane + 4 * i);
      h2[2 * i] = f32x2{bf2f(f2bf(xa[i][0] * rs * w4[0])), bf2f(f2bf(xa[i][1] * rs * w4[1]))};
      h2[2 * i + 1] = f32x2{bf2f(f2bf(xa[i][2] * rs * w4[2])), bf2f(f2bf(xa[i][3] * rs * w4[3]))};
    }
    f32x2 outv[8];
#pragma unroll
    for (int i = 0; i < 8; ++i) outv[i] = f32x2{0.f, 0.f};
#pragma unroll 1
    for (int bt = 0; bt < 2; ++bt) {
      const int eidx = EI[(size_t)tok * 128 + bt * 64 + lane];
      const float gt = GT[(size_t)tok * 128 + bt * 64 + lane];
      const float su = SCU[eidx], sv = SCV[eidx];
      float acc[64];
      {
        u32x4 cur[8], nxt[8];
#pragma unroll
        for (int j = 0; j < 8; ++j) cur[j] = *(const u32x4*)(EU + (size_t)__builtin_amdgcn_readlane(eidx, j) * 1024 + 16 * lane);
#pragma unroll
        for (int g = 0; g < 8; ++g) {
          if (g < 7) {
#pragma unroll
            for (int j = 0; j < 8; ++j) nxt[j] = *(const u32x4*)(EU + (size_t)__builtin_amdgcn_readlane(eidx, 8 * (g + 1) + j) * 1024 + 16 * lane);
          }
#pragma unroll
          for (int j = 0; j < 8; ++j) {
            f32x2 d = f32x2{0.f, 0.f};
#pragma unroll
            for (int i = 0; i < 4; ++i) {
              d += __builtin_amdgcn_cvt_pk_f32_fp8(cur[j][i], false) * h2[2 * i];
              d += __builtin_amdgcn_cvt_pk_f32_fp8(cur[j][i], true) * h2[2 * i + 1];
            }
            acc[8 * g + j] = d[0] + d[1];
          }
#pragma unroll
          for (int j = 0; j < 8; ++j) cur[j] = nxt[j];
        }
      }
#pragma unroll
      for (int st = 0; st < 6; ++st) {
        const int half = 32 >> st;
        const bool up = (lane & half) != 0;
#pragma unroll
        for (int k = 0; k < half; ++k) {
          const float send = up ? acc[k] : acc[k + half];
          const float keep = up ? acc[k + half] : acc[k];
          acc[k] = keep + __shfl_xor(send, half);
        }
      }
      const float wgt = gt * gelu_tanh(acc[0] * su) * sv;
      {
        u32x4 cur[8], nxt[8];
#pragma unroll
        for (int j = 0; j < 8; ++j) cur[j] = *(const u32x4*)(EV + (size_t)__builtin_amdgcn_readlane(eidx, j) * 1024 + 16 * lane);
#pragma unroll
        for (int g = 0; g < 8; ++g) {
          if (g < 7) {
#pragma unroll
            for (int j = 0; j < 8; ++j) nxt[j] = *(const u32x4*)(EV + (size_t)__builtin_amdgcn_readlane(eidx, 8 * (g + 1) + j) * 1024 + 16 * lane);
          }
#pragma unroll
          for (int j = 0; j < 8; ++j) {
            const float we = __uint_as_float((unsigned)__builtin_amdgcn_readlane((int)__float_as_uint(wgt), 8 * g + j));
            const f32x2 w2 = f32x2{we, we};
#pragma unroll
            for (int i = 0; i < 4; ++i) {
              outv[2 * i] += __builtin_amdgcn_cvt_pk_f32_fp8(cur[j][i], false) * w2;
              outv[2 * i + 1] += __builtin_amdgcn_cvt_pk_f32_fp8(cur[j][i], true) * w2;
            }
          }
#pragma unroll
          for (int j = 0; j < 8; ++j) cur[j] = nxt[j];
        }
      }
    }
    float s2 = 0.f;
#pragma unroll
    for (int i = 0; i < 4; ++i) {
      xa[i][0] += outv[2 * i][0]; xa[i][1] += outv[2 * i][1]; xa[i][2] += outv[2 * i + 1][0]; xa[i][3] += outv[2 * i + 1][1];
      s2 += xa[i][0] * xa[i][0] + xa[i][1] * xa[i][1] + xa[i][2] * xa[i][2] + xa[i][3] * xa[i][3];
    }
    s2 = wave_sum(s2);
    const float r2 = rsqrtf(s2 * (1.f / 1024.f) + 1e-6f);
    float* orow = p.out + (size_t)tok * 1024 + 16 * lane;
#pragma unroll
    for (int i = 0; i < 4; ++i) {
      const f32x4 nw = *(const f32x4*)(p.norm_final + 16 * lane + 4 * i);
      *(f32x4*)(orow + 4 * i) = f32x4{xa[i][0] * r2 * nw[0], xa[i][1] * r2 * nw[1], xa[i][2] * r2 * nw[2], xa[i][3] * r2 * nw[3]};
    }
  }
}

#ifndef MK_SINGLE
#define MK_SINGLE 1
#endif
#define SMEM_DECL __shared__ __attribute__((aligned(16))) char smem[SMEM_BYTES]

DI void run_phase(const Params& p, int ph, int bid, int nblk, char* smem) {
  switch (ph) {
    case 0: phase0(p, bid, nblk, smem); break;
    case 1: phase_inproj(p, bid, nblk, smem); break;
    case 2: phase2(p, bid, nblk, smem); break;
    case 3: phase4(p, smem); break;
    case 4: phase_branch(p, bid, nblk, smem); break;
    case 5: phase_outproj(p, bid, nblk, smem); break;
    case 6: for (int j = bid; j < 2048; j += nblk) peer_route_job(p, j, smem); break;
    case 7: peer_expert_phase(p, bid, nblk); break;
  }
}
constexpr int NPHASES = 8;

#if MK_SINGLE
DI void grid_barrier(unsigned* ctr, unsigned target) {
  asm volatile("s_waitcnt vmcnt(0)" ::: "memory");
  __syncthreads();
  if (tidx() == 0) {
    __builtin_amdgcn_fence(__ATOMIC_RELEASE, "agent");
    asm volatile("s_waitcnt vmcnt(0)" ::: "memory");
    __hip_atomic_fetch_add(ctr, 1u, __ATOMIC_RELAXED, __HIP_MEMORY_SCOPE_AGENT);
    while (__hip_atomic_load(ctr, __ATOMIC_RELAXED, __HIP_MEMORY_SCOPE_AGENT) < target) __builtin_amdgcn_s_sleep(2);
    __builtin_amdgcn_fence(__ATOMIC_ACQUIRE, "agent");
    asm volatile("s_waitcnt vmcnt(0)" ::: "memory");
  }
  __syncthreads();
}
#ifndef MK_PROBE_SPLIT
#define MK_PROBE_SPLIT 0
#endif
#ifndef PROBE_P4
#define PROBE_P4 103
#endif
#ifndef PROBE_REPEAT
#define PROBE_REPEAT 0
#endif
#if MK_PROBE_SPLIT
__global__ void __launch_bounds__(NTHREADS, 2) fwd_megakernel(Params p, int phase_sel) {
#else
__global__ void __launch_bounds__(NTHREADS, 2) fwd_megakernel(Params p) {
#endif
  SMEM_DECL;
  cg::grid_group grid = cg::this_grid();
  const int bid = blockIdx.x, nblk = gridDim.x;
  unsigned* bar = (unsigned*)(p.ws + OFF_MISC + MISC_CNT) + 8;
#if MK_PROBE_SPLIT
  switch (phase_sel) {
    case 0: run_phase(p, 0, bid, nblk, smem); break;
    case 1: run_phase(p, 1, bid, nblk, smem); break;
    case 2: run_phase(p, 2, bid, nblk, smem); break;
    case 3: run_phase(p, 3, bid, nblk, smem); break;
    case 103: phase4(p, smem, 1); break;
    case 203: phase4(p, smem, 2); break;
    case 4: run_phase(p, 4, bid, nblk, smem); break;
    case 5: run_phase(p, 5, bid, nblk, smem); break;
    case 6: run_phase(p, 6, bid, nblk, smem); break;
    default: run_phase(p, 7, bid, nblk, smem); break;
  }
  if (phase_sel < 0) { grid.sync(); grid_barrier(bar, 1u); }
#else
  run_phase(p, 0, bid, nblk, smem); grid.sync();
  run_phase(p, 1, bid, nblk, smem); grid_barrier(bar, 1u * nblk);
  run_phase(p, 2, bid, nblk, smem); grid_barrier(bar, 2u * nblk);
  run_phase(p, 3, bid, nblk, smem); grid_barrier(bar, 3u * nblk);
  run_phase(p, 4, bid, nblk, smem); grid_barrier(bar, 4u * nblk);
  run_phase(p, 5, bid, nblk, smem); grid_barrier(bar, 5u * nblk);
  run_phase(p, 6, bid, nblk, smem); grid_barrier(bar, 6u * nblk);
  run_phase(p, 7, bid, nblk, smem);
#endif
}
#else
template <int PH>
__global__ void __launch_bounds__(NTHREADS, 2) phase_kernel(Params p) {
  SMEM_DECL;
  run_phase(p, PH, blockIdx.x, gridDim.x, smem);
}
__global__ void __launch_bounds__(NTHREADS, 2) phase4_again(Params p) { SMEM_DECL; phase4(p, smem, 1); }
#ifndef REPEAT_MASK
#define REPEAT_MASK 0
#endif
#endif

extern "C" void kernel_launch(void* const* d_in, const int* in_sizes, int n_in, void* d_out, int out_size, void* d_ws, size_t ws_size,
                              hipStream_t stream) {
  Params p{};
  const float** f = (const float**)&p;
  for (int i = 0; i < 21; ++i) f[i] = (const float*)d_in[i];
  p.out = (float*)d_out;
  p.ws = (char*)d_ws;
  if (ws_size < WS_NEEDED) return;
#if MK_SINGLE
  static int grid_blocks = 0;
  if (!grid_blocks) {
    int dev = 0, cus = 0, per_cu = 0;
    hipGetDevice(&dev);
    hipDeviceGetAttribute(&cus, hipDeviceAttributeMultiprocessorCount, dev);
    hipOccupancyMaxActiveBlocksPerMultiprocessor(&per_cu, fwd_megakernel, NTHREADS, 0);
    if (per_cu > 2) per_cu = 2;
    grid_blocks = cus * per_cu;
  }
#if MK_PROBE_SPLIT
  for (int ph = 0; ph < NPHASES; ++ph) {
    fwd_megakernel<<<grid_blocks, NTHREADS, 0, stream>>>(p, ph);
    if ((PROBE_REPEAT >> ph) & 1) fwd_megakernel<<<grid_blocks, NTHREADS, 0, stream>>>(p, ph == 3 ? PROBE_P4 : ph);
  }
#else
  void* args[] = {&p};
  hipLaunchCooperativeKernel((void*)fwd_megakernel, dim3(grid_blocks), dim3(NTHREADS), args, 0, stream);
#endif
#else
  const int G = 512;
  phase_kernel<0><<<G, NTHREADS, 0, stream>>>(p);
#if REPEAT_MASK & (1 << 0)
  phase_kernel<0><<<G, NTHREADS, 0, stream>>>(p);
#endif
  phase_kernel<1><<<G, NTHREADS, 0, stream>>>(p);
#if REPEAT_MASK & (1 << 1)
  phase_kernel<1><<<G, NTHREADS, 0, stream>>>(p);
#endif
  phase_kernel<2><<<G, NTHREADS, 0, stream>>>(p);
#if REPEAT_MASK & (1 << 2)
  phase_kernel<2><<<G, NTHREADS, 0, stream>>>(p);
#endif
  phase_kernel<3><<<G, NTHREADS, 0, stream>>>(p);
#if REPEAT_MASK & (1 << 3)
  phase4_again<<<G, NTHREADS, 0, stream>>>(p);
#endif
  phase_kernel<4><<<G, NTHREADS, 0, stream>>>(p);
#if REPEAT_MASK & (1 << 4)
  phase_kernel<4><<<G, NTHREADS, 0, stream>>>(p);
#endif
  phase_kernel<5><<<G, NTHREADS, 0, stream>>>(p);
#if REPEAT_MASK & (1 << 5)
  phase_kernel<5><<<G, NTHREADS, 0, stream>>>(p);
#endif
  phase_kernel<6><<<G, NTHREADS, 0, stream>>>(p);
#if REPEAT_MASK & (1 << 6)
  phase_kernel<6><<<G, NTHREADS, 0, stream>>>(p);
#endif
  phase_kernel<7><<<G, NTHREADS, 0, stream>>>(p);
#if REPEAT_MASK & (1 << 7)
  phase_kernel<7><<<G, NTHREADS, 0, stream>>>(p);
#endif
#endif
}
```

```cpp
#include <hip/hip_runtime.h>
#include <hip/hip_cooperative_groups.h>
#include <stdint.h>
namespace cg = cooperative_groups;

#define DI __device__ __forceinline__
#ifndef SCAN_REP
#define SCAN_REP 0
#endif
typedef unsigned short u16;
typedef __attribute__((ext_vector_type(8))) short bf16x8;
typedef __attribute__((ext_vector_type(16))) float f32x16;
typedef __attribute__((ext_vector_type(4))) float f32x4;
typedef __attribute__((ext_vector_type(4))) unsigned u32x4;
typedef __attribute__((ext_vector_type(2))) unsigned u32x2;
typedef __attribute__((ext_vector_type(2))) __bf16 bf16x2v;

constexpr int BATCH = 8, SEQ = 4096, DM = 1024, NTOK = BATCH * SEQ;
constexpr int NIN = 5416, NP = 5504;
constexpr int NTHREADS = 256;
constexpr int SMEM_BYTES = 72 * 1024;
constexpr float L2E = 1.4426950408889634f;

constexpr size_t AL(size_t x) { return (x + 255) & ~(size_t)255; }
constexpr size_t OFF_WINT = 0;
constexpr size_t OFF_WAT = OFF_WINT + AL((size_t)NP * 1024 * 2);
constexpr size_t OFF_WBT = OFF_WAT + AL((size_t)1024 * 512 * 2);
constexpr size_t OFF_WOT = OFF_WBT + AL((size_t)1024 * 512 * 2);
constexpr size_t OFF_WQT = OFF_WOT + AL((size_t)1024 * 1024 * 2);
constexpr size_t OFF_SK = OFF_WQT + AL((size_t)2048 * 1024 * 2);
constexpr size_t OFF_WKT = OFF_SK + AL((size_t)16 * 128 * 128 * 2);
constexpr size_t OFF_WVT = OFF_WKT + AL((size_t)128 * 2048 * 2);
constexpr size_t OFF_EU = OFF_WVT + AL((size_t)128 * 2048 * 2);
constexpr size_t OFF_EV = OFF_EU + AL((size_t)16384 * 1024 * 2);
constexpr size_t OFF_MISC = OFF_EV + AL((size_t)16384 * 1024 * 2);
constexpr size_t MISC_CK = 0, MISC_CV = 256, MISC_BIAS = 512, MISC_CNT = 512 + 8 * 132 * 4 + 256, MISC_GL = 8192;
constexpr size_t MISC_SCU = 65536, MISC_SCV = 131072;
constexpr size_t OFF_RH = OFF_MISC + 262144;
constexpr size_t OFF_QKV = OFF_RH + (size_t)NTOK * 1024 * 2;
constexpr size_t OFF_Z = OFF_QKV + (size_t)NTOK * 1536 * 2;
constexpr size_t OFF_NQ = OFF_Z + (size_t)NTOK * 512 * 2;
constexpr size_t OFF_NKV = OFF_NQ + (size_t)NTOK * 512 * 2;
constexpr size_t OFF_MG = OFF_NKV + (size_t)NTOK * 768 * 2;
constexpr size_t OFF_SM = OFF_MG + (size_t)NTOK * 2048 * 2;
constexpr size_t OFF_VST = OFF_SM + AL((size_t)NTOK * 40 * 4);
constexpr size_t OFF_VWT = OFF_VST + (size_t)16 * 64 * 4096 * 2;
constexpr size_t OFF_KC = OFF_VWT + (size_t)16 * 64 * 4096 * 2;
constexpr size_t OFF_VCT = OFF_KC + (size_t)16 * 256 * 64 * 2;
constexpr size_t WS_NEEDED = OFF_VCT + (size_t)16 * 64 * 256 * 2;

struct Params {
  const float *x, *rel_bias, *norm_final, *norm_mix, *w_in, *conv_w, *a_log, *dt_bias, *gdn_norm, *cmp_pe_k, *cmp_pe_v,
      *cmp_w_k, *cmp_w_v, *w_a, *w_b, *w_out, *norm_ffn, *w_query, *sub_keys, *expert_u, *expert_v;
  float* out;
  char* ws;
};

DI u16 f2bf(float x) { return __builtin_bit_cast(u16, (__bf16)x); }
DI float bf2f(u16 b) { return __uint_as_float(((unsigned)b) << 16); }
typedef __attribute__((ext_vector_type(2))) float f32x2_;
typedef __attribute__((ext_vector_type(2))) __bf16 bf16x2_;
DI unsigned pack2(float lo, float hi) { f32x2_ v = {lo, hi}; return __builtin_bit_cast(unsigned, __builtin_convertvector(v, bf16x2_)); }
DI float bflo(unsigned u) { return __uint_as_float(u << 16); }
DI float bfhi(unsigned u) { return __uint_as_float(u & 0xffff0000u); }
DI float wave_sum(float v) {
#pragma unroll
  for (int o = 32; o >= 1; o >>= 1) v += __shfl_xor(v, o);
  return v;
}
DI int tidx() { int t = (int)__builtin_amdgcn_workitem_id_x(); asm volatile("" : "+v"(t)); return t; }
DI int opaque0() { int z = 0; asm volatile("" : "+v"(z)); return z; }
template <int CTRL> DI float dppf(float x) { return __uint_as_float((unsigned)__builtin_amdgcn_mov_dpp((int)__float_as_uint(x), CTRL, 0xF, 0xF, true)); }
DI float dpp_xor1(float x) { return __uint_as_float((unsigned)__builtin_amdgcn_mov_dpp((int)__float_as_uint(x), 0xB1, 0xF, 0xF, true)); }
DI unsigned dpp_xor1u(unsigned x) { return (unsigned)__builtin_amdgcn_mov_dpp((int)x, 0xB1, 0xF, 0xF, true); }
DI float sigmoidf_(float x) { return 1.f / (1.f + __expf(-x)); }
DI f32x16 mfma32(bf16x8 a, bf16x8 b, f32x16 c) { return __builtin_amdgcn_mfma_f32_32x32x16_bf16(a, b, c, 0, 0, 0); }
DI f32x4 mfma16(bf16x8 a, bf16x8 b, f32x4 c) { return __builtin_amdgcn_mfma_f32_16x16x32_bf16(a, b, c, 0, 0, 0); }
DI int swz(int row, int ch) { return row * 128 + ((ch ^ ((row >> 1) & 7)) << 4); }
DI bf16x8 lds_frag(const char* tile, int row, int ch) { return *(const bf16x8*)(tile + swz(row, ch)); }
DI bf16x8 pad_frag(const char* tile, int row, int ch) { return *(const bf16x8*)(tile + row * 144 + ch * 16); }
DI bf16x8 pack8(float a0, float a1, float a2, float a3, float a4, float a5, float a6, float a7) {
  u32x4 p;
  p[0] = pack2(a0, a1); p[1] = pack2(a2, a3); p[2] = pack2(a4, a5); p[3] = pack2(a6, a7);
  return __builtin_bit_cast(bf16x8, p);
}
DI int perm16(int o) { return (o & ~12) | ((o & 4) << 1) | ((o & 8) >> 1); }

DI int win_colmap(int n) {
  if (n < 2048) return n;
  if (n < 2560) return n - 2048 + 2064;
  if (n < 3328) return n - 2560 + 2576;
  if (n < 5376) return n - 3328 + 3368;
  if (n < 5392) return n - 5376 + 2048;
  if (n < 5416) return n - 5392 + 3344;
  return -1;
}
template <int MAPMODE>
DI void tconv_tile(const float* __restrict__ src, int K, int N, u16* __restrict__ dst, int kt, int nt, char* smem, const float* kscale = nullptr) {
  float* tile = (float*)smem;
  const int tid = tidx();
  const int nl = tid & 63, k0 = kt * 64, n0 = nt * 64;
  int col;
  if (MAPMODE == 1) col = win_colmap(n0 + nl); else col = (n0 + nl < N) ? (n0 + nl) : -1;
#pragma unroll 4
  for (int i = 0; i < 16; ++i) {
    int kl = (tid >> 6) + 4 * i;
    float v = (col >= 0) ? src[(size_t)(k0 + kl) * N + col] : 0.f;
    if (kscale) v *= kscale[k0 + kl];
    tile[kl * 65 + nl] = v;
  }
  __syncthreads();
  {
    const int n2 = tid >> 2, kp = tid & 3;
    u32x4 o0, o1;
#pragma unroll
    for (int i = 0; i < 4; ++i) {
      o0[i] = pack2(tile[(kp * 16 + 2 * i) * 65 + n2], tile[(kp * 16 + 2 * i + 1) * 65 + n2]);
      o1[i] = pack2(tile[(kp * 16 + 8 + 2 * i) * 65 + n2], tile[(kp * 16 + 8 + 2 * i + 1) * 65 + n2]);
    }
    u16* d = dst + (size_t)(n0 + n2) * K + k0 + kp * 16;
    *(u32x4*)d = o0;
    *(u32x4*)(d + 8) = o1;
  }
  __syncthreads();
}

DI void convert_flat(const float* __restrict__ src, u16* __restrict__ dst, size_t n, int bid, int nblk) {
  size_t nv = n / 8;
  for (size_t i = (size_t)bid * NTHREADS + tidx(); i < nv; i += (size_t)nblk * NTHREADS) {
    f32x4 a = ((const f32x4*)src)[2 * i], b = ((const f32x4*)src)[2 * i + 1];
    u32x4 o;
    o[0] = pack2(a[0], a[1]); o[1] = pack2(a[2], a[3]); o[2] = pack2(b[0], b[1]); o[3] = pack2(b[2], b[3]);
    ((u32x4*)dst)[i] = o;
  }
}


typedef __attribute__((ext_vector_type(2))) float f32x2;
DI unsigned f32_to_e4m3(float x) {
  unsigned u = __float_as_uint(x);
  const unsigned sign = (u >> 24) & 0x80u;
  u &= 0x7fffffffu;
  const float ax = __uint_as_float(u);
  unsigned r;
  if (ax < 0.015625f) r = (unsigned)__float2int_rn(ax * 512.f);
  else { u += 0x7ffffu + ((u >> 20) & 1u); r = (u >> 20) - (120u << 3); if (r > 0x7eu) r = 0x7eu; }
  return sign | r;
}
DI void convert_fp8_rows(const float* __restrict__ src, unsigned char* __restrict__ dst, float* __restrict__ inv_scale, int nrows, int bid, int nblk) {
  const int lane = tidx() & 63, wv = tidx() >> 6;
  for (int row = bid * 4 + wv; row < nrows; row += nblk * 4) {
    const f32x4* sp = (const f32x4*)(src + (size_t)row * 1024 + 16 * lane);
    f32x4 v[4];
    float mx = 0.f;
#pragma unroll
    for (int i = 0; i < 4; ++i) { v[i] = sp[i]; mx = fmaxf(mx, fmaxf(fmaxf(fabsf(v[i][0]), fabsf(v[i][1])), fmaxf(fabsf(v[i][2]), fabsf(v[i][3])))); }
#pragma unroll
    for (int o = 32; o >= 1; o >>= 1) mx = fmaxf(mx, __shfl_xor(mx, o));
    const float sc = (mx > 0.f) ? 240.f / mx : 1.f;
    u32x4 o4;
#pragma unroll
    for (int i = 0; i < 4; ++i)
      o4[i] = f32_to_e4m3(v[i][0] * sc) | (f32_to_e4m3(v[i][1] * sc) << 8) | (f32_to_e4m3(v[i][2] * sc) << 16) | (f32_to_e4m3(v[i][3] * sc) << 24);
    *(u32x4*)(dst + (size_t)row * 1024 + 16 * lane) = o4;
    if (lane == 0) inv_scale[row] = (mx > 0.f) ? mx / 240.f : 1.f;
  }
}

DI void rmsnorm_rows_bf16(const float* __restrict__ src, const float* __restrict__ w, u16* __restrict__ dst, int nrows, int bid, int nblk) {
  const int lane = tidx() & 63, wv = tidx() >> 6;
  f32x4 wr[4];
#pragma unroll
  for (int i = 0; i < 4; ++i) wr[i] = ((const f32x4*)w)[lane + 64 * i];
  for (int row = bid * 4 + wv; row < nrows; row += nblk * 4) {
    const f32x4* s = (const f32x4*)(src + (size_t)row * 1024);
    f32x4 v[4];
    float ss = 0.f;
#pragma unroll
    for (int i = 0; i < 4; ++i) { v[i] = s[lane + 64 * i]; ss += v[i][0] * v[i][0] + v[i][1] * v[i][1] + v[i][2] * v[i][2] + v[i][3] * v[i][3]; }
    ss = wave_sum(ss);
    float rs = rsqrtf(ss * (1.f / 1024.f) + 1e-6f);
#pragma unroll
    for (int i = 0; i < 4; ++i) {
      u32x2 o;
      o[0] = pack2(v[i][0] * rs * wr[i][0], v[i][1] * rs * wr[i][1]);
      o[1] = pack2(v[i][2] * rs * wr[i][2], v[i][3] * rs * wr[i][3]);
      *(u32x2*)(dst + (size_t)row * 1024 + (lane + 64 * i) * 4) = o;
    }
  }
}

DI int t5_bucket(int d) {
  if (d < 16) return d < 0 ? 0 : d;
  const int th[16] = {16, 19, 21, 24, 27, 31, 35, 40, 46, 52, 59, 67, 77, 87, 99, 113};
  int b = 16;
#pragma unroll
  for (int k = 1; k < 16; ++k) b += (d >= th[k]) ? 1 : 0;
  return b;
}

DI void phase0(const Params& p, int bid, int nblk, char* smem) {
  char* ws = p.ws;
  const int n_win = 16 * 86, n_wa = 8 * 16, n_wo = 16 * 16, n_wq = 16 * 32, n_wc = 32 * 2;
  const int total = n_win + 2 * n_wa + n_wo + n_wq + 2 * n_wc;
  for (int it = bid; it < total; it += nblk) {
    int i = it;
    if (i < n_win) { tconv_tile<1>(p.w_in, 1024, NIN, (u16*)(ws + OFF_WINT), i / 86, i % 86, smem); continue; }
    i -= n_win;
    if (i < n_wa) { tconv_tile<0>(p.w_a, 512, 1024, (u16*)(ws + OFF_WAT), i / 16, i % 16, smem); continue; }
    i -= n_wa;
    if (i < n_wa) { tconv_tile<0>(p.w_b, 512, 1024, (u16*)(ws + OFF_WBT), i / 16, i % 16, smem); continue; }
    i -= n_wa;
    if (i < n_wo) { tconv_tile<0>(p.w_out, 1024, 1024, (u16*)(ws + OFF_WOT), i / 16, i % 16, smem); continue; }
    i -= n_wo;
    if (i < n_wq) { tconv_tile<0>(p.w_query, 1024, 2048, (u16*)(ws + OFF_WQT), i / 32, i % 32, smem, p.norm_ffn); continue; }
    i -= n_wq;
    if (i < n_wc) { tconv_tile<0>(p.cmp_w_k, 2048, 64, (u16*)(ws + OFF_WKT), i / 2, i % 2, smem); continue; }
    i -= n_wc;
    tconv_tile<0>(p.cmp_w_v, 2048, 64, (u16*)(ws + OFF_WVT), i / 2, i % 2, smem);
  }
  convert_flat(p.sub_keys, (u16*)(ws + OFF_SK), (size_t)16 * 128 * 128, bid, nblk);
  rmsnorm_rows_bf16(p.x, p.norm_mix, (u16*)(ws + OFF_RH), NTOK, bid, nblk);
  const int tid = tidx();
  if (bid == nblk - 1) {
    float* ck = (float*)(ws + OFF_MISC + MISC_CK);
    float* cv = (float*)(ws + OFF_MISC + MISC_CV);
    if (tid < 128) {
      const int e = tid & 63;
      const float* pe = (tid < 64) ? p.cmp_pe_k : p.cmp_pe_v;
      const float* W = (tid < 64) ? p.cmp_w_k : p.cmp_w_v;
      float s = 0.f;
      for (int k = 0; k < 2048; ++k) s += pe[k] * W[(size_t)k * 64 + e];
      if (tid < 64) ck[e] = s; else cv[e] = s;
    }
  }
  if (bid == nblk - 2 || nblk == 1) {
    float* bt = (float*)(ws + OFF_MISC + MISC_BIAS);
    for (int i = tid; i < 8 * 132; i += NTHREADS) {
      int hd = i / 132, d = i % 132;
      bt[i] = p.rel_bias[t5_bucket(d) * 8 + hd] * L2E;
    }
    if (tid < 16) ((unsigned*)(ws + OFF_MISC + MISC_CNT))[tid] = 0u;
  }
}

struct GemmPtrs {
  const u16* a[4];
  const u16* b[4];
  long aks, bks;
};

typedef __attribute__((address_space(3))) unsigned* lds_u32p;
DI void glds16(const u16* gsrc, const char* lds_dst) {
  __builtin_amdgcn_global_load_lds((const unsigned*)gsrc, (lds_u32p)(unsigned)(size_t)lds_dst, 16, 0, 0);
}
DI void gemm_kloop(f32x16 (&acc)[2][2], const GemmPtrs& g, int nkt, char* smem) {
  const int tid = tidx(), lane = tid & 63, w = tid >> 6, wm = w >> 1, wn = w & 1, r = lane & 31, h = lane >> 5;
  const char* dstA = smem + (w * 4) * 1024 + lane * 16;
#pragma unroll
  for (int i = 0; i < 4; ++i) { glds16(g.a[i], dstA + i * 1024); glds16(g.b[i], dstA + 16384 + i * 1024); }
  asm volatile("s_waitcnt vmcnt(0)" ::: "memory");
  __syncthreads();
  for (int kt = 0; kt < nkt; ++kt) {
    const char* A = smem + (kt & 1) * 32768;
    const char* B = A + 16384;
    if (kt + 1 < nkt) {
      const char* d2 = dstA + ((kt + 1) & 1) * 32768;
#pragma unroll
      for (int i = 0; i < 4; ++i) { glds16(g.a[i] + (long)(kt + 1) * g.aks, d2 + i * 1024); glds16(g.b[i] + (long)(kt + 1) * g.bks, d2 + 16384 + i * 1024); }
    }
#pragma unroll
    for (int s = 0; s < 4; ++s) {
      bf16x8 a0 = lds_frag(A, wm * 64 + r, 2 * s + h);
      bf16x8 a1 = lds_frag(A, wm * 64 + 32 + r, 2 * s + h);
      bf16x8 b0 = lds_frag(B, wn * 64 + r, 2 * s + h);
      bf16x8 b1 = lds_frag(B, wn * 64 + 32 + r, 2 * s + h);
      acc[0][0] = mfma32(a0, b0, acc[0][0]);
      acc[0][1] = mfma32(a0, b1, acc[0][1]);
      acc[1][0] = mfma32(a1, b0, acc[1][0]);
      acc[1][1] = mfma32(a1, b1, acc[1][1]);
    }
    asm volatile("s_waitcnt vmcnt(0)" ::: "memory");
    __syncthreads();
  }
}

DI void zero_acc(f32x16 (&acc)[2][2]) {
#pragma unroll
  for (int i = 0; i < 2; ++i)
#pragma unroll
    for (int j = 0; j < 2; ++j)
#pragma unroll
      for (int k = 0; k < 16; ++k) acc[i][j][k] = 0.f;
}
DI int glds_row(int i) { return ((tidx() >> 6) * 4 + i) * 8 + ((tidx() & 63) >> 3); }
DI int glds_chunk(int row) { return (tidx() & 7) ^ ((row >> 1) & 7); }
DI void gemm_setup(GemmPtrs& g, const u16* A, long lda, int m0, const u16* Bt, long ldb, int n0) {
#pragma unroll
  for (int i = 0; i < 4; ++i) {
    const int row = glds_row(i), ch = glds_chunk(row);
    g.a[i] = A + (size_t)(m0 + row) * lda + ch * 8;
    g.b[i] = Bt + (size_t)(n0 + row) * ldb + ch * 8;
  }
  g.aks = 64; g.bks = 64;
}
template <class F>
DI void gemm_epilogue(const f32x16 (&acc)[2][2], F f) {
  const int lane = tidx() & 63, w = tidx() >> 6, wm = w >> 1, wn = w & 1, r = lane & 31, h = lane >> 5;
#pragma unroll
  for (int i = 0; i < 2; ++i)
#pragma unroll
    for (int j = 0; j < 2; ++j) {
#pragma unroll
      for (int k = 0; k < 16; ++k) f(wm * 64 + i * 32 + (k & 3) + 8 * (k >> 2) + 4 * h, wn * 64 + j * 32 + r, acc[i][j][k]);
      asm volatile("" ::: "memory");
    }
}

template <class F>
DI void gemm_epilogue_lds(const f32x16 (&acc)[2][2], char* smem, F f) {
  float* T = (float*)smem;
  {
    const int lane = tidx() & 63, w = tidx() >> 6, wm = w >> 1, wn = w & 1, r = lane & 31, h = lane >> 5;
#pragma unroll
    for (int i = 0; i < 2; ++i)
#pragma unroll
      for (int j = 0; j < 2; ++j)
#pragma unroll
        for (int k = 0; k < 16; ++k) T[(wm * 64 + i * 32 + (k & 3) + 8 * (k >> 2) + 4 * h) * 132 + wn * 64 + j * 32 + r] = acc[i][j][k];
  }
  __syncthreads();
  const int c8 = (tidx() & 15) * 8, r0 = tidx() >> 4;
#pragma unroll 2
  for (int it = 0; it < 8; ++it) {
    const int row = r0 + 16 * it;
    const f32x4 a = *(const f32x4*)(T + row * 132 + c8), b = *(const f32x4*)(T + row * 132 + c8 + 4);
    const float v[8] = {a[0], a[1], a[2], a[3], b[0], b[1], b[2], b[3]};
    f(row, c8, v);
  }
  __syncthreads();
}
DI u32x4 pack8u(const float (&v)[8]) { u32x4 o; o[0] = pack2(v[0], v[1]); o[1] = pack2(v[2], v[3]); o[2] = pack2(v[4], v[5]); o[3] = pack2(v[6], v[7]); return o; }

DI bool xcd_tile(int k, int bid, int nblk, int NMT, int NNT, int& mt, int& nt) {
  if ((nblk & 7) != 0 || nblk < 8) {
    const int t = bid + k * nblk;
    if (t >= NMT * NNT) return false;
    mt = t / NNT; nt = t % NNT; return true;
  }
  const int x = bid & 7, j = bid >> 3, per = nblk >> 3;
  const int groups = NMT >> 6;
  const int i = j + k * per;
  if (i >= groups * 8 * NNT) return false;
  const int g = i / (8 * NNT), rem = i - g * (8 * NNT);
  nt = rem >> 3; mt = ((x + 8 * g) << 3) + (rem & 7);
  return true;
}

DI void phase_inproj(const Params& p, int bid, int nblk, char* smem) {
  char* ws = p.ws;
  const u16* H = (const u16*)(ws + OFF_RH);
  const u16* W = (const u16*)(ws + OFF_WINT);
  const int NT = NP / 128;
  for (int k = 0;; ++k) {
    int mt, nt;
    if (!xcd_tile(k, bid, nblk, 256, NT, mt, nt)) break;
    const int m0 = mt * 128, n0 = nt * 128;
    GemmPtrs g;
    gemm_setup(g, H, 1024, m0, W, 1024, n0);
    f32x16 acc[2][2];
    zero_acc(acc);
    gemm_kloop(acc, g, 16, smem);
    if (n0 >= 5376) {
      float* SM = (float*)(ws + OFF_SM);
      gemm_epilogue_lds(acc, smem, [&](int ml, int nl, const float (&v)[8]) {
        if (nl < 40) {
          float* d = SM + (size_t)(m0 + ml) * 40 + nl;
          *(f32x4*)d = f32x4{v[0], v[1], v[2], v[3]};
          *(f32x4*)(d + 4) = f32x4{v[4], v[5], v[6], v[7]};
        }
      });
    } else {
      u16* dst; int ld, c0;
      if (n0 < 1536) { dst = (u16*)(ws + OFF_QKV); ld = 1536; c0 = n0; }
      else if (n0 < 2048) { dst = (u16*)(ws + OFF_Z); ld = 512; c0 = n0 - 1536; }
      else if (n0 < 2560) { dst = (u16*)(ws + OFF_NQ); ld = 512; c0 = n0 - 2048; }
      else if (n0 < 3328) { dst = (u16*)(ws + OFF_NKV); ld = 768; c0 = n0 - 2560; }
      else { dst = (u16*)(ws + OFF_MG); ld = 2048; c0 = n0 - 3328; }
      gemm_epilogue_lds(acc, smem, [&](int ml, int nl, const float (&v)[8]) { *(u32x4*)(dst + (size_t)(m0 + ml) * ld + c0 + nl) = pack8u(v); });
    }
  }
}

DI void vtrans_item(const Params& p, int item, char* smem) {
  char* ws = p.ws;
  const int tile = item & 63, bg = (item >> 6) & 15, which = item >> 10;
  const int b = bg >> 1, g = bg & 1;
  const u16* NKV = (const u16*)(ws + OFF_NKV);
  u16* VT = (u16*)(ws + (which ? OFF_VWT : OFF_VST)) + ((size_t)bg * 64 + tile) * 4096;
  const int col0 = (which ? 640 : 384) + g * 64;
  u16* t = (u16*)smem;
  const int tid = tidx();
  {
#pragma unroll
    for (int i = 0; i < 2; ++i) {
      int c = tid + 256 * i, row = c >> 3, ch = c & 7;
      u32x4 v = *(const u32x4*)(NKV + (size_t)(b * SEQ + tile * 64 + row) * 768 + col0 + ch * 8);
      *(u32x4*)(t + row * 72 + ch * 8) = v;
    }
  }
  __syncthreads();
  {
    const int d = tid >> 2, part = tid & 3;
    u32x4 o0, o1;
    u16 vals[16];
#pragma unroll
    for (int pp = 0; pp < 16; ++pp) vals[pp] = t[(part * 16 + perm16(pp)) * 72 + d];
#pragma unroll
    for (int i = 0; i < 4; ++i) {
      o0[i] = (unsigned)vals[2 * i] | ((unsigned)vals[2 * i + 1] << 16);
      o1[i] = (unsigned)vals[8 + 2 * i] | ((unsigned)vals[8 + 2 * i + 1] << 16);
    }
    u16* dst = VT + (size_t)d * 64 + part * 16;
    *(u32x4*)dst = o0;
    *(u32x4*)(dst + 8) = o1;
  }
  __syncthreads();
}

DI void cmp_gemm_item(const Params& p, int item, char* smem) {
  char* ws = p.ws;
  const int which = item >> 5, mt = item & 31, m0 = mt * 128;
  const u16* NKV = (const u16*)(ws + OFF_NKV);
  const u16* Wt = (const u16*)(ws + (which ? OFF_WVT : OFF_WKT));
  GemmPtrs g;
#pragma unroll
  for (int i = 0; i < 4; ++i) {
    const int row = glds_row(i), ch = glds_chunk(row);
    int m = m0 + row, bg = m >> 8, n = m & 255;
    if (n > 254) n = 254;
    g.a[i] = NKV + (size_t)((bg >> 1) * SEQ + 16 * n) * 768 + which * 128 + (bg & 1) * 64 + ch * 8;
    g.b[i] = Wt + (size_t)row * 2048 + ch * 8;
  }
  g.aks = 768; g.bks = 64;
  f32x16 acc[2][2];
  zero_acc(acc);
  gemm_kloop(acc, g, 32, smem);
  const float* cc = (const float*)(ws + OFF_MISC + (which ? MISC_CV : MISC_CK));
  if (which == 0) {
    u16* KC = (u16*)(ws + OFF_KC);
    gemm_epilogue_lds(acc, smem, [&](int ml, int nl, const float (&v)[8]) {
      if (nl < 64) {
        float t[8];
#pragma unroll
        for (int e = 0; e < 8; ++e) t[e] = v[e] + cc[nl + e];
        *(u32x4*)(KC + (size_t)(m0 + ml) * 64 + nl) = pack8u(t);
      }
    });
  } else {
    u16* VCT = (u16*)(ws + OFF_VCT);
    gemm_epilogue_lds(acc, smem, [&](int ml, int nl, const float (&v)[8]) {
      if (nl < 64) {
        const int m = m0 + ml, bg = m >> 8, n = m & 255;
        u16* d = VCT + (((size_t)bg * 4 + (n >> 6)) * 64 + nl) * 64 + (n & 48) + perm16(n & 15);
#pragma unroll
        for (int e = 0; e < 8; ++e) d[e * 64] = f2bf(v[e] + cc[nl + e]);
      }
    });
  }
}

DI void gdn_store_frag(u16* dst, const char* tile, int idx  , float scale_is_row, const float* rowscale) {
  const int blk = idx >> 6, lane = idx & 63, rt = blk >> 1, ks = blk & 1, r = lane & 15, q = lane >> 4;
  const int row = 16 * rt + r;
  const int k0 = 32 * ks + 4 * q, k1 = k0 + 16;
  u32x2 lo = *(const u32x2*)(tile + swz(row, k0 >> 3) + (k0 & 7) * 2);
  u32x2 hi = *(const u32x2*)(tile + swz(row, k1 >> 3) + (k1 & 7) * 2);
  u32x4 o;
  if (rowscale) {
    float s = rowscale[row];
    o[0] = pack2(bflo(lo[0]) * s, bfhi(lo[0]) * s); o[1] = pack2(bflo(lo[1]) * s, bfhi(lo[1]) * s);
    o[2] = pack2(bflo(hi[0]) * s, bfhi(hi[0]) * s); o[3] = pack2(bflo(hi[1]) * s, bfhi(hi[1]) * s);
  } else { o[0] = lo[0]; o[1] = lo[1]; o[2] = hi[0]; o[3] = hi[1]; }
  *(u32x4*)(dst + (size_t)idx * 8) = o;
}

DI void gdn_chunk_item(const Params& p, int item, char* smem) {
  char* ws = p.ws;
  const int n = item & 63, bh = item >> 6, b = bh >> 3, hd = bh & 7;
  const int tid = tidx() + opaque0(), lane = tid & 63, w = tid >> 6;
  char* Cq = smem;
  char* Ck = smem + 8192;
  char* Cv = smem + 16384;
  float* Am = (float*)(smem + 24576);
  char* ATT = smem + 40960;
  char* Wt = smem + 49152;
  float* gc = (float*)(smem + 57344);
  float* bet = gc + 64;
  float* eg = gc + 128;
  float* ekd = gc + 192;
  const u16* QKV = (const u16*)(ws + OFF_QKV);
  const size_t tok0 = (size_t)b * SEQ + n * 64;
  {
    const int cg = tid & 7, tp = tid >> 3;
#pragma unroll
    for (int part = 0; part < 3; ++part) {
      const int col = part * 512 + hd * 64 + cg * 8;
      const int s0 = n * 64 + 2 * tp;
      const u16* src = QKV + ((size_t)b * SEQ) * 1536 + col;
      u32x4 xr[5];
#pragma unroll
      for (int j = 0; j < 5; ++j) {
        const int ss = s0 - 3 + j;
        xr[j] = (ss >= 0) ? *(const u32x4*)(src + (size_t)ss * 1536) : u32x4{0u, 0u, 0u, 0u};
      }
      float wv[4][8];
#pragma unroll
      for (int j = 0; j < 4; ++j) {
        const f32x4 wa = *(const f32x4*)(p.conv_w + j * 1536 + col), wb = *(const f32x4*)(p.conv_w + j * 1536 + col + 4);
        wv[j][0] = wa[0]; wv[j][1] = wa[1]; wv[j][2] = wa[2]; wv[j][3] = wa[3]; wv[j][4] = wb[0]; wv[j][5] = wb[1]; wv[j][6] = wb[2]; wv[j][7] = wb[3];
      }
      char* C = smem + part * 8192;
#pragma unroll
      for (int tt = 0; tt < 2; ++tt) {
        float y[8];
#pragma unroll
        for (int e = 0; e < 8; ++e) {
          float acc = 0.f;
#pragma unroll
          for (int j = 0; j < 4; ++j) {
            const unsigned wd = xr[tt + j][e >> 1];
            acc += wv[j][e] * ((e & 1) ? bfhi(wd) : bflo(wd));
          }
          y[e] = acc / (1.f + __expf(-acc));
        }
        u32x4 o; o[0] = pack2(y[0], y[1]); o[1] = pack2(y[2], y[3]); o[2] = pack2(y[4], y[5]); o[3] = pack2(y[6], y[7]);
        *(u32x4*)(C + swz(2 * tp + tt, cg)) = o;
      }
    }
  }
  if (w == 0) {
    const float* SM = (const float*)(ws + OFF_SM);
    float bi = SM[(tok0 + lane) * 40 + hd], ai = SM[(tok0 + lane) * 40 + 8 + hd];
    float xs = ai + p.dt_bias[hd];
    float sp = (xs > 20.f) ? xs : log1pf(__expf(xs));
    float gv = -__expf(p.a_log[hd]) * sp;
#pragma unroll
    for (int o = 1; o < 64; o <<= 1) { float t = __shfl_up(gv, o); if (lane >= o) gv += t; }
    float glast = __shfl(gv, 63);
    gc[lane] = gv; bet[lane] = sigmoidf_(bi); eg[lane] = __expf(gv); ekd[lane] = __expf(glast - gv);
    if (lane == 63) ((float*)(ws + OFF_MISC + MISC_GL))[item] = __expf(gv);
  }
  __syncthreads();
  if (tid < 128) {
    char* C = (tid < 64) ? Cq : Ck;
    const int row = tid & 63;
    u32x4 v[8];
    float ss = 0.f;
#pragma unroll
    for (int c = 0; c < 8; ++c) {
      v[c] = *(const u32x4*)(C + swz(row, c));
#pragma unroll
      for (int e = 0; e < 4; ++e) { float a = bflo(v[c][e]), bb = bfhi(v[c][e]); ss += a * a + bb * bb; }
    }
    float rs = rsqrtf(ss + 1e-6f) * ((tid < 64) ? 0.125f : 1.f);
#pragma unroll
    for (int c = 0; c < 8; ++c) {
      u32x4 o;
#pragma unroll
      for (int e = 0; e < 4; ++e) o[e] = pack2(bflo(v[c][e]) * rs, bfhi(v[c][e]) * rs);
      *(u32x4*)(C + swz(row, c)) = o;
    }
  }
  __syncthreads();
  {
    const int qa = w >> 1, qb = w & 1, r = lane & 31, h = lane >> 5;
    f32x16 akk, aqk;
#pragma unroll
    for (int k = 0; k < 16; ++k) { akk[k] = 0.f; aqk[k] = 0.f; }
    if (!(qa == 0 && qb == 1)) {
#pragma unroll
      for (int s = 0; s < 4; ++s) {
        bf16x8 ak = lds_frag(Ck, 32 * qa + r, 2 * s + h);
        bf16x8 aq = lds_frag(Cq, 32 * qa + r, 2 * s + h);
        bf16x8 bk = lds_frag(Ck, 32 * qb + r, 2 * s + h);
        akk = mfma32(ak, bk, akk);
        aqk = mfma32(aq, bk, aqk);
      }
    }
    const int j = 32 * qb + r;
    const float gj = gc[j];
#pragma unroll
    for (int k = 0; k < 16; ++k) {
      const int i = 32 * qa + (k & 3) + 8 * (k >> 2) + 4 * h;
      float dec = __expf(fminf(gc[i] - gj, 0.f));
      Am[i * 64 + j] = (j < i) ? akk[k] * bet[i] * dec : 0.f;
      *(u16*)(ATT + swz(i, j >> 3) + (j & 7) * 2) = f2bf((j <= i) ? aqk[k] * dec : 0.f);
    }
  }
  __syncthreads();
  u16* AMg = (u16*)p.out + (size_t)item * 16384;
  {
    const int c = tid >> 1, half = tid & 1, dcol = c & 63;
    const char* Rt = (c < 64) ? Cv : Ck;
    float xh[32];
#pragma unroll
    for (int k = 0; k < 32; ++k) xh[k] = 0.f;
#pragma unroll
    for (int i = 0; i < 64; ++i) {
      const float rhs = bf2f(*(const u16*)(Rt + swz(i, dcol >> 3) + (dcol & 7) * 2)) * bet[i] * ((c < 64) ? 1.f : eg[i]);
      float s0 = 0.f, s1 = 0.f;
#pragma unroll
      for (int j4 = 0; j4 < (i + 3) / 4; ++j4) {
        const f32x4 a = *(const f32x4*)(Am + i * 64 + j4 * 4);
        s0 += (half ? a[1] : a[0]) * xh[2 * j4];
        s1 += (half ? a[3] : a[2]) * xh[2 * j4 + 1];
      }
      float tot = s0 + s1;
      tot += dpp_xor1(tot);
      float xi = rhs - tot;
      asm volatile("" : "+v"(xi) : : "memory");
      if ((i & 1) == 0) { if (half == 0) xh[i >> 1] = xi; } else { if (half == 1) xh[i >> 1] = xi; }
    }
    if (c < 64) {
      float* U = (float*)(ws + OFF_RH) + ((size_t)item * 64 + c) * 64;
#pragma unroll
      for (int k = 0; k < 32; ++k) U[2 * k + half] = xh[k];
    } else {
#pragma unroll
      for (int k = 0; k < 32; ++k) { const int i = 2 * k + half; *(u16*)(Wt + swz(i, dcol >> 3) + (dcol & 7) * 2) = f2bf(xh[k]); }
    }
  }
  {
#pragma unroll
    for (int i = 0; i < 2; ++i) {
      gdn_store_frag(AMg + 4096, Cq, tid + 256 * i, 1.f, eg);
      gdn_store_frag(AMg + 8192, ATT, tid + 256 * i, 0.f, nullptr);
    }
#pragma unroll
    for (int i = 0; i < 2; ++i) {
      const int idx = tid + 256 * i, blk = idx >> 6, ln = idx & 63, rt = blk >> 1, ks = blk & 1, r = ln & 15, q = ln >> 4;
      const int d = 16 * rt + r;
      float vv[8];
#pragma unroll
      for (int j = 0; j < 8; ++j) {
        const int tk = 32 * ks + ((j < 4) ? (4 * q + j) : (16 + 4 * q + (j - 4)));
        vv[j] = bf2f(*(const u16*)(Ck + swz(tk, d >> 3) + (d & 7) * 2)) * ekd[tk];
      }
      *(bf16x8*)(AMg + 12288 + (size_t)idx * 8) = pack8(vv[0], vv[1], vv[2], vv[3], vv[4], vv[5], vv[6], vv[7]);
    }
  }
  __syncthreads();
#pragma unroll
  for (int i = 0; i < 2; ++i) gdn_store_frag(AMg, Wt, tid + 256 * i, 0.f, nullptr);
  __syncthreads();
}

DI void phase2(const Params& p, int bid, int nblk, char* smem) {
  const int total = 64 + 2048 + 4096;
  for (int it = bid; it < total; it += nblk) {
    if (it < 64) cmp_gemm_item(p, it, smem);
    else if (it < 2112) vtrans_item(p, it - 64, smem);
    else gdn_chunk_item(p, it - 2112, smem);
  }
}

DI void gdn_scan_item(const Params& p, int bh, char* smem) {
  char* ws = p.ws;
  const int tid = tidx(), lane = tid & 63, w = tid >> 6, col = lane & 15, q = lane >> 4;
  const int b = bh >> 3, hd = bh & 7;
  const u16* AMg = (const u16*)p.out + (size_t)bh * 64 * 16384;
  const float* U = (const float*)(ws + OFF_RH) + (size_t)bh * 64 * 4096;
  const float* GL = (const float*)(ws + OFF_MISC + MISC_GL) + bh * 64;
  float* O = (float*)(ws + OFF_QKV);
  f32x4 S[4];
#pragma unroll
  for (int t = 0; t < 4; ++t) S[t] = f32x4{0.f, 0.f, 0.f, 0.f};
  u32x4 stg[8];
#pragma unroll
  for (int i = 0; i < 8; ++i) stg[i] = *(const u32x4*)(AMg + (size_t)(i * 256 + tid) * 8);
  f32x4 u[4];
#pragma unroll
  for (int ct = 0; ct < 4; ++ct) u[ct] = *(const f32x4*)(U + (size_t)(16 * w + col) * 64 + 16 * ct + 4 * q);
  float gl = GL[0];
  for (int nn = 0; nn < 64 * (1 + SCAN_REP); ++nn) {
    const int n = nn & 63;
    char* buf = smem + (n & 1) * 32768;
    if (n == 0) {
#pragma unroll
      for (int t4 = 0; t4 < 4; ++t4) S[t4] = f32x4{0.f, 0.f, 0.f, 0.f};
    }
#pragma unroll
    for (int i = 0; i < 8; ++i) *(u32x4*)(buf + (i * 256 + tid) * 16) = stg[i];
    __syncthreads();
    f32x4 ucur[4];
#pragma unroll
    for (int ct = 0; ct < 4; ++ct) ucur[ct] = u[ct];
    const float glcur = gl;
    if (nn + 1 < 64 * (1 + SCAN_REP)) {
      const int nx = (n + 1) & 63;
      const u16* src = AMg + (size_t)nx * 16384;
#pragma unroll
      for (int i = 0; i < 8; ++i) stg[i] = *(const u32x4*)(src + (size_t)(i * 256 + tid) * 8);
      const float* un = U + (size_t)nx * 4096;
#pragma unroll
      for (int ct = 0; ct < 4; ++ct) u[ct] = *(const f32x4*)(un + (size_t)(16 * w + col) * 64 + 16 * ct + 4 * q);
      gl = GL[nx];
    }
    bf16x8 bS[2];
#pragma unroll
    for (int ks = 0; ks < 2; ++ks)
      bS[ks] = pack8(S[2 * ks][0], S[2 * ks][1], S[2 * ks][2], S[2 * ks][3], S[2 * ks + 1][0], S[2 * ks + 1][1], S[2 * ks + 1][2], S[2 * ks + 1][3]);
#define AFRAG(mat, rt, ks) (*(const bf16x8*)(buf + (mat) * 8192 + (((rt) * 2 + (ks)) * 64 + lane) * 16))
    f32x4 vn[4], o[4];
#pragma unroll
    for (int ct = 0; ct < 4; ++ct) {
      f32x4 a = f32x4{0.f, 0.f, 0.f, 0.f};
      a = mfma16(AFRAG(0, ct, 0), bS[0], a);
      a = mfma16(AFRAG(0, ct, 1), bS[1], a);
      vn[ct] = ucur[ct] - a;
      f32x4 oo = f32x4{0.f, 0.f, 0.f, 0.f};
      oo = mfma16(AFRAG(1, ct, 0), bS[0], oo);
      oo = mfma16(AFRAG(1, ct, 1), bS[1], oo);
      o[ct] = oo;
    }
    bf16x8 bV[2];
#pragma unroll
    for (int ks = 0; ks < 2; ++ks)
      bV[ks] = pack8(vn[2 * ks][0], vn[2 * ks][1], vn[2 * ks][2], vn[2 * ks][3], vn[2 * ks + 1][0], vn[2 * ks + 1][1], vn[2 * ks + 1][2], vn[2 * ks + 1][3]);
#pragma unroll
    for (int ct = 0; ct < 4; ++ct) {
      o[ct] = mfma16(AFRAG(2, ct, 0), bV[0], o[ct]);
      o[ct] = mfma16(AFRAG(2, ct, 1), bV[1], o[ct]);
      f32x4 sn = S[ct] * glcur;
      sn = mfma16(AFRAG(3, ct, 0), bV[0], sn);
      sn = mfma16(AFRAG(3, ct, 1), bV[1], sn);
      S[ct] = sn;
    }
#undef AFRAG
    float* od = O + ((size_t)b * SEQ + n * 64) * 512 + hd * 64 + 16 * w + col;
#pragma unroll
    for (int ct = 0; ct < 4; ++ct)
#pragma unroll
      for (int rg = 0; rg < 4; ++rg) od[(size_t)(16 * ct + 4 * q + rg) * 512] = o[ct][rg];
  }
  asm volatile("s_waitcnt vmcnt(0)" ::: "memory");
  __syncthreads();
  {
    u16* Z = (u16*)(ws + OFF_Z);
    const int sub = tid & 15;
    const f32x4 gw = ((const f32x4*)p.gdn_norm)[sub];
    for (int tk0 = tid >> 4; tk0 < SEQ; tk0 += 16 * 8) {
      f32x4 v[8]; u32x2 zz[8];
#pragma unroll
      for (int u8 = 0; u8 < 8; ++u8) {
        const size_t gi = ((size_t)b * SEQ + tk0 + 16 * u8) * 8 + hd;
        v[u8] = *(const f32x4*)(O + gi * 64 + sub * 4);
        zz[u8] = *(const u32x2*)(Z + gi * 64 + sub * 4);
      }
#pragma unroll
      for (int u8 = 0; u8 < 8; ++u8) {
        const size_t gi = ((size_t)b * SEQ + tk0 + 16 * u8) * 8 + hd;
        float ss = v[u8][0] * v[u8][0] + v[u8][1] * v[u8][1] + v[u8][2] * v[u8][2] + v[u8][3] * v[u8][3];
        ss += dppf<0xB1>(ss); ss += dppf<0x4E>(ss); ss += dppf<0x141>(ss); ss += dppf<0x140>(ss);
        const float rs = rsqrtf(ss * (1.f / 64.f) + 1e-6f);
        const float z0 = bflo(zz[u8][0]), z1 = bfhi(zz[u8][0]), z2 = bflo(zz[u8][1]), z3 = bfhi(zz[u8][1]);
        u32x2 ov;
        ov[0] = pack2(v[u8][0] * rs * gw[0] * (z0 * sigmoidf_(z0)), v[u8][1] * rs * gw[1] * (z1 * sigmoidf_(z1)));
        ov[1] = pack2(v[u8][2] * rs * gw[2] * (z2 * sigmoidf_(z2)), v[u8][3] * rs * gw[3] * (z3 * sigmoidf_(z3)));
        *(u32x2*)(Z + gi * 64 + sub * 4) = ov;
      }
    }
  }
  __syncthreads();
}

DI void phase_gdn_post(const Params& p, int bid, int nblk) {
  char* ws = p.ws;
  const float* O = (const float*)(ws + OFF_QKV);
  const u16* Z = (const u16*)(ws + OFF_Z);
  u16* OA = (u16*)(ws + OFF_NQ);
  const int sub = tidx() & 15;
  const f32x4 gw = ((const f32x4*)p.gdn_norm)[sub];
  const size_t ngrp = (size_t)NTOK * 8;
  for (size_t gi = ((size_t)bid * NTHREADS + tidx()) >> 4; gi < ngrp; gi += ((size_t)nblk * NTHREADS) >> 4) {
    f32x4 v = *(const f32x4*)(O + gi * 64 + sub * 4);
    float ss = v[0] * v[0] + v[1] * v[1] + v[2] * v[2] + v[3] * v[3];
    ss += __shfl_xor(ss, 1); ss += __shfl_xor(ss, 2); ss += __shfl_xor(ss, 4); ss += __shfl_xor(ss, 8);
    float rs = rsqrtf(ss * (1.f / 64.f) + 1e-6f);
    u32x2 zz = *(const u32x2*)(Z + gi * 64 + sub * 4);
    float z0 = bflo(zz[0]), z1 = bfhi(zz[0]), z2 = bflo(zz[1]), z3 = bfhi(zz[1]);
    u32x2 o;
    o[0] = pack2(v[0] * rs * gw[0] * (z0 * sigmoidf_(z0)), v[1] * rs * gw[1] * (z1 * sigmoidf_(z1)));
    o[1] = pack2(v[2] * rs * gw[2] * (z2 * sigmoidf_(z2)), v[3] * rs * gw[3] * (z3 * sigmoidf_(z3)));
    *(u32x2*)(OA + gi * 64 + sub * 4) = o;
  }
}

constexpr float NEGBIG = -1e30f;
constexpr float QK_SCALE = 0.125f * L2E;

DI float fexp2(float x) { return __builtin_amdgcn_exp2f(x); }
DI float xhalf_max(float x) {
  auto r = __builtin_amdgcn_permlane32_swap(__float_as_uint(x), __float_as_uint(x), false, false);
  return fmaxf(__uint_as_float(r[0]), __uint_as_float(r[1]));
}
DI float xhalf_sum(float x) {
  auto r = __builtin_amdgcn_permlane32_swap(__float_as_uint(x), __float_as_uint(x), false, false);
  return __uint_as_float(r[0]) + __uint_as_float(r[1]);
}

template <int MODE, bool SLOW>
DI void nsa_tile(const char* Kt, const char* Vt, const bf16x8 (&Qf)[4], f32x16 (&O)[2], float& m, float& l,
                 const int t, const int key0, const bool lane_sel, const float* tab, const float c31,
                 const float mfin, const float linv, float* impw) {
  const int lane = tidx() & 63, r = lane & 31, h = lane >> 5;
#pragma unroll
  for (int a = 0; a < 2; ++a) {
    f32x16 S;
#pragma unroll
    for (int k = 0; k < 16; ++k) S[k] = 0.f;
#pragma unroll
    for (int s = 0; s < 4; ++s) S = mfma32(lds_frag(Kt, 32 * a + r, 2 * s + h), Qf[s], S);
    if (!SLOW) {
      const float cb = (MODE == 2 && !lane_sel) ? NEGBIG : c31;
      float mxr = fmaxf(fmaxf(S[0], S[1]), fmaxf(S[2], S[3]));
#pragma unroll
      for (int k = 4; k < 16; k += 4) mxr = fmaxf(mxr, fmaxf(fmaxf(S[k], S[k + 1]), fmaxf(S[k + 2], S[k + 3])));
      const float mx = xhalf_max(fmaf(mxr, QK_SCALE, cb));
      const float mn = fmaxf(m, mx);
      const float alpha = fexp2(m - mn);
      const float cbm = cb - mn;
      float ps = 0.f;
#pragma unroll
      for (int k = 0; k < 16; ++k) { S[k] = fexp2(fmaf(S[k], QK_SCALE, cbm)); ps += S[k]; }
      l = l * alpha + ps;
      m = mn;
#pragma unroll
      for (int dt = 0; dt < 2; ++dt)
#pragma unroll
        for (int k = 0; k < 16; ++k) O[dt][k] *= alpha;
    } else {
      float bias[16];
#pragma unroll
      for (int k = 0; k < 16; ++k) {
        const int kl = 32 * a + (k & 3) + 8 * (k >> 2) + 4 * h;
        const int dist = (MODE < 2) ? (t - (16 * (key0 + kl) + 31)) : (t - (key0 + kl));
        bias[k] = tab[min(max(dist, 0), 128)];
      }
#pragma unroll
      for (int k = 0; k < 16; ++k) asm volatile("" : "+v"(bias[k]));
#pragma unroll
      for (int k = 0; k < 16; ++k) {
        const int kl = 32 * a + (k & 3) + 8 * (k >> 2) + 4 * h;
        const int dist = (MODE < 2) ? (t - (16 * (key0 + kl) + 31)) : (t - (key0 + kl));
        bool valid = (dist >= 0) && lane_sel;
        if (MODE == 3) valid = valid && (dist < 512);
        S[k] = valid ? fmaf(S[k], QK_SCALE, bias[k]) : NEGBIG;
      }
    if (MODE == 1) {
#pragma unroll
      for (int k = 0; k < 16; ++k) S[k] = (S[k] > -1e29f) ? fexp2(S[k] - mfin) * linv : 0.f;
    } else {
      float mx = fmaxf(fmaxf(S[0], S[1]), fmaxf(S[2], S[3]));
#pragma unroll
      for (int k = 4; k < 16; k += 4) mx = fmaxf(mx, fmaxf(fmaxf(S[k], S[k + 1]), fmaxf(S[k + 2], S[k + 3])));
      mx = xhalf_max(mx);
      const float mn = fmaxf(m, mx);
      const float alpha = fexp2(m - mn);
      float ps = 0.f;
#pragma unroll
      for (int k = 0; k < 16; ++k) { S[k] = (S[k] > -1e29f) ? fexp2(S[k] - mn) : 0.f; ps += S[k]; }
      l = l * alpha + ps;
      m = mn;
      if (MODE != 0) {
#pragma unroll
        for (int dt = 0; dt < 2; ++dt)
#pragma unroll
          for (int k = 0; k < 16; ++k) O[dt][k] *= alpha;
      }
    }
    }
    if (MODE == 1) {
#pragma unroll
      for (int g4 = 0; g4 < 4; ++g4) {
        float mainv = S[4 * g4] + S[4 * g4 + 1] + S[4 * g4 + 2] + 0.5f * S[4 * g4 + 3];
        float spill = 0.5f * S[4 * g4 + 3];
        mainv += __shfl_xor(mainv, 8); mainv += __shfl_xor(mainv, 16);
        spill += __shfl_xor(spill, 8); spill += __shfl_xor(spill, 16);
        const int blk = ((key0 + 32 * a) >> 2) + 2 * g4 + h;
        if (r < 8) { atomicAdd(&impw[r * 68 + blk], mainv); atomicAdd(&impw[r * 68 + blk + 1], spill); }
      }
    }
    if (MODE != 0) {
      bf16x8 P0 = pack8(S[0], S[1], S[2], S[3], S[4], S[5], S[6], S[7]);
      bf16x8 P1 = pack8(S[8], S[9], S[10], S[11], S[12], S[13], S[14], S[15]);
#pragma unroll
      for (int dt = 0; dt < 2; ++dt) {
        O[dt] = mfma32(lds_frag(Vt, 32 * dt + r, 4 * a + h), P0, O[dt]);
        O[dt] = mfma32(lds_frag(Vt, 32 * dt + r, 4 * a + 2 + h), P1, O[dt]);
      }
    }
  }
}

struct NsaSrc { const u16* k; long kld; const u16* v; long vld; };

constexpr int NSA_BUF = 16384;
constexpr int NSA_LDS_BIAS = 3 * NSA_BUF, NSA_LDS_IMP = NSA_LDS_BIAS + 8 * 132 * 4, NSA_LDS_Q = NSA_LDS_IMP + 4 * 8 * 68 * 4;

DI void nsa_item(const Params& p, const int bg, const int hq, char* smem) {
  char* ws = p.ws;
  const int tid = tidx(), lane = tid & 63, w = tid >> 6, r = lane & 31, h = lane >> 5;
  const int b = bg >> 1, g = bg & 1, qi = hq >> 1;
  const int t = 32 * hq + 8 * w + (r & 7);
  const int head = g * 4 + (r >> 3);
  const size_t trow = (size_t)b * SEQ + t;
  float* biasl = (float*)(smem + NSA_LDS_BIAS);
  float* impw = (float*)(smem + NSA_LDS_IMP) + w * (8 * 68);
  const u16* NKV = (const u16*)(ws + OFF_NKV);
  __syncthreads();
  for (int i = tid; i < 8 * 132; i += NTHREADS) biasl[i] = ((const float*)(ws + OFF_MISC + MISC_BIAS))[i];
  for (int i = lane; i < 8 * 68; i += 64) impw[i] = 0.f;
  bf16x8 Q[4];
  {
    const u16* NQ = (const u16*)(ws + OFF_NQ);
#pragma unroll
    for (int s = 0; s < 4; ++s) Q[s] = *(const bf16x8*)(NQ + trow * 512 + head * 64 + 16 * s + 8 * h);
  }
  const float* tab = biasl + head * 132;
  f32x16 O[2];
  float m, l, mfin = 0.f, linv = 0.f;
  u16* OB = (u16*)(ws + OFF_QKV + (size_t)NTOK * 512 * 4);
  auto reset = [&]() {
#pragma unroll
    for (int dt = 0; dt < 2; ++dt)
#pragma unroll
      for (int k = 0; k < 16; ++k) O[dt][k] = 0.f;
    m = NEGBIG; l = 0.f;
  };
  auto stage_issue = [&](const NsaSrc& s, char* buf) {
#pragma unroll
    for (int i = 0; i < 2; ++i) {
      const int ii = w * 2 + i, row = 8 * ii + (lane >> 3), ch = (lane & 7) ^ ((row >> 1) & 7);
      glds16(s.k + (size_t)row * s.kld + ch * 8, buf + ii * 1024 + lane * 16);
      glds16(s.v + (size_t)row * s.vld + ch * 8, buf + 8192 + ii * 1024 + lane * 16);
    }
  };
  auto src_cmp = [&](int tt) { NsaSrc s; s.k = (const u16*)(ws + OFF_KC) + ((size_t)bg * 256 + 64 * tt) * 64; s.kld = 64;
                               s.v = (const u16*)(ws + OFF_VCT) + ((size_t)bg * 4 + tt) * 4096; s.vld = 64; return s; };
  auto src_slc = [&](int j) { NsaSrc s; s.k = NKV + ((size_t)b * SEQ + 64 * j) * 768 + 256 + g * 64; s.kld = 768;
                              s.v = (const u16*)(ws + OFF_VST) + ((size_t)bg * 64 + j) * 4096; s.vld = 64; return s; };
  auto src_win = [&](int j) { NsaSrc s; s.k = NKV + ((size_t)b * SEQ + 64 * j) * 768 + 512 + g * 64; s.kld = 768;
                              s.v = (const u16*)(ws + OFF_VWT) + ((size_t)bg * 64 + j) * 4096; s.vld = 64; return s; };
  auto gatev = [&](int br) { return sigmoidf_(((const float*)(ws + OFF_SM))[trow * 40 + 16 + head * 3 + br]); };
  auto emit = [&](const float wgt, bool first) {
#pragma unroll
    for (int dt = 0; dt < 2; ++dt)
#pragma unroll
      for (int g4 = 0; g4 < 4; ++g4) {
        u16* dst = OB + trow * 512 + head * 64 + 32 * dt + 8 * g4 + 4 * h;
        float v0 = O[dt][4 * g4] * wgt, v1 = O[dt][4 * g4 + 1] * wgt, v2 = O[dt][4 * g4 + 2] * wgt, v3 = O[dt][4 * g4 + 3] * wgt;
        if (!first) {
          u32x2 old = *(const u32x2*)dst;
          v0 += bflo(old[0]); v1 += bfhi(old[0]); v2 += bflo(old[1]); v3 += bfhi(old[1]);
        }
        u32x2 o; o[0] = pack2(v0, v1); o[1] = pack2(v2, v3);
        *(u32x2*)dst = o;
      }
  };
  const int ntc = (2 * hq + 1 + 63) >> 6;
  const int j0 = qi >= 8 ? qi - 8 : 0;
  const int nslc = qi + 1, nwin = qi - j0 + 1, ntot = 2 * ntc + nslc + nwin;
  auto tile_src = [&](int i) {
    if (i < 2 * ntc) return src_cmp(i < ntc ? i : i - ntc);
    i -= 2 * ntc;
    if (i < nslc) return src_slc(i);
    return src_win(j0 + i - nslc);
  };
  int it = 0;
  stage_issue(tile_src(0), smem);
  if (ntot > 1) stage_issue(tile_src(1), smem + NSA_BUF);
  const float c31 = ((const float*)(ws + OFF_MISC + MISC_BIAS))[head * 132 + 128];
#define NSA_STEP(CALL) { \
    if (it + 1 < ntot) asm volatile("s_waitcnt vmcnt(4)" ::: "memory"); else asm volatile("s_waitcnt vmcnt(0)" ::: "memory"); \
    __builtin_amdgcn_s_barrier(); \
    if (it + 2 < ntot) stage_issue(tile_src(it + 2), smem + ((it + 2) % 3) * NSA_BUF); \
    { const char* Kt = smem + (it % 3) * NSA_BUF; const char* Vt = Kt + 8192; CALL; } \
    ++it; }

  reset();
  for (int tt = 0; tt < ntc; ++tt)
    NSA_STEP((nsa_tile<0, true>(Kt, Vt, Q, O, m, l, t, 64 * tt, true, tab, c31, mfin, linv, impw)));
  { float lt = xhalf_sum(l); mfin = m; linv = lt > 0.f ? 1.f / lt : 0.f; }
  for (int tt = 0; tt < ntc; ++tt)
    NSA_STEP((nsa_tile<1, true>(Kt, Vt, Q, O, m, l, t, 64 * tt, true, tab, c31, mfin, linv, impw)));
  emit(gatev(0), true);
  unsigned sel_lo, sel_hi;
  if (qi < 16) {
    unsigned long long mk = (2ull << qi) - 1ull;
    sel_lo = (unsigned)mk; sel_hi = (unsigned)(mk >> 32);
  } else {
    unsigned long long mk = 0ull;
    const float* row = impw + (lane & 7) * 68;
    const int part = lane >> 3, hiM = qi - 2;
    for (int mm = 1 + part; mm <= hiM; mm += 8) {
      const float v = row[mm];
      int rank = 0;
      for (int m2 = 1; m2 <= hiM; ++m2) { const float u = row[m2]; rank += ((u > v) || (u == v && m2 < mm)) ? 1 : 0; }
      if (rank < 13) mk |= 1ull << mm;
    }
    mk |= 1ull | (1ull << qi) | (1ull << (qi - 1));
    sel_lo = (unsigned)mk; sel_hi = (unsigned)(mk >> 32);
    sel_lo |= __shfl_xor(sel_lo, 8); sel_hi |= __shfl_xor(sel_hi, 8);
    sel_lo |= __shfl_xor(sel_lo, 16); sel_hi |= __shfl_xor(sel_hi, 16);
    sel_lo |= __shfl_xor(sel_lo, 32); sel_hi |= __shfl_xor(sel_hi, 32);
  }
  reset();
  for (int j = 0; j <= qi; ++j) {
    const bool lsel = ((j < 32 ? (sel_lo >> j) : (sel_hi >> (j - 32))) & 1u) != 0u;
    if (qi - j <= 2) {
      NSA_STEP((nsa_tile<2, true>(Kt, Vt, Q, O, m, l, t, 64 * j, lsel, tab, c31, mfin, linv, impw)));
    } else {
      NSA_STEP((nsa_tile<2, false>(Kt, Vt, Q, O, m, l, t, 64 * j, lsel, tab, c31, mfin, linv, impw)));
    }
  }
  { float lt = xhalf_sum(l); emit(lt > 0.f ? gatev(1) / lt : 0.f, false); }
  reset();
  for (int j = j0; j <= qi; ++j) {
    if ((qi - j <= 2) || (qi - j == 8)) {
      NSA_STEP((nsa_tile<3, true>(Kt, Vt, Q, O, m, l, t, 64 * j, true, tab, c31, mfin, linv, impw)));
    } else {
      NSA_STEP((nsa_tile<3, false>(Kt, Vt, Q, O, m, l, t, 64 * j, true, tab, c31, mfin, linv, impw)));
    }
  }
#undef NSA_STEP
  { float lt = xhalf_sum(l); emit(lt > 0.f ? gatev(2) / lt : 0.f, false); }
}

DI void phase4(const Params& p, char* smem, int   = 0) {
  const int bid = blockIdx.x, nblk = gridDim.x;
  if (nblk < 128) {
    for (int it = bid; it < 64 + 2048; it += nblk) {
      if (it < 64) gdn_scan_item(p, it, smem);
      else { const int k = it - 64; nsa_item(p, k & 15, 127 - (k >> 4), smem); }
    }
    convert_fp8_rows(p.expert_u, (unsigned char*)(p.ws + OFF_EU), (float*)(p.ws + OFF_MISC + MISC_SCU), 16384, bid, nblk);
    convert_fp8_rows(p.expert_v, (unsigned char*)(p.ws + OFF_EV), (float*)(p.ws + OFF_MISC + MISC_SCV), 16384, bid, nblk);
    return;
  }
  if (bid < 64) {
    gdn_scan_item(p, bid, smem);
    convert_fp8_rows(p.expert_u, (unsigned char*)(p.ws + OFF_EU), (float*)(p.ws + OFF_MISC + MISC_SCU), 16384, bid, 64);
    convert_fp8_rows(p.expert_v, (unsigned char*)(p.ws + OFF_EV), (float*)(p.ws + OFF_MISC + MISC_SCV), 16384, bid, 64);
    return;
  }
  const int nb = nblk - 64, c = bid - 64;
  for (int r = 0;; ++r) {
    const int k = r * nb + ((r & 1) ? (nb - 1 - c) : c);
    if (k >= 2048) break;
    nsa_item(p, k & 15, 127 - (k >> 4), smem);
  }
}

DI void phase_branch(const Params& p, int bid, int nblk, char* smem) {
  char* ws = p.ws;
  const u16* OA = (const u16*)(ws + OFF_Z);
  const u16* OB = (const u16*)(ws + OFF_QKV + (size_t)NTOK * 512 * 4);
  const u16* MG = (const u16*)(ws + OFF_MG);
  u16* MIX = (u16*)(ws + OFF_RH);
  for (int k = 0;; ++k) {
    int mt, nt;
    if (!xcd_tile(k, bid, nblk, 256, 8, mt, nt)) break;
    const int m0 = mt * 128, n0 = nt * 128;
    GemmPtrs g;
    f32x16 acc[2][2];
    gemm_setup(g, OA, 512, m0, (const u16*)(ws + OFF_WAT), 512, n0);
    zero_acc(acc);
    gemm_kloop(acc, g, 8, smem);
    gemm_epilogue_lds(acc, smem, [&](int ml, int nl, const float (&v)[8]) {
      const size_t m = m0 + ml; const int n = n0 + nl;
      const u32x4 gt = *(const u32x4*)(MG + m * 2048 + n);
      float t[8];
#pragma unroll
      for (int e = 0; e < 4; ++e) { t[2 * e] = v[2 * e] * sigmoidf_(bflo(gt[e])); t[2 * e + 1] = v[2 * e + 1] * sigmoidf_(bfhi(gt[e])); }
      *(u32x4*)(MIX + m * 1024 + n) = pack8u(t);
    });
    gemm_setup(g, OB, 512, m0, (const u16*)(ws + OFF_WBT), 512, n0);
    zero_acc(acc);
    gemm_kloop(acc, g, 8, smem);
    gemm_epilogue_lds(acc, smem, [&](int ml, int nl, const float (&v)[8]) {
      const size_t m = m0 + ml; const int n = n0 + nl;
      const u32x4 gt = *(const u32x4*)(MG + m * 2048 + 1024 + n);
      const u32x4 old = *(const u32x4*)(MIX + m * 1024 + n);
      float t[8];
#pragma unroll
      for (int e = 0; e < 4; ++e) {
        t[2 * e] = bflo(old[e]) + v[2 * e] * sigmoidf_(bflo(gt[e]));
        t[2 * e + 1] = bfhi(old[e]) + v[2 * e + 1] * sigmoidf_(bfhi(gt[e]));
      }
      *(u32x4*)(MIX + m * 1024 + n) = pack8u(t);
    });
  }
}

DI void phase_outproj(const Params& p, int bid, int nblk, char* smem) {
  char* ws = p.ws;
  const u16* MIX = (const u16*)(ws + OFF_RH);
  for (int k = 0;; ++k) {
    int mt, nt;
    if (!xcd_tile(k, bid, nblk, 256, 8, mt, nt)) break;
    const int m0 = mt * 128, n0 = nt * 128;
    GemmPtrs g;
    f32x16 acc[2][2];
    gemm_setup(g, MIX, 1024, m0, (const u16*)(ws + OFF_WOT), 1024, n0);
    zero_acc(acc);
    gemm_kloop(acc, g, 16, smem);
    gemm_epilogue_lds(acc, smem, [&](int ml, int nl, const float (&v)[8]) {
      const size_t idx = (size_t)(m0 + ml) * 1024 + n0 + nl;
      const f32x4 x0 = *(const f32x4*)(p.x + idx), x1 = *(const f32x4*)(p.x + idx + 4);
      float* X1 = (float*)(ws + OFF_QKV);
      const float y[8] = {x0[0] + v[0], x0[1] + v[1], x0[2] + v[2], x0[3] + v[3], x1[0] + v[4], x1[1] + v[5], x1[2] + v[6], x1[3] + v[7]};
      *(f32x4*)(X1 + idx) = f32x4{y[0], y[1], y[2], y[3]};
      *(f32x4*)(X1 + idx + 4) = f32x4{y[4], y[5], y[6], y[7]};
      *(u32x4*)((u16*)(ws + OFF_MG) + idx) = pack8u(y);
      float ss = y[0] * y[0] + y[1] * y[1] + y[2] * y[2] + y[3] * y[3] + y[4] * y[4] + y[5] * y[5] + y[6] * y[6] + y[7] * y[7];
      ss += dppf<0xB1>(ss); ss += dppf<0x4E>(ss); ss += dppf<0x141>(ss); ss += dppf<0x140>(ss);
      if ((tidx() & 15) == 0) ((float*)(ws + OFF_MG + (size_t)NTOK * 1024 * 2))[(size_t)(m0 + ml) * 8 + nt] = ss;
    });
  }
}

DI void phase_query(const Params& p, int bid, int nblk, char* smem) {
  char* ws = p.ws;
  const u16* H2 = (const u16*)(ws + OFF_RH);
  u16* QRY = (u16*)(ws + OFF_MG);
  for (int k = 0;; ++k) {
    int mt, nt;
    if (!xcd_tile(k, bid, nblk, 256, 16, mt, nt)) break;
    const int m0 = mt * 128, n0 = nt * 128;
    GemmPtrs g;
    f32x16 acc[2][2];
    gemm_setup(g, H2, 1024, m0, (const u16*)(ws + OFF_WQT), 1024, n0);
    zero_acc(acc);
    gemm_kloop(acc, g, 16, smem);
    gemm_epilogue_lds(acc, smem, [&](int ml, int nl, const float (&v)[8]) { *(u32x4*)(QRY + (size_t)(m0 + ml) * 2048 + n0 + nl) = pack8u(v); });
  }
}

DI unsigned f2ord(float f) { unsigned u = __float_as_uint(f); return (u & 0x80000000u) ? ~u : (u | 0x80000000u); }
DI float ord2f(unsigned o) { unsigned u = (o & 0x80000000u) ? (o & 0x7fffffffu) : ~o; return __uint_as_float(u); }

DI void peer_route_job(const Params& p, int job, char* smem) {
  char* ws = p.ws;
  const int mt = job >> 3, hd = job & 7, m0 = mt * 128;
  const u16* H2 = (const u16*)(ws + OFF_MG);
  const u16* WQ = (const u16*)(ws + OFF_WQT);
  float* rs_l = (float*)(smem + 71680);
  const u16* SK = (const u16*)(ws + OFF_SK);
  unsigned* keys = (unsigned*)smem;
  unsigned char* idxs = (unsigned char*)(smem + 67584);
  const int tid = tidx() + opaque0();
  float v1[16], v2[16];
  __syncthreads();
  if (tid < 128) {
    const float* sp = (const float*)(ws + OFF_MG + (size_t)NTOK * 1024 * 2) + (size_t)(m0 + tid) * 8;
    const f32x4 a = *(const f32x4*)sp, b4 = *(const f32x4*)(sp + 4);
    rs_l[tid] = rsqrtf((a[0] + a[1] + a[2] + a[3] + b4[0] + b4[1] + b4[2] + b4[3]) * (1.f / 1024.f) + 1e-6f);
  }
#pragma unroll
  for (int pp = 0; pp < 2; ++pp) {
    GemmPtrs g;
    f32x16 acc[2][2];
    gemm_setup(g, H2, 1024, m0, WQ, 1024, (hd * 2 + pp) * 128);
    zero_acc(acc);
    gemm_kloop(acc, g, 16, smem);
    {
      const int lane = tid & 63, w = tid >> 6, wm = w >> 1, wn = w & 1, r = lane & 31, h = lane >> 5;
#pragma unroll
      for (int i = 0; i < 2; ++i)
#pragma unroll
        for (int j = 0; j < 2; ++j)
          {
            const int nl = wn * 64 + j * 32 + r;
            char* colbase = smem + (nl >> 6) * 32768 + (nl & 7) * 2;
            const int chn = (nl & 63) >> 3;
#pragma unroll
            for (int k = 0; k < 16; ++k) {
              const int ml = wm * 64 + i * 32 + (k & 3) + 8 * (k >> 2) + 4 * h;
              *(u16*)(colbase + swz(ml, chn)) = f2bf(acc[i][j][k] * rs_l[ml]);
              if ((k & 3) == 3) asm volatile("" ::: "memory");
            }
          }
      const u16* skt = SK + (size_t)(hd * 2 + pp) * 128 * 128;
      char* dstB = smem + 16384 + (w * 4) * 1024 + lane * 16;
#pragma unroll
      for (int i = 0; i < 4; ++i) {
        const int rw = glds_row(i), ch = glds_chunk(rw);
        glds16(skt + (size_t)rw * 128 + ch * 8, dstB + i * 1024);
        glds16(skt + (size_t)rw * 128 + 64 + ch * 8, dstB + 32768 + i * 1024);
      }
      asm volatile("s_waitcnt vmcnt(0)" ::: "memory");
      __syncthreads();
      zero_acc(acc);
#pragma unroll
      for (int kt = 0; kt < 2; ++kt) {
        const char* A = smem + kt * 32768;
        const char* B = A + 16384;
#pragma unroll
        for (int s4 = 0; s4 < 4; ++s4) {
          bf16x8 a0 = lds_frag(A, wm * 64 + r, 2 * s4 + h);
          bf16x8 a1 = lds_frag(A, wm * 64 + 32 + r, 2 * s4 + h);
          bf16x8 b0 = lds_frag(B, wn * 64 + r, 2 * s4 + h);
          bf16x8 b1 = lds_frag(B, wn * 64 + 32 + r, 2 * s4 + h);
          acc[0][0] = mfma32(a0, b0, acc[0][0]);
          acc[0][1] = mfma32(a0, b1, acc[0][1]);
          acc[1][0] = mfma32(a1, b0, acc[1][0]);
          acc[1][1] = mfma32(a1, b1, acc[1][1]);
        }
      }
      __syncthreads();
    }
    gemm_epilogue(acc, [&](int ml, int nl, float v) { keys[ml * 132 + nl] = (f2ord(v) & ~127u) | (unsigned)(127 - nl); });
    __syncthreads();
    {
      const int t2 = tidx(), row = t2 >> 1, half = t2 & 1;
      unsigned kr[64];
#pragma unroll
      for (int j = 0; j < 16; ++j) {
        const u32x4 q4 = *(const u32x4*)(keys + row * 132 + half * 64 + 4 * j);
        kr[4 * j] = q4[0]; kr[4 * j + 1] = q4[1]; kr[4 * j + 2] = q4[2]; kr[4 * j + 3] = q4[3];
      }
      unsigned prev = 0xffffffffu;
#pragma unroll
      for (int rd = 0; rd < 16; ++rd) {
        unsigned best = 0u;
#pragma unroll
        for (int j = 0; j < 64; ++j) { const unsigned k = (kr[j] < prev) ? kr[j] : 0u; best = (k > best) ? k : best; }
        const unsigned other = dpp_xor1u(best);
        best = best > other ? best : other;
        prev = best;
        const float val = ord2f(best & ~127u);
        if (pp == 0) v1[rd] = val; else v2[rd] = val;
        if (half == 0) idxs[row * 32 + pp * 16 + rd] = (unsigned char)(127u - (best & 127u));
      }
    }
    __syncthreads();
  }
  const int t3 = tidx(), row = t3 >> 1, half = t3 & 1;
  unsigned ck[25];
  {
    constexpr int CI[50] = {0,0,0,0,0,0,0,0,0,0,0,0,0,0,0,0, 1,1,1,1,1,1,1,1, 2,2,2,2,2, 3,3,3,3, 4,4,4, 5,5, 6,6, 7,7, 8, 9, 10, 11, 12, 13, 14, 15};
    constexpr int CJ[50] = {0,1,2,3,4,5,6,7,8,9,10,11,12,13,14,15, 0,1,2,3,4,5,6,7, 0,1,2,3,4, 0,1,2,3, 0,1,2, 0,1, 0,1, 0,1, 0, 0, 0, 0, 0, 0, 0, 0};
#pragma unroll
    for (int c = 0; c < 25; ++c) {
      const float a = half ? v1[CI[2 * c + 1]] : v1[CI[2 * c]];
      const float b = half ? v2[CJ[2 * c + 1]] : v2[CJ[2 * c]];
      const int fl = half ? (16 * CI[2 * c + 1] + CJ[2 * c + 1]) : (16 * CI[2 * c] + CJ[2 * c]);
      ck[c] = (f2ord(a + b) & ~255u) | (unsigned)(255 - fl);
    }
  }
  int* EI = (int*)(ws + OFF_NQ) + ((size_t)(m0 + row) * 128 + hd * 16);
  float* GT = (float*)(ws + OFF_NKV) + ((size_t)(m0 + row) * 128 + hd * 16);
  float selv[16];
  unsigned prev = 0xffffffffu;
#pragma unroll
  for (int rd = 0; rd < 16; ++rd) {
    unsigned best = 0u;
#pragma unroll
    for (int c = 0; c < 25; ++c) { unsigned k = (ck[c] < prev) ? ck[c] : 0u; best = (k > best) ? k : best; }
    const unsigned other = dpp_xor1u(best);
    best = best > other ? best : other;
    prev = best;
    const int flat = 255 - (int)(best & 255u);
    selv[rd] = ord2f(best & ~255u);
    if (half == 0) EI[rd] = (int)idxs[row * 32 + (flat >> 4)] * 128 + (int)idxs[row * 32 + 16 + (flat & 15)];
  }
  float sum = 0.f;
  const float mx = selv[0];
#pragma unroll
  for (int k = 0; k < 16; ++k) { selv[k] = __expf(selv[k] - mx); sum += selv[k]; }
  const float inv = 1.f / sum;
  if (half == 0) {
#pragma unroll
    for (int k = 0; k < 16; ++k) GT[k] = selv[k] * inv;
  }
}

DI float gelu_tanh(float x) {
  const float u = 0.7978845608028654f * (x + 0.044715f * x * x * x);
  const float e = __expf(2.f * u);
  const float th = 1.f - 2.f / (e + 1.f);
  return 0.5f * x * (1.f + th);
}
DI void peer_expert_phase(const Params& p, int bid, int nblk) {
  char* ws = p.ws;
  const int lane = tidx() & 63, wv = tidx() >> 6;
  const unsigned char* EU = (const unsigned char*)(ws + OFF_EU);
  const unsigned char* EV = (const unsigned char*)(ws + OFF_EV);
  const float* SCU = (const float*)(ws + OFF_MISC + MISC_SCU);
  const float* SCV = (const float*)(ws + OFF_MISC + MISC_SCV);
  const int* EI = (const int*)(ws + OFF_NQ);
  const float* GT = (const float*)(ws + OFF_NKV);
  for (int tok = bid * 4 + wv; tok < NTOK; tok += nblk * 4) {
    const float* xr = (const float*)(ws + OFF_QKV) + (size_t)tok * 1024 + 16 * lane;
    f32x4 xa[4];
    float ss = 0.f;
#pragma unroll
    for (int i = 0; i < 4; ++i) { xa[i] = *(const f32x4*)(xr + 4 * i); ss += xa[i][0] * xa[i][0] + xa[i][1] * xa[i][1] + xa[i][2] * xa[i][2] + xa[i][3] * xa[i][3]; }
    ss = wave_sum(ss);
    const float rs = rsqrtf(ss * (1.f / 1024.f) + 1e-6f);
    f32x2 h2[8];
#pragma unroll
    for (int i = 0; i < 4; ++i) {
      const f32x4 w4 = *(const f32x4*)(p.norm_ffn + 16 * lane + 4 * i);
      h2[2 * i] = f32x2{bf2f(f2bf(xa[i][0] * rs * w4[0])), bf2f(f2bf(xa[i][1] * rs * w4[1]))};
      h2[2 * i + 1] = f32x2{bf2f(f2bf(xa[i][2] * rs * w4[2])), bf2f(f2bf(xa[i][3] * rs * w4[3]))};
    }
    f32x2 outv[8];
#pragma unroll
    for (int i = 0; i < 8; ++i) outv[i] = f32x2{0.f, 0.f};
#pragma unroll 1
    for (int bt = 0; bt < 2; ++bt) {
      const int eidx = EI[(size_t)tok * 128 + bt * 64 + lane];
      const float gt = GT[(size_t)tok * 128 + bt * 64 + lane];
      const float su = SCU[eidx], sv = SCV[eidx];
      float acc[64];
      {
        u32x4 cur[8], nxt[8];
#pragma unroll
        for (int j = 0; j < 8; ++j) cur[j] = *(const u32x4*)(EU + (size_t)__builtin_amdgcn_readlane(eidx, j) * 1024 + 16 * lane);
#pragma unroll
        for (int g = 0; g < 8; ++g) {
          if (g < 7) {
#pragma unroll
            for (int j = 0; j < 8; ++j) nxt[j] = *(const u32x4*)(EU + (size_t)__builtin_amdgcn_readlane(eidx, 8 * (g + 1) + j) * 1024 + 16 * lane);
          }
#pragma unroll
          for (int j = 0; j < 8; ++j) {
            f32x2 d = f32x2{0.f, 0.f};
#pragma unroll
            for (int i = 0; i < 4; ++i) {
              d += __builtin_amdgcn_cvt_pk_f32_fp8(cur[j][i], false) * h2[2 * i];
              d += __builtin_amdgcn_cvt_pk_f32_fp8(cur[j][i], true) * h2[2 * i + 1];
            }
            acc[8 * g + j] = d[0] + d[1];
          }
#pragma unroll
          for (int j = 0; j < 8; ++j) cur[j] = nxt[j];
        }
      }
#pragma unroll
      for (int st = 0; st < 6; ++st) {
        const int half = 32 >> st;
        const bool up = (lane & half) != 0;
#pragma unroll
        for (int k = 0; k < half; ++k) {
          const float send = up ? acc[k] : acc[k + half];
          const float keep = up ? acc[k + half] : acc[k];
          acc[k] = keep + __shfl_xor(send, half);
        }
      }
      const float wgt = gt * gelu_tanh(acc[0] * su) * sv;
      {
        u32x4 cur[8], nxt[8];
#pragma unroll
        for (int j = 0; j < 8; ++j) cur[j] = *(const u32x4*)(EV + (size_t)__builtin_amdgcn_readlane(eidx, j) * 1024 + 16 * lane);
#pragma unroll
        for (int g = 0; g < 8; ++g) {
          if (g < 7) {
#pragma unroll
            for (int j = 0; j < 8; ++j) nxt[j] = *(const u32x4*)(EV + (size_t)__builtin_amdgcn_readlane(eidx, 8 * (g + 1) + j) * 1024 + 16 * lane);
          }
#pragma unroll
          for (int j = 0; j < 8; ++j) {
            const float we = __uint_as_float((unsigned)__builtin_amdgcn_readlane((int)__float_as_uint(wgt), 8 * g + j));
            const f32x2 w2 = f32x2{we, we};
#pragma unroll
            for (int i = 0; i < 4; ++i) {
              outv[2 * i] += __builtin_amdgcn_cvt_pk_f32_fp8(cur[j][i], false) * w2;
              outv[2 * i + 1] += __builtin_amdgcn_cvt_pk_f32_fp8(cur[j][i], true) * w2;
            }
          }
#pragma unroll
          for (int j = 0; j < 8; ++j) cur[j] = nxt[j];
        }
      }
    }
    float s2 = 0.f;
#pragma unroll
    for (int i = 0; i < 4; ++i) {
      xa[i][0] += outv[2 * i][0]; xa[i][1] += outv[2 * i][1]; xa[i][2] += outv[2 * i + 1][0]; xa[i][3] += outv[2 * i + 1][1];
      s2 += xa[i][0] * xa[i][0] + xa[i][1] * xa[i][1] + xa[i][2] * xa[i][2] + xa[i][3] * xa[i][3];
    }
    s2 = wave_sum(s2);
    const float r2 = rsqrtf(s2 * (1.f / 1024.f) + 1e-6f);
    float* orow = p.out + (size_t)tok * 1024 + 16 * lane;
#pragma unroll
    for (int i = 0; i < 4; ++i) {
      const f32x4 nw = *(const f32x4*)(p.norm_final + 16 * lane + 4 * i);
      *(f32x4*)(orow + 4 * i) = f32x4{xa[i][0] * r2 * nw[0], xa[i][1] * r2 * nw[1], xa[i][2] * r2 * nw[2], xa[i][3] * r2 * nw[3]};
    }
  }
}

#ifndef MK_SINGLE
#define MK_SINGLE 1
#endif
#define SMEM_DECL __shared__ __attribute__((aligned(16))) char smem[SMEM_BYTES]

DI void run_phase(const Params& p, int ph, int bid, int nblk, char* smem) {
  switch (ph) {
    case 0: phase0(p, bid, nblk, smem); break;
    case 1: phase_inproj(p, bid, nblk, smem); break;
    case 2: phase2(p, bid, nblk, smem); break;
    case 3: phase4(p, smem); break;
    case 4: phase_branch(p, bid, nblk, smem); break;
    case 5: phase_outproj(p, bid, nblk, smem); break;
    case 6: for (int j = bid; j < 2048; j += nblk) peer_route_job(p, j, smem); break;
    case 7: peer_expert_phase(p, bid, nblk); break;
  }
}
constexpr int NPHASES = 8;

#if MK_SINGLE
DI void grid_barrier(unsigned* ctr, unsigned target) {
  asm volatile("s_waitcnt vmcnt(0)" ::: "memory");
  __syncthreads();
  if (tidx() == 0) {
    __builtin_amdgcn_fence(__ATOMIC_RELEASE, "agent");
    asm volatile("s_waitcnt vmcnt(0)" ::: "memory");
    __hip_atomic_fetch_add(ctr, 1u, __ATOMIC_RELAXED, __HIP_MEMORY_SCOPE_AGENT);
    while (__hip_atomic_load(ctr, __ATOMIC_RELAXED, __HIP_MEMORY_SCOPE_AGENT) < target) __builtin_amdgcn_s_sleep(2);
    __builtin_amdgcn_fence(__ATOMIC_ACQUIRE, "agent");
    asm volatile("s_waitcnt vmcnt(0)" ::: "memory");
  }
  __syncthreads();
}
#ifndef MK_PROBE_SPLIT
#define MK_PROBE_SPLIT 0
#endif
#ifndef PROBE_P4
#define PROBE_P4 103
#endif
#ifndef PROBE_REPEAT
#define PROBE_REPEAT 0
#endif
#if MK_PROBE_SPLIT
__global__ void __launch_bounds__(NTHREADS, 2) fwd_megakernel(Params p, int phase_sel) {
#else
__global__ void __launch_bounds__(NTHREADS, 2) fwd_megakernel(Params p) {
#endif
  SMEM_DECL;
  cg::grid_group grid = cg::this_grid();
  const int bid = blockIdx.x, nblk = gridDim.x;
  unsigned* bar = (unsigned*)(p.ws + OFF_MISC + MISC_CNT) + 8;
#if MK_PROBE_SPLIT
  switch (phase_sel) {
    case 0: run_phase(p, 0, bid, nblk, smem); break;
    case 1: run_phase(p, 1, bid, nblk, smem); break;
    case 2: run_phase(p, 2, bid, nblk, smem); break;
    case 3: run_phase(p, 3, bid, nblk, smem); break;
    case 103: phase4(p, smem, 1); break;
    case 203: phase4(p, smem, 2); break;
    case 4: run_phase(p, 4, bid, nblk, smem); break;
    case 5: run_phase(p, 5, bid, nblk, smem); break;
    case 6: run_phase(p, 6, bid, nblk, smem); break;
    default: run_phase(p, 7, bid, nblk, smem); break;
  }
  if (phase_sel < 0) { grid.sync(); grid_barrier(bar, 1u); }
#else
  run_phase(p, 0, bid, nblk, smem); grid.sync();
  run_phase(p, 1, bid, nblk, smem); grid_barrier(bar, 1u * nblk);
  run_phase(p, 2, bid, nblk, smem); grid_barrier(bar, 2u * nblk);
  run_phase(p, 3, bid, nblk, smem); grid_barrier(bar, 3u * nblk);
  run_phase(p, 4, bid, nblk, smem); grid_barrier(bar, 4u * nblk);
  run_phase(p, 5, bid, nblk, smem); grid_barrier(bar, 5u * nblk);
  run_phase(p, 6, bid, nblk, smem); grid_barrier(bar, 6u * nblk);
  run_phase(p, 7, bid, nblk, smem);
#endif
}
#else
template <int PH>
__global__ void __launch_bounds__(NTHREADS, 2) phase_kernel(Params p) {
  SMEM_DECL;
  run_phase(p, PH, blockIdx.x, gridDim.x, smem);
}
__global__ void __launch_bounds__(NTHREADS, 2) phase4_again(Params p) { SMEM_DECL; phase4(p, smem, 1); }
#ifndef REPEAT_MASK
#define REPEAT_MASK 0
#endif
#endif

extern "C" void kernel_launch(void* const* d_in, const int* in_sizes, int n_in, void* d_out, int out_size, void* d_ws, size_t ws_size,
                              hipStream_t stream) {
  Params p{};
  const float** f = (const float**)&p;
  for (int i = 0; i < 21; ++i) f[i] = (const float*)d_in[i];
  p.out = (float*)d_out;
  p.ws = (char*)d_ws;
  if (ws_size < WS_NEEDED) return;
#if MK_SINGLE
  static int grid_blocks = 0;
  if (!grid_blocks) {
    int dev = 0, cus = 0, per_cu = 0;
    hipGetDevice(&dev);
    hipDeviceGetAttribute(&cus, hipDeviceAttributeMultiprocessorCount, dev);
    hipOccupancyMaxActiveBlocksPerMultiprocessor(&per_cu, fwd_megakernel, NTHREADS, 0);
    if (per_cu > 2) per_cu = 2;
    grid_blocks = cus * per_cu;
  }
#if MK_PROBE_SPLIT
  for (int ph = 0; ph < NPHASES; ++ph) {
    fwd_megakernel<<<grid_blocks, NTHREADS, 0, stream>>>(p, ph);
    if ((PROBE_REPEAT >> ph) & 1) fwd_megakernel<<<grid_blocks, NTHREADS, 0, stream>>>(p, ph == 3 ? PROBE_P4 : ph);
  }
#else
  void* args[] = {&p};
  hipLaunchCooperativeKernel((void*)fwd_megakernel, dim3(grid_blocks), dim3(NTHREADS), args, 0, stream);
#endif
#else
  const int G = 512;
  phase_kernel<0><<<G, NTHREADS, 0, stream>>>(p);
#if REPEAT_MASK & (1 << 0)
  phase_kernel<0><<<G, NTHREADS, 0, stream>>>(p);
#endif
  phase_kernel<1><<<G, NTHREADS, 0, stream>>>(p);
#if REPEAT_MASK & (1 << 1)
  phase_kernel<1><<<G, NTHREADS, 0, stream>>>(p);
#endif
  phase_kernel<2><<<G, NTHREADS, 0, stream>>>(p);
#if REPEAT_MASK & (1 << 2)
  phase_kernel<2><<<G, NTHREADS, 0, stream>>>(p);
#endif
  phase_kernel<3><<<G, NTHREADS, 0, stream>>>(p);
#if REPEAT_MASK & (1 << 3)
  phase4_again<<<G, NTHREADS, 0, stream>>>(p);
#endif
  phase_kernel<4><<<G, NTHREADS, 0, stream>>>(p);
#if REPEAT_MASK & (1 << 4)
  phase_kernel<4><<<G, NTHREADS, 0, stream>>>(p);
#endif
  phase_kernel<5><<<G, NTHREADS, 0, stream>>>(p);
#if REPEAT_MASK & (1 << 5)
  phase_kernel<5><<<G, NTHREADS, 0, stream>>>(p);
#endif
  phase_kernel<6><<<G, NTHREADS, 0, stream>>>(p);
#if REPEAT_MASK & (1 << 6)
  phase_kernel<6><<<G, NTHREADS, 0, stream>>>(p);
#endif
  phase_kernel<7><<<G, NTHREADS, 0, stream>>>(p);
#if REPEAT_MASK & (1 << 7)
  phase_kernel<7><<<G, NTHREADS, 0, stream>>>(p);
#endif
#endif
}
```
